# Optimizing an MI355X kernel written in HIP

```python
import jax, jax.numpy as jnp
from jax import lax
import numpy as np

D_MODEL = 2048
BATCH = 8
SEQ = 2048
DEPTH = 2
DEC_BATCH = 128
DEC_SEQ = 4
PAST_LEN = 8192
PAGE_SIZE = 128

N_A_LAYERS = DEPTH // 2
N_B_LAYERS = DEPTH - N_A_LAYERS
N_META = 16
A_HEADS = 4
A_DV = D_MODEL // A_HEADS
A_DK = A_DV // 2
A_CHUNK = 128
A_GATE_CAP = 15.0
A_IN_COLS = 2 * A_HEADS * A_DK + 2 * A_HEADS * A_DV + 2 * A_HEADS
B_HEADS = 32
B_DH = D_MODEL // B_HEADS
B_KV_HEADS = 4
B_GROUP = B_HEADS // B_KV_HEADS
WINDOW = 128
B_BLOCK = 128
D_FF = ((8 * D_MODEL // 3 + 255) // 256) * 256
EPS = 1e-6

kernel_name = 'yoco_mlstm_swa_sink_macaron_step'


def rms_norm(x, g):
    xf = x.astype(jnp.float32)
    y = xf * lax.rsqrt(jnp.mean(xf * xf, axis=-1, keepdims=True) + EPS)
    return (y * g.astype(jnp.float32)).astype(x.dtype)


def swiglu_ffn(x, w_in, w_out):
    g, u = jnp.split(x @ w_in, 2, axis=-1)
    return (jax.nn.silu(g) * u) @ w_out


def alibi_slopes():
    h = jnp.arange(1, B_HEADS + 1, dtype=jnp.float32)
    return jnp.exp2(-8.0 * h / B_HEADS).reshape(B_KV_HEADS, B_GROUP)


def mlstm_project(xn, w_in, b_gate):
    bsz, t = xn.shape[0], xn.shape[1]
    p = xn @ w_in
    qk = A_HEADS * A_DK
    hv = A_HEADS * A_DV
    cuts = [qk, 2 * qk, 2 * qk + hv, 2 * qk + 2 * hv, 2 * qk + 2 * hv + A_HEADS]
    q, k, v, o, ig, fg = jnp.split(p, cuts, axis=-1)
    q = q.reshape(bsz, t, A_HEADS, A_DK)
    k = k.reshape(bsz, t, A_HEADS, A_DK) * (A_DK ** -0.5)
    v = v.reshape(bsz, t, A_HEADS, A_DV)
    gates = jnp.concatenate([ig, fg], axis=-1).astype(jnp.float32) + b_gate.astype(jnp.float32)
    gates = A_GATE_CAP * jnp.tanh(gates / A_GATE_CAP)
    ig, fg = jnp.split(gates, 2, axis=-1)
    return q, k, v, o, ig, jax.nn.log_sigmoid(fg)


def mlstm_chunk(carry, inp):
    c_prev, n_prev, m_prev = carry
    q, k, v, ig, log_f = inp
    q = q.astype(jnp.float32)
    k = k.astype(jnp.float32)
    v = v.astype(jnp.float32)
    L = q.shape[1]
    b = jnp.cumsum(log_f, axis=1).transpose(0, 2, 1)
    igt = ig.transpose(0, 2, 1)
    causal = jnp.tril(jnp.ones((L, L), dtype=bool))
    d_log = jnp.where(causal, b[..., :, None] - b[..., None, :] + igt[..., None, :], -jnp.inf)
    inter_log = b + m_prev[..., None]
    m_t = jnp.maximum(inter_log, jnp.max(d_log, axis=-1))
    w_intra = jnp.exp(d_log - m_t[..., None])
    w_inter = jnp.exp(inter_log - m_t)
    s = jnp.einsum('blhd,bshd->bhls', q, k) * w_intra
    num = jnp.einsum('bhls,bshv->bhlv', s, v) + w_inter[..., None] * jnp.einsum('blhd,bhdv->bhlv', q, c_prev)
    den = jnp.sum(s, axis=-1) + w_inter * jnp.einsum('blhd,bhd->bhl', q, n_prev)
    den = jnp.maximum(jnp.abs(den), jnp.exp(-m_t))
    h = (num / den[..., None]).transpose(0, 2, 1, 3)
    b_last = b[..., -1]
    w_log = b_last[..., None] - b + igt
    m_new = jnp.maximum(b_last + m_prev, jnp.max(w_log, axis=-1))
    w_state = jnp.exp(w_log - m_new[..., None])
    decay = jnp.exp(b_last + m_prev - m_new)
    c_new = decay[..., None, None] * c_prev + jnp.einsum('bhs,bshd,bshv->bhdv', w_state, k, v)
    n_new = decay[..., None] * n_prev + jnp.einsum('bhs,bshd->bhd', w_state, k)
    return (c_new, n_new, m_new), h


def mlstm_prompt(q, k, v, ig, log_f):
    bsz = q.shape[0]
    zero = (jnp.zeros((bsz, A_HEADS, A_DK, A_DV), jnp.float32),
            jnp.zeros((bsz, A_HEADS, A_DK), jnp.float32),
            jnp.zeros((bsz, A_HEADS), jnp.float32))
    arrs = (q, k, v, ig, log_f)
    carry, h_meta = mlstm_chunk(zero, tuple(a[:, :N_META] for a in arrs))

    def to_chunks(a):
        r = a[:, N_META:]
        nc = r.shape[1] // A_CHUNK
        return jnp.moveaxis(r.reshape((bsz, nc, A_CHUNK) + r.shape[2:]), 1, 0)

    carry, h_seq = lax.scan(mlstm_chunk, carry, tuple(to_chunks(a) for a in arrs))
    h_seq = jnp.moveaxis(h_seq, 0, 1).reshape(bsz, -1, A_HEADS, A_DV)
    return jnp.concatenate([h_meta, h_seq], axis=1), carry


def mlstm_out(h, o, head_gain, w_out, dtype):
    hn = h * lax.rsqrt(jnp.mean(h * h, axis=-1, keepdims=True) + EPS)
    hn = hn.reshape(h.shape[0], h.shape[1], A_HEADS * A_DV) * head_gain.astype(jnp.float32)
    return (hn * jax.nn.sigmoid(o.astype(jnp.float32))).astype(dtype) @ w_out


def shared_kv(h, kv_norm, w_kv, k_norm):
    xn = rms_norm(h, kv_norm)
    kv = (xn @ w_kv).reshape(h.shape[0], h.shape[1], 2, B_KV_HEADS, B_DH)
    return rms_norm(kv[:, :, 0], k_norm), kv[:, :, 1]


def b_queries(xn, w_q, q_norm):
    q = (xn @ w_q).reshape(xn.shape[0], xn.shape[1], B_KV_HEADS, B_GROUP, B_DH)
    return rms_norm(q, q_norm)


def sink_attention(q, k, v, valid, dist, sinks):
    slopes = alibi_slopes()
    s = jnp.einsum('bnqgrd,bnkgd->bngrqk', q, k).astype(jnp.float32) * (B_DH ** -0.5)
    s = s - slopes[None, None, :, :, None, None] * dist[None, :, None, None]
    s = jnp.where(valid[None, :, None, None], s, -jnp.inf)
    sink = sinks.astype(jnp.float32)[None, None, :, :, None]
    mx = jnp.maximum(jnp.max(s, axis=-1), sink)
    p = jnp.exp(s - mx[..., None])
    den = jnp.sum(p, axis=-1) + jnp.exp(sink - mx)
    return jnp.einsum('bngrqk,bnkgd->bnqgrd', p / den[..., None], v.astype(jnp.float32))


def window_attn_prompt(q, k, v, sinks):
    bsz, t = q.shape[0], q.shape[1]
    nb = -(-t // B_BLOCK)
    pad = nb * B_BLOCK - t
    qb = jnp.pad(q, ((0, 0), (0, pad), (0, 0), (0, 0), (0, 0))).reshape(bsz, nb, B_BLOCK, B_KV_HEADS, B_GROUP, B_DH)
    kp = jnp.pad(k, ((0, 0), (B_BLOCK, pad), (0, 0), (0, 0))).reshape(bsz, nb + 1, B_BLOCK, B_KV_HEADS, B_DH)
    vp = jnp.pad(v, ((0, 0), (B_BLOCK, pad), (0, 0), (0, 0))).reshape(bsz, nb + 1, B_BLOCK, B_KV_HEADS, B_DH)
    meta_shape = (bsz, nb, N_META, B_KV_HEADS, B_DH)
    keys = jnp.concatenate([jnp.broadcast_to(k[:, None, :N_META], meta_shape), kp[:, :-1], kp[:, 1:]], axis=2)
    vals = jnp.concatenate([jnp.broadcast_to(v[:, None, :N_META], meta_shape), vp[:, :-1], vp[:, 1:]], axis=2)
    blk = jnp.arange(nb)[:, None]
    t_pos = blk * B_BLOCK + jnp.arange(B_BLOCK)[None, :]
    s_band = (blk - 1) * B_BLOCK + jnp.arange(2 * B_BLOCK)[None, :]
    s_meta = jnp.broadcast_to(jnp.arange(N_META)[None, :], (nb, N_META))
    s_all = jnp.concatenate([s_meta, s_band], axis=1)
    is_meta = jnp.concatenate([jnp.ones((N_META,), bool), jnp.zeros((2 * B_BLOCK,), bool)])
    rel = t_pos[:, :, None] - s_all[:, None, :]
    band_ok = (rel >= 0) & (rel < WINDOW) & (s_all[:, None, :] >= 0) & (s_all[:, None, :] < t)
    valid = jnp.where(is_meta[None, None, :], rel >= WINDOW, band_ok)
    dist = jnp.minimum(rel, WINDOW).astype(jnp.float32)
    o = sink_attention(qb, keys, vals, valid, dist, sinks)
    return o.reshape(bsz, nb * B_BLOCK, B_HEADS * B_DH)[:, :t]


def window_attn_sample(q, k_new, v_new, k_meta, v_meta, k_win, v_win, sinks):
    bsz, s_len = q.shape[0], q.shape[1]
    keys = jnp.concatenate([k_meta, k_win, k_new.astype(k_win.dtype)], axis=1)[:, None]
    vals = jnp.concatenate([v_meta, v_win, v_new.astype(v_win.dtype)], axis=1)[:, None]
    t_pos = PAST_LEN + jnp.arange(s_len)
    s_all = jnp.concatenate([jnp.arange(N_META), PAST_LEN - WINDOW + jnp.arange(WINDOW), PAST_LEN + jnp.arange(s_len)])
    is_meta = jnp.concatenate([jnp.ones((N_META,), bool), jnp.zeros((WINDOW + s_len,), bool)])
    rel = t_pos[:, None] - s_all[None, :]
    valid = jnp.where(is_meta[None, :], rel >= WINDOW, (rel >= 0) & (rel < WINDOW))
    dist = jnp.minimum(rel, WINDOW).astype(jnp.float32)
    o = sink_attention(q[:, None], keys, vals, valid[None], dist[None], sinks)
    return o.reshape(bsz, s_len, B_HEADS * B_DH)


def trunk(h, a_mixer, make_kv, b_mixer, ffn_norm, w_ffn_in, w_ffn_out, mix_norm):
    a_states = []
    kv = None
    for layer in range(DEPTH):
        if layer == N_A_LAYERS:
            kv = make_kv(h)
        h = h + 0.5 * swiglu_ffn(rms_norm(h, ffn_norm[layer, 0]), w_ffn_in[layer, 0], w_ffn_out[layer, 0])
        xn = rms_norm(h, mix_norm[layer])
        if layer < N_A_LAYERS:
            out, st = a_mixer(layer, xn)
            a_states.append(st)
        else:
            out = b_mixer(layer - N_A_LAYERS, xn, kv)
        h = h + out
        h = h + 0.5 * swiglu_ffn(rms_norm(h, ffn_norm[layer, 1]), w_ffn_in[layer, 1], w_ffn_out[layer, 1])
    return h, a_states, kv


def setup_inputs(seed: int = 0) -> dict:
    key = jax.random.key(seed)
    ks = jax.random.split(key, 32)

    def nrm(k, shape, scale):
        return jax.random.normal(k, shape, jnp.float32) * scale

    f_bias = jnp.linspace(3.0, 6.0, A_HEADS, dtype=jnp.float32)[None, :] + nrm(ks[20], (N_A_LAYERS, A_HEADS), 0.1)
    i_bias = nrm(ks[21], (N_A_LAYERS, A_HEADS), 0.1)
    return {
        'x_prompt': nrm(ks[0], (BATCH, SEQ, D_MODEL), 1.0),
        'x_sample': nrm(ks[1], (DEC_BATCH, DEC_SEQ, D_MODEL), 1.0),
        'state_C': nrm(ks[2], (N_A_LAYERS, DEC_BATCH, A_HEADS, A_DK, A_DV), 0.1),
        'state_n': nrm(ks[3], (N_A_LAYERS, DEC_BATCH, A_HEADS, A_DK), 0.1),
        'state_m': nrm(ks[4], (N_A_LAYERS, DEC_BATCH, A_HEADS), 1.0),
        'cache_k_meta': nrm(ks[5], (DEC_BATCH, N_META, B_KV_HEADS, B_DH), 1.0),
        'cache_v_meta': nrm(ks[6], (DEC_BATCH, N_META, B_KV_HEADS, B_DH), 1.0),
        'cache_k_win': nrm(ks[7], (DEC_BATCH, WINDOW, B_KV_HEADS, B_DH), 1.0),
        'cache_v_win': nrm(ks[8], (DEC_BATCH, WINDOW, B_KV_HEADS, B_DH), 1.0),
        'meta_tokens': nrm(ks[9], (N_META, D_MODEL), 1.0),
        'ffn_norm': 1.0 + nrm(ks[10], (DEPTH, 2, D_MODEL), 0.02),
        'w_ffn_in': nrm(ks[11], (DEPTH, 2, D_MODEL, 2 * D_FF), D_MODEL ** -0.5),
        'w_ffn_out': nrm(ks[12], (DEPTH, 2, D_FF, D_MODEL), D_FF ** -0.5),
        'mix_norm': 1.0 + nrm(ks[13], (DEPTH, D_MODEL), 0.02),
        'w_a_in': nrm(ks[14], (N_A_LAYERS, D_MODEL, A_IN_COLS), D_MODEL ** -0.5),
        'b_a_gate': jnp.concatenate([i_bias, f_bias], axis=-1),
        'a_head_norm': 1.0 + nrm(ks[15], (N_A_LAYERS, A_HEADS * A_DV), 0.02),
        'w_a_out': nrm(ks[16], (N_A_LAYERS, A_HEADS * A_DV, D_MODEL), (A_HEADS * A_DV) ** -0.5),
        'kv_norm': 1.0 + nrm(ks[17], (D_MODEL,), 0.02),
        'w_kv': nrm(ks[18], (D_MODEL, 2 * B_KV_HEADS * B_DH), D_MODEL ** -0.5),
        'k_norm': 1.0 + nrm(ks[19], (B_DH,), 0.02),
        'w_q': nrm(ks[22], (N_B_LAYERS, D_MODEL, B_HEADS * B_DH), D_MODEL ** -0.5),
        'q_norm': 1.0 + nrm(ks[23], (N_B_LAYERS, B_DH), 0.02),
        'sinks': nrm(ks[24], (N_B_LAYERS, B_HEADS), 0.5),
        'w_b_out': nrm(ks[25], (N_B_LAYERS, B_HEADS * B_DH, D_MODEL), (B_HEADS * B_DH) ** -0.5),
    }


def reference(x_prompt, x_sample, state_C, state_n, state_m, cache_k_meta, cache_v_meta, cache_k_win, cache_v_win,
              meta_tokens, ffn_norm, w_ffn_in, w_ffn_out, mix_norm, w_a_in, b_a_gate, a_head_norm, w_a_out,
              kv_norm, w_kv, k_norm, w_q, q_norm, sinks, w_b_out):
    def make_kv(h):
        return shared_kv(h, kv_norm, w_kv, k_norm)

    def a_prompt(la, xn):
        q, k, v, o, ig, lf = mlstm_project(xn, w_a_in[la], b_a_gate[la])
        h, st = mlstm_prompt(q, k, v, ig, lf)
        return mlstm_out(h, o, a_head_norm[la], w_a_out[la], xn.dtype), st

    def a_sample(la, xn):
        q, k, v, o, ig, lf = mlstm_project(xn, w_a_in[la], b_a_gate[la])
        carry = (state_C[la].astype(jnp.float32), state_n[la].astype(jnp.float32), state_m[la].astype(jnp.float32))
        st, h = mlstm_chunk(carry, (q, k, v, ig, lf))
        return mlstm_out(h, o, a_head_norm[la], w_a_out[la], xn.dtype), st

    def b_prompt(lb, xn, kv):
        q = b_queries(xn, w_q[lb], q_norm[lb])
        o = window_attn_prompt(q, kv[0], kv[1], sinks[lb].reshape(B_KV_HEADS, B_GROUP))
        return o.astype(xn.dtype) @ w_b_out[lb]

    def b_sample(lb, xn, kv):
        q = b_queries(xn, w_q[lb], q_norm[lb])
        o = window_attn_sample(q, kv[0], kv[1], cache_k_meta, cache_v_meta, cache_k_win, cache_v_win,
                               sinks[lb].reshape(B_KV_HEADS, B_GROUP))
        return o.astype(xn.dtype) @ w_b_out[lb]

    bsz = x_prompt.shape[0]
    meta = jnp.broadcast_to(meta_tokens.astype(x_prompt.dtype)[None], (bsz, N_META, D_MODEL))
    h_p, st_p, kv_p = trunk(jnp.concatenate([meta, x_prompt], axis=1), a_prompt, make_kv, b_prompt,
                            ffn_norm, w_ffn_in, w_ffn_out, mix_norm)
    h_s, st_s, kv_s = trunk(x_sample, a_sample, make_kv, b_sample, ffn_norm, w_ffn_in, w_ffn_out, mix_norm)

    y_prompt = h_p[:, N_META:]
    k_p, v_p = kv_p
    k_s, v_s = kv_s
    c_p = jnp.stack([st[0] for st in st_p]).astype(state_C.dtype)
    n_p = jnp.stack([st[1] for st in st_p]).astype(state_n.dtype)
    m_p = jnp.stack([st[2] for st in st_p]).astype(state_m.dtype)
    c_s = jnp.stack([st[0] for st in st_s]).astype(state_C.dtype)
    n_s = jnp.stack([st[1] for st in st_s]).astype(state_n.dtype)
    m_s = jnp.stack([st[2] for st in st_s]).astype(state_m.dtype)
    k_win_s = jnp.concatenate([cache_k_win, k_s.astype(cache_k_win.dtype)], axis=1)[:, -WINDOW:]
    v_win_s = jnp.concatenate([cache_v_win, v_s.astype(cache_v_win.dtype)], axis=1)[:, -WINDOW:]
    return (y_prompt, h_s, c_p, n_p, m_p, k_p[:, :N_META], v_p[:, :N_META], k_p[:, -WINDOW:], v_p[:, -WINDOW:], c_s, n_s, m_s, k_win_s, v_win_s)
```

```cpp
#include <hip/hip_runtime.h>
#include <cstdio>
#include <cstdint>
namespace pg8 {
#define PG8_LAS __attribute__((address_space(3)))
typedef unsigned short bf16_t;
typedef short bf16x8 __attribute__((ext_vector_type(8)));
typedef float f32x4 __attribute__((ext_vector_type(4)));
typedef unsigned u32x4 __attribute__((ext_vector_type(4)));
constexpr int BM = 256, BK = 64, HALF = 128, HTB = HALF * BK * 2  , STAGE_BYTES = 8 * HTB, NXCD = 8, WGM = 8;

__host__ __device__ __forceinline__ int lds_byte(int r, int c) { const int st = (r >> 4) * 2 + (c >> 5), rr = r & 15, cc = c & 31, ob = rr * 64 + cc * 2; return st * 1024 + (ob ^ (((ob >> 9) & 1) << 5)); }
__host__ __device__ __forceinline__ void stage_rc(int b, int& R, int& C) { const int st = b / 1024, sb = b % 1024, swz = sb ^ (((sb >> 9) & 1) << 5); R = (st >> 1) * 16 + swz / 64; C = (st & 1) * 32 + (swz % 64) / 2; }
__host__ __device__ __forceinline__ int perm32(int rho) { const int n = rho >> 4, i = rho & 15; return 8 * (i >> 2) + 4 * n + (i & 3); }

struct Unit { int pm, pn; };
struct Gemm { const bf16_t* A; const bf16_t* Bt; int M, N, K; };

struct StaticOrder {
    int nM, nN, nwg, G, c;
    __host__ __device__ void init(int M, int N, int G_, int c_) { nM = M / BM; nN = N / BM; nwg = nM * nN; G = G_; c = c_; }
    __host__ __device__ bool next(int i, Unit& u) const {
        const long L = (long)i * G + c; if (L >= nwg) return false;
        int wgid = (int)L; { const int q = nwg / NXCD, r = nwg % NXCD, xcd = wgid % NXCD, off = wgid / NXCD; wgid = (xcd < r ? xcd * (q + 1) : r * (q + 1) + (xcd - r) * q) + off; }
        const int nig = WGM * nN, gid = wgid / nig, fm = gid * WGM, gsz = (nM - fm) < WGM ? (nM - fm) : WGM;
        u.pm = fm + ((wgid % nig) % gsz); u.pn = (wgid % nig) / gsz; return true;
    }
    __device__ __forceinline__ void a_ready(const Unit&) const {}
    __device__ __forceinline__ void done(const Unit&) const {}
};

__device__ __forceinline__ unsigned cvt_pk_bf16(float lo, float hi) { unsigned r; asm volatile("v_cvt_pk_bf16_f32 %0, %1, %2" : "=v"(r) : "v"(lo), "v"(hi)); return r; }
typedef float f32x2 __attribute__((ext_vector_type(2)));
template <class Epi, class Sched, bool ALIGN_EPI = false, bool SP2 = false>
__device__ __forceinline__ void gemm_phase(PG8_LAS unsigned char* lds, const Gemm g, const Sched& S, const Epi& E) {
    int tid_l = threadIdx.x; asm volatile("" : "+v"(tid_l));
    const int tid = tid_l, wid = __builtin_amdgcn_readfirstlane(tid >> 6), lane = tid & 63, wr = wid >> 2, wc = wid & 3, fr = lane & 15, fq = lane >> 4;
    const int K = g.K, nt = K / BK;
    unsigned voffA[2], voffB[2];
#pragma unroll
    for (int i = 0; i < 2; ++i) { int R, C; stage_rc(tid * 16 + i * 8192, R, C); const int Rb = Epi::PERM ? ((R & ~31) + perm32(R & 31)) : R;
        voffA[i] = (unsigned)(R * K + C) * 2u; voffB[i] = (unsigned)(Rb * K + C) * 2u; }
    const size_t kstep = (size_t)(BK * 2);
    const size_t hstep = (size_t)HALF * K * 2;
    const size_t tstep = 2 * hstep;
    const unsigned ldsw = (unsigned)wid * 1024u;
    const int aoff = lds_byte(wr * 64 + fr, fq * 8), boff = lds_byte(wc * 32 + fr, fq * 8);
#define PG8_SA(b, h) (((b) * 2 + (h)) * HTB)
#define PG8_SB(b, h) ((4 + (b) * 2 + (h)) * HTB)
#define PG8_STAGE(bufoff, gbase, voff) do { _Pragma("unroll") for (int _i = 0; _i < 2; ++_i) \
        __builtin_amdgcn_global_load_lds((const unsigned*)((const char*)(gbase) + (voff)[_i]), (PG8_LAS unsigned*)(lds + (bufoff) + ldsw + _i * 8192), 16, 0, 0); } while (0)
#define PG8_LDA(dst, b, h) do { _Pragma("unroll") for (int m = 0; m < 4; ++m) _Pragma("unroll") for (int k = 0; k < 2; ++k) dst[m][k] = *(const PG8_LAS bf16x8*)(lds + PG8_SA(b, h) + aoff + m * 2048 + k * 1024); } while (0)
#define PG8_LDB(dst, b, h) do { _Pragma("unroll") for (int n = 0; n < 2; ++n) _Pragma("unroll") for (int k = 0; k < 2; ++k) dst[n][k] = *(const PG8_LAS bf16x8*)(lds + PG8_SB(b, h) + boff + n * 2048 + k * 1024); } while (0)
#define PG8_MMA(ai, bj, At, Bt) do { __builtin_amdgcn_s_setprio(1); _Pragma("unroll") for (int m = 0; m < 4; ++m) _Pragma("unroll") for (int n = 0; n < 2; ++n) _Pragma("unroll") for (int k = 0; k < 2; ++k) \
        acc[ai][bj][m][n] = __builtin_amdgcn_mfma_f32_16x16x32_bf16(Bt[n][k], At[m][k], acc[ai][bj][m][n], 0, 0, 0); __builtin_amdgcn_s_setprio(0); } while (0)
#define PG8_WAIT_V(n) asm volatile("s_waitcnt vmcnt(" #n ")" ::: "memory")
#define PG8_WAIT_L(n) asm volatile("s_waitcnt lgkmcnt(" #n ")" ::: "memory")
#define PG8_BAR __builtin_amdgcn_s_barrier()
#define PG8_SCHED __builtin_amdgcn_sched_barrier(0)
    Unit cur, nxt; int ui = 0;
    if (!S.next(0, cur)) return;
    f32x4 acc[2][2][4][2];
#pragma unroll
    for (int a = 0; a < 2; ++a)
#pragma unroll
        for (int b = 0; b < 2; ++b)
#pragma unroll
            for (int m = 0; m < 4; ++m)
#pragma unroll
                for (int n = 0; n < 2; ++n) acc[a][b][m][n] = (f32x4){0.f, 0.f, 0.f, 0.f};
    bf16x8 At[4][2], B0[2][2], B1[2][2];
    const char* cA = (const char*)g.A + (size_t)cur.pm * tstep; const char* cB = (const char*)g.Bt + (size_t)cur.pn * tstep;
    S.a_ready(cur);
    if constexpr (SP2) {
        PG8_STAGE(PG8_SB(0, 0), cB, voffB); PG8_STAGE(PG8_SB(0, 1), cB + hstep, voffB); PG8_STAGE(PG8_SA(0, 0), cA, voffA); PG8_STAGE(PG8_SA(0, 1), cA + hstep, voffA);
        if (wr == 1) PG8_BAR;
        PG8_WAIT_V(2); PG8_BAR;
        PG8_STAGE(PG8_SB(1, 0), cB + kstep, voffB); PG8_STAGE(PG8_SA(1, 0), cA + kstep, voffA); PG8_STAGE(PG8_SB(1, 1), cB + hstep + kstep, voffB);
        PG8_WAIT_V(6); PG8_BAR;
    } else {
        PG8_STAGE(PG8_SB(0, 0), cB, voffB); PG8_STAGE(PG8_SA(0, 0), cA, voffA); PG8_STAGE(PG8_SB(0, 1), cB + hstep, voffB); PG8_STAGE(PG8_SA(0, 1), cA + hstep, voffA);
        if (wr == 1) PG8_BAR;
        PG8_WAIT_V(4); PG8_BAR;
        PG8_STAGE(PG8_SB(1, 0), cB + kstep, voffB); PG8_STAGE(PG8_SA(1, 0), cA + kstep, voffA); PG8_STAGE(PG8_SB(1, 1), cB + hstep + kstep, voffB);
        PG8_WAIT_V(6); PG8_BAR;
    }
    for (;;) {
        const bool has_next = S.next(ui + 1, nxt);
        const char* nA = has_next ? (const char*)g.A + (size_t)nxt.pm * tstep : cA; const char* nB = has_next ? (const char*)g.Bt + (size_t)nxt.pn * tstep : cB;
        for (int t = 0; t < nt; t += 2) {
            const bool last = (t == nt - 2);
            const char* a1 = cA + (size_t)(t + 1) * kstep;
            const char* a2 = last ? nA : cA + (size_t)(t + 2) * kstep; const char* b2 = last ? nB : cB + (size_t)(t + 2) * kstep;
            const char* a3 = a2 + kstep; const char* b3 = b2 + kstep;
            if (last && has_next) S.a_ready(nxt);
            if constexpr (SP2) {
            PG8_LDB(B0, 0, 0); PG8_LDB(B1, 0, 1); PG8_SCHED; PG8_LDA(At, 0, 0); PG8_STAGE(PG8_SA(1, 1), a1 + hstep, voffA);
            PG8_WAIT_V(8); PG8_WAIT_L(0); PG8_BAR; PG8_MMA(0, 0, At, B0); PG8_MMA(0, 1, At, B1); PG8_BAR; PG8_SCHED;
            PG8_LDA(At, 0, 1); PG8_STAGE(PG8_SB(0, 0), b2, voffB); PG8_STAGE(PG8_SB(0, 1), b2 + hstep, voffB); PG8_STAGE(PG8_SA(0, 0), a2, voffA);
            PG8_WAIT_V(8); PG8_WAIT_L(0); PG8_BAR; PG8_MMA(1, 0, At, B0); PG8_MMA(1, 1, At, B1); PG8_BAR; PG8_SCHED;
            PG8_LDB(B0, 1, 0); PG8_LDB(B1, 1, 1); PG8_SCHED; PG8_LDA(At, 1, 0); PG8_STAGE(PG8_SA(0, 1), a2 + hstep, voffA);
            PG8_WAIT_V(8); PG8_WAIT_L(0); PG8_BAR; PG8_MMA(0, 0, At, B0); PG8_MMA(0, 1, At, B1); PG8_BAR; PG8_SCHED;
            PG8_LDA(At, 1, 1); PG8_STAGE(PG8_SB(1, 0), b3, voffB); PG8_STAGE(PG8_SB(1, 1), b3 + hstep, voffB); PG8_STAGE(PG8_SA(1, 0), a3, voffA);
            PG8_WAIT_V(8); PG8_WAIT_L(0); PG8_BAR; PG8_MMA(1, 0, At, B0); PG8_MMA(1, 1, At, B1); PG8_BAR; PG8_SCHED;
            } else {
            PG8_LDB(B0, 0, 0); PG8_SCHED; PG8_LDA(At, 0, 0); PG8_STAGE(PG8_SA(1, 1), a1 + hstep, voffA);
            PG8_WAIT_L(8); PG8_BAR; PG8_WAIT_L(0); PG8_MMA(0, 0, At, B0); PG8_BAR; PG8_SCHED;
            PG8_LDB(B1, 0, 1); PG8_STAGE(PG8_SB(0, 0), b2, voffB);
            PG8_BAR; PG8_WAIT_L(0); PG8_MMA(0, 1, At, B1); PG8_BAR;
            PG8_LDA(At, 0, 1); PG8_STAGE(PG8_SA(0, 0), a2, voffA);
            PG8_BAR; PG8_WAIT_L(0); PG8_MMA(1, 0, At, B0); PG8_BAR; PG8_SCHED;
            PG8_STAGE(PG8_SB(0, 1), b2 + hstep, voffB);
            PG8_WAIT_V(6); PG8_BAR; PG8_MMA(1, 1, At, B1); PG8_BAR;
            PG8_LDB(B0, 1, 0); PG8_SCHED; PG8_LDA(At, 1, 0); PG8_STAGE(PG8_SA(0, 1), a2 + hstep, voffA);
            PG8_WAIT_L(8); PG8_BAR; PG8_WAIT_L(0); PG8_MMA(0, 0, At, B0); PG8_BAR; PG8_SCHED;
            PG8_LDB(B1, 1, 1); PG8_STAGE(PG8_SB(1, 0), b3, voffB);
            PG8_BAR; PG8_WAIT_L(0); PG8_MMA(0, 1, At, B1); PG8_BAR;
            PG8_LDA(At, 1, 1); PG8_STAGE(PG8_SA(1, 0), a3, voffA);
            PG8_BAR; PG8_WAIT_L(0); PG8_MMA(1, 0, At, B0); PG8_BAR; PG8_SCHED;
            PG8_STAGE(PG8_SB(1, 1), b3 + hstep, voffB);
            PG8_WAIT_V(6); PG8_BAR; PG8_MMA(1, 1, At, B1); PG8_BAR;
            }
        }
        if constexpr (ALIGN_EPI) { if (wr == 0) PG8_BAR; }
        if constexpr (!Epi::AFTER_DRAIN) { E(acc, cur, wr, wc, fr, fq); S.done(cur); }
        if (!has_next) break;
#pragma unroll
        for (int a = 0; a < 2; ++a)
#pragma unroll
            for (int b = 0; b < 2; ++b)
#pragma unroll
                for (int m = 0; m < 4; ++m)
#pragma unroll
                    for (int n = 0; n < 2; ++n) acc[a][b][m][n] = (f32x4){0.f, 0.f, 0.f, 0.f};
        cur = nxt; cA = nA; cB = nB; ++ui;
        if constexpr (ALIGN_EPI) { if (wr == 1) PG8_BAR; }
    }
    PG8_WAIT_V(0);
    if constexpr (!ALIGN_EPI) { if (wr == 0) PG8_BAR; }
    PG8_BAR;
    if constexpr (Epi::AFTER_DRAIN) { E.fused(acc, cur, wr, wc, fr, fq, lds, wid, lane); S.done(cur); }
#undef PG8_SA
#undef PG8_SB
#undef PG8_STAGE
#undef PG8_LDA
#undef PG8_LDB
#undef PG8_MMA
#undef PG8_WAIT_V
#undef PG8_WAIT_L
#undef PG8_BAR
#undef PG8_SCHED
}
}

constexpr int NWAVES = 8;
constexpr int DM = 2048, DFF = 5632, NBATCH = 8, SEQ = 2048, NMETA = 16, TP = SEQ + NMETA;
constexpr int DECB = 128, DECS = 4, MPR = NBATCH * TP  , MSM = DECB * DECS  , MREAL = MPR + MSM  , MP = 17152  ;
constexpr int AH = 4, ADK = 256, ADV = 512, NAIN = 6144, NAIN_PAD = 6400;
constexpr int BH = 32, BDH = 64, BKV = 4, WIN = 128;
constexpr float EPS = 1e-6f;

constexpr size_t MiB = 1u << 20;
constexpr size_t WS_CTL = 0, CTL_ZERO_BYTES = 1 * MiB;
constexpr size_t SZ_W1 = (size_t)2 * DFF * DM * 2, SZ_W2 = (size_t)DM * DFF * 2;
constexpr size_t WS_W1 = 1 * MiB;
constexpr size_t WS_W2 = WS_W1 + 4 * SZ_W1;
constexpr size_t WS_WAIN = WS_W2 + 4 * SZ_W2;
constexpr size_t WS_WAOUT = WS_WAIN + (size_t)NAIN_PAD * DM * 2;
constexpr size_t WS_WKV = WS_WAOUT + (size_t)DM * DM * 2;
constexpr size_t WS_WQ = WS_WKV + (size_t)512 * DM * 2;
constexpr size_t WS_WBO = WS_WQ + (size_t)DM * DM * 2;
constexpr size_t WS_H = WS_WBO + (size_t)DM * DM * 2;
constexpr size_t WS_AB = WS_H + (size_t)MP * DM * 4;
constexpr size_t WS_ACT = WS_AB + (size_t)MP * DM * 2;
constexpr size_t WS_HM = WS_ACT + (size_t)MP * NAIN * 2;
constexpr size_t WS_AM = WS_HM + (size_t)MP * DM * 4;
constexpr size_t WS_QB = WS_AM + (size_t)MP * DM * 2;
constexpr size_t WS_KB = WS_QB + (size_t)MP * DM * 2;
constexpr size_t WS_VB = WS_KB + (size_t)MP * 256 * 2;
constexpr size_t WS_SSQ = WS_VB + (size_t)MP * 256 * 2;
constexpr size_t WS_HSSQ = WS_SSQ + (size_t)MP * 32 * 4;
constexpr size_t WS_GATES = WS_HSSQ + (size_t)MP * 32 * 4;
constexpr size_t WS_END = WS_GATES + (size_t)MP * 8 * 4;
constexpr int CW_BAR = 4096;

constexpr size_t O_YP = 0, O_YS = O_YP + (size_t)NBATCH * SEQ * DM, O_CP = O_YS + (size_t)MSM * DM, O_NP = O_CP + (size_t)NBATCH * AH * ADK * ADV,
                 O_MP = O_NP + NBATCH * AH * ADK, O_KMP = O_MP + NBATCH * AH, O_VMP = O_KMP + NBATCH * NMETA * 256, O_KWP = O_VMP + NBATCH * NMETA * 256,
                 O_VWP = O_KWP + NBATCH * WIN * 256, O_CS = O_VWP + NBATCH * WIN * 256, O_NS = O_CS + (size_t)DECB * AH * ADK * ADV, O_MS = O_NS + DECB * AH * ADK,
                 O_KWS = O_MS + DECB * AH, O_VWS = O_KWS + (size_t)DECB * WIN * 256, O_END = O_VWS + (size_t)DECB * WIN * 256;

constexpr int SCR_BYTES = 143360;
constexpr int MISC_OFF = SCR_BYTES;
constexpr int LDS_BYTES = 147456;

#define GAS __attribute__((address_space(1)))
#define LAS __attribute__((address_space(3)))
typedef unsigned short bf16;
typedef unsigned v4u __attribute__((ext_vector_type(4)));
typedef unsigned v2u __attribute__((ext_vector_type(2)));
typedef float f32x4 __attribute__((ext_vector_type(4)));
typedef short bf16x8 __attribute__((ext_vector_type(8)));
#define LDS_WAIT() asm volatile("s_waitcnt lgkmcnt(0)" ::: "memory")
#define MFMA16(a, b, c) __builtin_amdgcn_mfma_f32_16x16x32_bf16((a), (b), (c), 0, 0, 0)
__device__ __forceinline__ unsigned pk2(float lo, float hi) { return pg8::cvt_pk_bf16(lo, hi); }
__device__ __forceinline__ float bflo(unsigned w) { return __uint_as_float(w << 16); }
__device__ __forceinline__ float bfhi(unsigned w) { return __uint_as_float(w & 0xffff0000u); }
__device__ __forceinline__ unsigned bfel(const v4u& r, int e) { return (r[e >> 1] >> (16 * (e & 1))) & 0xffffu; }
__device__ __forceinline__ float wave_sum(float v) {
#pragma unroll
    for (int o = 1; o < 64; o <<= 1) v += __shfl_xor(v, o);
    return v;
}
#define XB_TMO      128
#define XB_XCNT(j)  (256  + 64 * (j))
#define XB_XSUB(j)  (1280 + 64 * (j))
#define XB_XGEN(j)  (2304 + 64 * (j))
#define XB_TOP      3328
#define XB_TOPGEN   3392
#define XCD_BAR_WORDS 3456
#define XB_SPIN_CAP (1u << 18)

__device__ __forceinline__ unsigned xb_ld(unsigned* p)              { return __hip_atomic_load(p, __ATOMIC_RELAXED, __HIP_MEMORY_SCOPE_AGENT); }
__device__ __forceinline__ unsigned xb_add(unsigned* p, unsigned v) { return __hip_atomic_fetch_add(p, v, __ATOMIC_RELAXED, __HIP_MEMORY_SCOPE_AGENT); }
__device__ __forceinline__ unsigned xb_xcc_id() { return (unsigned)__builtin_amdgcn_s_getreg((3 << 11) | 20) & 0xFu; }
#define XB_SPIN(cond, bar) do { unsigned _sp = 0; while (cond) { __builtin_amdgcn_s_sleep(1); \
    if ((++_sp & 255u) == 0u) { if (xb_ld(&(bar)[XB_TMO])) break; if (_sp > XB_SPIN_CAP) { atomicAdd(&(bar)[XB_TMO], 1u); break; } } } } while (0)

struct XcdBarrier {
    unsigned* bar; unsigned x;
    volatile LAS unsigned* st;
};

__device__ __forceinline__ XcdBarrier xcd_barrier_post(unsigned* bar, volatile LAS unsigned* st) {
    XcdBarrier b; b.bar = bar; b.x = xb_xcc_id(); b.st = st;
    if (threadIdx.x == 0) (void)xb_add(&bar[XB_XCNT(b.x)], 1u);
    return b;
}
__device__ __forceinline__ void xcd_barrier_complete(unsigned* bar, unsigned x, unsigned& nloc, unsigned& nx) {
    const unsigned G = gridDim.x * gridDim.y * gridDim.z;
    unsigned sum, cnt, mine, sp = 0u;
    for (;;) {
        sum = 0u; cnt = 0u; mine = 0u;
#pragma unroll
        for (unsigned j = 0; j < 16; ++j) { const unsigned c = xb_ld(&bar[XB_XCNT(j)]); sum += c; cnt += (c > 0u) ? 1u : 0u; mine = (j == x) ? c : mine; }
        if (sum == G) break;
        __builtin_amdgcn_s_sleep(1);
        if ((++sp & 255u) == 0u) { if (xb_ld(&bar[XB_TMO])) break; if (sp > XB_SPIN_CAP) { atomicAdd(&bar[XB_TMO], 1u); break; } }
    }
    nloc = mine > 0u ? mine : 1u; nx = cnt > 0u ? cnt : 1u;
}

__device__ __forceinline__ void xcd_barrier(const XcdBarrier& b) {
    asm volatile("s_waitcnt vmcnt(0)" ::: "memory");
    __syncthreads();
    if (threadIdx.x == 0) {
        unsigned* bar = b.bar;
        __builtin_amdgcn_s_waitcnt(0);
        unsigned nloc = b.st[0], nx = b.st[1];
        if (nloc == 0u) { xcd_barrier_complete(bar, b.x, nloc, nx); b.st[0] = nloc; b.st[1] = nx; }
        const unsigned old = xb_add(&bar[XB_XSUB(b.x)], 1u);
        const unsigned gen = old / nloc;
        if (old + 1u == (gen + 1u) * nloc) {
            __builtin_amdgcn_fence(__ATOMIC_RELEASE, "agent");
            asm volatile("s_waitcnt vmcnt(0)" ::: "memory");
            const unsigned og = xb_add(&bar[XB_TOP], 1u);
            const unsigned tg = og / nx;
            if (og + 1u == (tg + 1u) * nx) xb_add(&bar[XB_TOPGEN], 1u);
            else XB_SPIN(xb_ld(&bar[XB_TOPGEN]) == tg, bar);
            __builtin_amdgcn_fence(__ATOMIC_ACQUIRE, "agent");
            xb_add(&bar[XB_XGEN(b.x)], 1u);
            asm volatile("s_waitcnt vmcnt(0)" ::: "memory");
        } else {
            XB_SPIN(xb_ld(&bar[XB_XGEN(b.x)]) == gen, bar);
            __builtin_amdgcn_fence(__ATOMIC_ACQUIRE, "agent");
            asm volatile("s_waitcnt vmcnt(0)" ::: "memory");
        }
    }
    __syncthreads();
}

__device__ __forceinline__ float row_rscale(const float* ssq, int row, int fq) {
    const f32x4* p = (const f32x4*)(ssq + (size_t)row * 32 + 8 * fq);
    const f32x4 a = p[0], b = p[1];
    float s = ((a.x + a.y) + (a.z + a.w)) + ((b.x + b.y) + (b.z + b.w));
    s += __shfl_xor(s, 16); s += __shfl_xor(s, 32);
    return rsqrtf(s * (1.0f / DM) + EPS);
}
__device__ __forceinline__ float silu_f(float g) { return g * __builtin_amdgcn_rcpf(1.0f + __expf(-g)); }

struct EpiSwiglu {
    static constexpr bool PERM = true, AFTER_DRAIN = false;
    bf16* O; const float* ssq;
    __device__ __forceinline__ void operator()(const f32x4 (&acc)[2][2][4][2], const pg8::Unit& u, int wr, int wc, int fr, int fq) const {
        const int row0 = u.pm * 256 + wr * 64 + fr, col0 = u.pn * 128 + wc * 32 + 8 * fq;
#pragma unroll
        for (int ai = 0; ai < 2; ++ai)
#pragma unroll
            for (int m = 0; m < 4; ++m) {
                const int row = row0 + ai * 128 + m * 16;
                const float r = row_rscale(ssq, row, fq);
                float o[8];
#pragma unroll
                for (int n = 0; n < 2; ++n)
#pragma unroll
                    for (int j = 0; j < 4; ++j) o[4 * n + j] = silu_f(acc[ai][0][m][n][j] * r) * (acc[ai][1][m][n][j] * r);
                v4u w; w.x = pk2(o[0], o[1]); w.y = pk2(o[2], o[3]); w.z = pk2(o[4], o[5]); w.w = pk2(o[6], o[7]);
                *(v4u*)(O + (size_t)row * DFF + col0) = w;
            }
    }
};
template <bool FINAL> struct EpiResid {
    static constexpr bool PERM = true, AFTER_DRAIN = false;
    float* H; bf16* AB; float* ssq; float sc; float* out;
    __device__ __forceinline__ void operator()(const f32x4 (&acc)[2][2][4][2], const pg8::Unit& u, int wr, int wc, int fr, int fq) const {
        const int row0 = u.pm * 256 + wr * 64 + fr, col0 = u.pn * 256 + wc * 32 + 8 * fq;
#pragma unroll
        for (int ai = 0; ai < 2; ++ai)
#pragma unroll
            for (int m = 0; m < 4; ++m) {
                const int row = row0 + ai * 128 + m * 16;
                const float* hp = H + (size_t)row * DM + col0;
                float ss = 0.f;
                float* op = nullptr;
                if (FINAL) {
                    if (row < MPR) { const int b = row / TP, t = row - b * TP; if (t >= NMETA) op = out + O_YP + ((size_t)b * SEQ + (t - NMETA)) * DM + col0; }
                    else if (row < MREAL) op = out + O_YS + (size_t)(row - MPR) * DM + col0;
                }
#pragma unroll
                for (int bj = 0; bj < 2; ++bj) {
                    const f32x4 h0 = *(const f32x4*)(hp + bj * 128), h1 = *(const f32x4*)(hp + bj * 128 + 4);
                    const f32x4 n0 = h0 + acc[ai][bj][m][0] * sc, n1 = h1 + acc[ai][bj][m][1] * sc;
                    if (FINAL) { if (op) { *(f32x4*)(op + bj * 128) = n0; *(f32x4*)(op + bj * 128 + 4) = n1; } }
                    else {
                        *(f32x4*)(H + (size_t)row * DM + col0 + bj * 128) = n0; *(f32x4*)(H + (size_t)row * DM + col0 + bj * 128 + 4) = n1;
                        v4u w; w.x = pk2(n0[0], n0[1]); w.y = pk2(n0[2], n0[3]); w.z = pk2(n1[0], n1[1]); w.w = pk2(n1[2], n1[3]);
                        *(v4u*)(AB + (size_t)row * DM + col0 + bj * 128) = w;
                        ss += (n0[0] * n0[0] + n0[1] * n0[1]) + (n0[2] * n0[2] + n0[3] * n0[3]) + (n1[0] * n1[0] + n1[1] * n1[1]) + (n1[2] * n1[2] + n1[3] * n1[3]);
                    }
                }
                if (!FINAL) { ss += __shfl_xor(ss, 16); ss += __shfl_xor(ss, 32); if (fq == 0) ssq[(size_t)row * 32 + u.pn * 4 + wc] = ss; }
            }
    }
};
struct EpiQkvo {
    static constexpr bool PERM = true, AFTER_DRAIN = false;
    bf16* O; const float* ssq; float* gates; const float* bias;
    __device__ __forceinline__ void operator()(const f32x4 (&acc)[2][2][4][2], const pg8::Unit& u, int wr, int wc, int fr, int fq) const {
        const int row0 = u.pm * 256 + wr * 64 + fr, col0 = u.pn * 256 + wc * 32 + 8 * fq;
        const bool gate_tile = (u.pn == NAIN / 256);
        f32x4 bi = (f32x4){0.f, 0.f, 0.f, 0.f}, bf = bi;
        if (gate_tile) { bi = *(const f32x4*)bias; bf = *(const f32x4*)(bias + 4); }
#pragma unroll
        for (int ai = 0; ai < 2; ++ai)
#pragma unroll
            for (int m = 0; m < 4; ++m) {
                const int row = row0 + ai * 128 + m * 16;
                const float r = row_rscale(ssq, row, fq);
                if (!gate_tile) {
#pragma unroll
                    for (int bj = 0; bj < 2; ++bj) { const f32x4 v0 = acc[ai][bj][m][0] * r, v1 = acc[ai][bj][m][1] * r;
                        v4u w; w.x = pk2(v0[0], v0[1]); w.y = pk2(v0[2], v0[3]); w.z = pk2(v1[0], v1[1]); w.w = pk2(v1[2], v1[3]);
                        *(v4u*)(O + (size_t)row * NAIN + col0 + bj * 128) = w; }
                } else if (wc == 0 && fq == 0) {
                    const f32x4 xi = acc[ai][0][m][0] * r + bi, xf = acc[ai][0][m][1] * r + bf;
                    f32x4 gi, gf;
#pragma unroll
                    for (int j = 0; j < 4; ++j) { gi[j] = 15.0f * tanhf(xi[j] * (1.0f / 15.0f)); const float c = 15.0f * tanhf(xf[j] * (1.0f / 15.0f));
                        gf[j] = fminf(c, 0.f) - log1pf(expf(-fabsf(c))); }
                    *(f32x4*)(gates + (size_t)row * 8) = gi; *(f32x4*)(gates + (size_t)row * 8 + 4) = gf;
                }
            }
    }
};
struct EpiHead {
    static constexpr bool PERM = true, AFTER_DRAIN = false;
    bf16* O0; int ld0; bf16* O1; int ld1; int norm_tiles; const float* ssq; const float* gain; float post;
    __device__ __forceinline__ void operator()(const f32x4 (&acc)[2][2][4][2], const pg8::Unit& u, int wr, int wc, int fr, int fq) const {
        const int row0 = u.pm * 256 + wr * 64 + fr;
        const bool normed = u.pn < norm_tiles;
        bf16* base = normed ? O0 + (size_t)u.pn * 256 : O1 + (size_t)(u.pn - norm_tiles) * 256;
        const int ld = normed ? ld0 : ld1;
        f32x4 gn[2][2];
#pragma unroll
        for (int bj = 0; bj < 2; ++bj)
#pragma unroll
            for (int n = 0; n < 2; ++n) gn[bj][n] = normed ? *(const f32x4*)(gain + 32 * bj + 8 * fq + 4 * n) * post : (f32x4){1.f, 1.f, 1.f, 1.f};
#pragma unroll
        for (int ai = 0; ai < 2; ++ai)
#pragma unroll
            for (int m = 0; m < 4; ++m) {
                const int row = row0 + ai * 128 + m * 16;
                const float r = row_rscale(ssq, row, fq);
                f32x4 x[2][2]; float ms = 0.f;
#pragma unroll
                for (int bj = 0; bj < 2; ++bj)
#pragma unroll
                    for (int n = 0; n < 2; ++n) { x[bj][n] = acc[ai][bj][m][n] * r; const f32x4 q = x[bj][n] * x[bj][n]; ms += (q[0] + q[1]) + (q[2] + q[3]); }
                ms += __shfl_xor(ms, 16); ms += __shfl_xor(ms, 32);
                const float inv = normed ? rsqrtf(ms * (1.0f / 64.0f) + EPS) : 1.0f;
#pragma unroll
                for (int bj = 0; bj < 2; ++bj) { const f32x4 v0 = x[bj][0] * inv * gn[bj][0], v1 = x[bj][1] * inv * gn[bj][1];
                    v4u w; w.x = pk2(v0[0], v0[1]); w.y = pk2(v0[2], v0[3]); w.z = pk2(v1[0], v1[1]); w.w = pk2(v1[2], v1[3]);
                    *(v4u*)(base + (size_t)row * ld + wc * 64 + 32 * bj + 8 * fq) = w; }
            }
    }
};

__device__ __forceinline__ void cvt_item(const float* W, int ldw, int col0, int nvalid, int K, const float* gain, float scale, bf16* dst, int drow0, int k0, LAS float* scr, int lane) {
    const int nl = lane & 31, kh = lane >> 5;
#pragma unroll 8
    for (int i = 0; i < 32; ++i) { const int kk = 2 * i + kh; float v = 0.f;
        if (nl < nvalid) { v = W[(size_t)(k0 + kk) * ldw + col0 + nl] * scale; if (gain) v *= gain[k0 + kk]; }
        scr[kk * 33 + nl] = v; }
    LDS_WAIT(); asm volatile("" ::: "memory");
    const int c = lane & 7;
#pragma unroll
    for (int j = 0; j < 4; ++j) { const int n = (lane >> 3) + 8 * j; const LAS float* s = scr + (8 * c) * 33 + n;
        v4u o; o.x = pk2(s[0 * 33], s[1 * 33]); o.y = pk2(s[2 * 33], s[3 * 33]); o.z = pk2(s[4 * 33], s[5 * 33]); o.w = pk2(s[6 * 33], s[7 * 33]);
        *(v4u*)(dst + (size_t)(drow0 + n) * K + k0 + 8 * c) = o; }
    LDS_WAIT(); asm volatile("" ::: "memory");
}
struct Args { const float* in[25]; float* out; unsigned char* ws; };
enum { I_XP = 0, I_XS, I_SC, I_SN, I_SM, I_CKM, I_CVM, I_CKW, I_CVW, I_META, I_FFNN, I_WFI, I_WFO, I_MIXN, I_WAI, I_BAG, I_AHN, I_WAO, I_KVN, I_WKV, I_KN, I_WQ, I_QN, I_SINK, I_WBO };

__device__ __forceinline__ void p0_prologue(const Args& a, LAS unsigned char* lds, int gw, int NGW, int wave, int lane) {
    LAS float* scr = (LAS float*)(lds + wave * 16384);
    unsigned char* ws = a.ws;
    constexpr int IT_W1 = (DM / 64) * (2 * DFF / 32), IT_W2 = (DFF / 64) * (DM / 32), IT_AIN = (DM / 64) * (NAIN_PAD / 32), IT_SQ = (DM / 64) * (DM / 32), IT_KV = (DM / 64) * (512 / 32);
    constexpr int NITEMS = 4 * IT_W1 + 4 * IT_W2 + IT_AIN + IT_SQ + IT_KV + IT_SQ + IT_SQ;
    for (int it = gw; it < NITEMS; it += NGW) {
        int r = it;
        if (r < 4 * IT_W1) {
            const int f = r / IT_W1; r -= f * IT_W1; const int nblk = 2 * DFF / 32, kb = r / nblk, nb = r % nblk, n0 = 32 * nb, tile = n0 >> 8, within = n0 & 255;
            const int col0 = within < 128 ? 128 * tile + within : DFF + 128 * tile + (within - 128);
            cvt_item(a.in[I_WFI] + (size_t)f * DM * 2 * DFF, 2 * DFF, col0, 32, DM, a.in[I_FFNN] + f * DM, 1.0f, (bf16*)(ws + WS_W1 + f * SZ_W1), n0, 64 * kb, scr, lane); continue; }
        r -= 4 * IT_W1;
        if (r < 4 * IT_W2) {
            const int f = r / IT_W2; r -= f * IT_W2; const int nblk = DM / 32, kb = r / nblk, nb = r % nblk;
            cvt_item(a.in[I_WFO] + (size_t)f * DFF * DM, DM, 32 * nb, 32, DFF, nullptr, 1.0f, (bf16*)(ws + WS_W2 + f * SZ_W2), 32 * nb, 64 * kb, scr, lane); continue; }
        r -= 4 * IT_W2;
        if (r < IT_AIN) {
            const int nblk = NAIN_PAD / 32, kb = r / nblk, nb = r % nblk, n0 = 32 * nb;
            const int nvalid = n0 < NAIN ? 32 : (n0 == NAIN ? 8 : 0); const float sc = (n0 >= 1024 && n0 < 2048) ? 0.0625f : 1.0f;
            cvt_item(a.in[I_WAI], NAIN + 8, n0 < NAIN ? n0 : NAIN, nvalid, DM, a.in[I_MIXN], sc, (bf16*)(ws + WS_WAIN), n0, 64 * kb, scr, lane); continue; }
        r -= IT_AIN;
        if (r < IT_SQ) { const int nblk = DM / 32, kb = r / nblk, nb = r % nblk;
            cvt_item(a.in[I_WAO], DM, 32 * nb, 32, DM, nullptr, 1.0f, (bf16*)(ws + WS_WAOUT), 32 * nb, 64 * kb, scr, lane); continue; }
        r -= IT_SQ;
        if (r < IT_KV) { const int nblk = 512 / 32, kb = r / nblk, nb = r % nblk, n0 = 32 * nb, tile = n0 >> 8, within = n0 & 255, bj = within >> 7, wc = (within >> 5) & 3;
            cvt_item(a.in[I_WKV], 512, 256 * tile + 64 * wc + 32 * bj, 32, DM, a.in[I_KVN], 1.0f, (bf16*)(ws + WS_WKV), n0, 64 * kb, scr, lane); continue; }
        r -= IT_KV;
        if (r < IT_SQ) { const int nblk = DM / 32, kb = r / nblk, nb = r % nblk, n0 = 32 * nb, tile = n0 >> 8, within = n0 & 255, bj = within >> 7, wc = (within >> 5) & 3;
            cvt_item(a.in[I_WQ], DM, 256 * tile + 64 * wc + 32 * bj, 32, DM, a.in[I_MIXN] + DM, 1.0f, (bf16*)(ws + WS_WQ), n0, 64 * kb, scr, lane); continue; }
        r -= IT_SQ;
        { const int nblk = DM / 32, kb = r / nblk, nb = r % nblk;
          cvt_item(a.in[I_WBO], DM, 32 * nb, 32, DM, nullptr, 1.0f, (bf16*)(ws + WS_WBO), 32 * nb, 64 * kb, scr, lane); }
    }
    float* H = (float*)(ws + WS_H); bf16* AB = (bf16*)(ws + WS_AB); float* SSQ = (float*)(ws + WS_SSQ);
    for (int row = gw; row < MP; row += NGW) {
        const float* src = nullptr;
        if (row < MPR) { const int b = row / TP, t = row - b * TP; src = t < NMETA ? a.in[I_META] + (size_t)t * DM : a.in[I_XP] + ((size_t)b * SEQ + (t - NMETA)) * DM; }
        else if (row < MREAL) src = a.in[I_XS] + (size_t)(row - MPR) * DM;
        float ss = 0.f;
#pragma unroll
        for (int j = 0; j < 4; ++j) {
            f32x4 v0 = (f32x4){0.f, 0.f, 0.f, 0.f}, v1 = v0;
            if (src) { v0 = *(const f32x4*)(src + 512 * j + 8 * lane); v1 = *(const f32x4*)(src + 512 * j + 8 * lane + 4); }
            *(f32x4*)(H + (size_t)row * DM + 512 * j + 8 * lane) = v0; *(f32x4*)(H + (size_t)row * DM + 512 * j + 8 * lane + 4) = v1;
            v4u w; w.x = pk2(v0[0], v0[1]); w.y = pk2(v0[2], v0[3]); w.z = pk2(v1[0], v1[1]); w.w = pk2(v1[2], v1[3]);
            *(v4u*)(AB + (size_t)row * DM + 512 * j + 8 * lane) = w;
            ss += (v0[0] * v0[0] + v0[1] * v0[1]) + (v0[2] * v0[2] + v0[3] * v0[3]) + (v1[0] * v1[0] + v1[1] * v1[1]) + (v1[2] * v1[2] + v1[3] * v1[3]);
        }
        ss = wave_sum(ss);
        if (lane < 32) SSQ[(size_t)row * 32 + lane] = lane == 0 ? ss : 0.f;
    }
}

constexpr int ML_KN = 0, ML_KNS = 272, ML_KT = 34816, ML_KTS = 272, ML_VT = 69632, ML_VTS = 272, ML_CTB = ML_VT + 80 * 272  , ML_CTBS = 528, ML_GA = ML_CTB + 80 * 528  ;
static_assert(ML_GA + 2816 <= SCR_BYTES, "mLSTM LDS map");

#define ML_HALF(DH) do { \
    _Pragma("unroll") for (int jb = 0; jb < 8; ++jb) _Pragma("unroll") for (int ks = 0; ks < 4; ++ks) { \
        const bf16x8 af = *(const LAS bf16x8*)(lds + ML_KN + (16 * jb + i16) * ML_KNS + (32 * ks + 8 * g) * 2); as_[jb] = MFMA16(af, qf[4 * (DH) + ks], as_[jb]); } \
    _Pragma("unroll") for (int vb = 0; vb < 5; ++vb) accC[DH][vb] = accC[DH][vb] * decay; \
    _Pragma("unroll") for (int ks = 0; ks < 4; ++ks) { \
        const bf16x8 bfr = *(const LAS bf16x8*)(lds + ML_KT + (16 * wave + i16) * ML_KTS + (32 * ks + 8 * g) * 2); \
        _Pragma("unroll") for (int vb = 0; vb < 5; ++vb) { const bf16x8 afr = *(const LAS bf16x8*)(lds + ML_VT + (16 * vb + i16) * ML_VTS + (32 * ks + 8 * g) * 2); accC[DH][vb] = MFMA16(afr, bfr, accC[DH][vb]); } } \
} while (0)
#define ML_PUT_CTB(DH) do { _Pragma("unroll") for (int vb = 0; vb < 5; ++vb) _Pragma("unroll") for (int r = 0; r < 4; ++r) \
    *(LAS bf16*)(lds + ML_CTB + (16 * vb + 4 * g + r) * ML_CTBS + (128 * (DH) + 16 * wave + i16) * 2) = (bf16)(pk2(accC[DH][vb][r], 0.f) & 0xffffu); } while (0)
#define ML_LOAD_K(DH) do { _Pragma("unroll") for (int it = 0; it < 2; ++it) { const int dc = wave + 8 * it; \
    const bf16* kp = QKVO + (rowbase + 2 * lane) * NAIN + 1024 + h * ADK + 128 * (DH) + 8 * dc; \
    const v4u r0 = *(const v4u*)kp, r1 = *(const v4u*)(kp + NAIN); \
    *(LAS v4u*)(lds + ML_KN + (2 * lane) * ML_KNS + 16 * dc) = r0; *(LAS v4u*)(lds + ML_KN + (2 * lane + 1) * ML_KNS + 16 * dc) = r1; \
    const float w0 = ga[512 + 2 * lane], w1 = ga[512 + 2 * lane + 1]; \
    _Pragma("unroll") for (int e = 0; e < 8; ++e) *(LAS unsigned*)(lds + ML_KT + (8 * dc + e) * ML_KTS + 4 * lane) = pk2(__uint_as_float(bfel(r0, e) << 16) * w0, __uint_as_float(bfel(r1, e) << 16) * w1); } } while (0)

__device__ __forceinline__ void mlstm_prompt_unit(LAS unsigned char* lds, const bf16* QKVO, const float* GATES, float* HM, float* HSSQ, float* out, int b, int h, int j, int tid, int wave, int lane) {
    const int i16 = lane & 15, g = lane >> 4;
    LAS float* ga = (LAS float*)(lds + ML_GA);
    f32x4 accC[2][5];
#pragma unroll
    for (int dh = 0; dh < 2; ++dh)
#pragma unroll
        for (int vb = 0; vb < 5; ++vb) accC[dh][vb] = (f32x4){0.f, 0.f, 0.f, 0.f};
    __syncthreads();
    for (int o = tid * 16; o < 80 * ML_CTBS; o += 512 * 16) *(LAS v4u*)(lds + ML_CTB + o) = (v4u){0u, 0u, 0u, 0u};
    for (int o = tid; o < 16 * 64; o += 512) { const int rr = o >> 6, cc = o & 63; *(LAS unsigned*)(lds + ML_VT + (64 + rr) * ML_VTS + cc * 4) = rr == 0 ? 0x3F803F80u : 0u; }
    float m_prev = 0.f;
    for (int c = 0; c < 17; ++c) {
        const int tok0 = c == 0 ? 0 : NMETA + 128 * (c - 1), nvalid = c == 0 ? NMETA : 128;
        const size_t rowbase = (size_t)b * TP + tok0;
        __syncthreads();
        bf16x8 qf[8];
        { const bf16* qp = QKVO + (rowbase + 16 * wave + i16) * NAIN + h * ADK + 8 * g;
#pragma unroll
          for (int ks = 0; ks < 8; ++ks) qf[ks] = *(const bf16x8*)(qp + 32 * ks); }
        if (wave == 0) {
            const int t0 = 2 * lane, t1 = t0 + 1;
            float ig0 = -1e30f, ig1 = -1e30f, lf0 = 0.f, lf1 = 0.f;
            if (t0 < nvalid) { const float* gp = GATES + (rowbase + t0) * 8; ig0 = gp[h]; lf0 = gp[4 + h]; }
            if (t1 < nvalid) { const float* gp = GATES + (rowbase + t1) * 8; ig1 = gp[h]; lf1 = gp[4 + h]; }
            const float c1 = lf0 + lf1; float sc = c1;
#pragma unroll
            for (int o = 1; o < 64; o <<= 1) { const float t = __shfl_up(sc, o); if (lane >= o) sc += t; }
            const float excl = sc - c1, b0 = excl + lf0, b1 = excl + c1;
            const float a0 = ig0 - b0, a1 = ig1 - b1;
            float smx = fmaxf(a0, a1);
#pragma unroll
            for (int o = 1; o < 64; o <<= 1) { const float t = __shfl_up(smx, o); if (lane >= o) smx = fmaxf(smx, t); }
            float exm = __shfl_up(smx, 1); if (lane == 0) exm = -INFINITY;
            const float p0 = fmaxf(exm, a0), p1 = fmaxf(p0, a1);
            const float pm0 = fmaxf(m_prev, p0), pm1 = fmaxf(m_prev, p1);
            const float Mx = fmaxf(m_prev, __shfl(smx, 63)), blast = __shfl(b1, 63);
            ga[t0] = a0; ga[t1] = a1; ga[128 + t0] = pm0; ga[128 + t1] = pm1;
            ga[256 + t0] = __expf(m_prev - pm0); ga[256 + t1] = __expf(m_prev - pm1);
            ga[384 + t0] = __expf(-(b0 + pm0)); ga[384 + t1] = __expf(-(b1 + pm1));
            ga[512 + t0] = __expf(a0 - Mx); ga[512 + t1] = __expf(a1 - Mx);
            if (lane == 0) ga[640] = __expf(m_prev - Mx);
            m_prev = blast + Mx;
        }
        __syncthreads();
        {
            const bf16* vp = QKVO + (rowbase + 2 * lane) * NAIN + 2048 + h * ADV + 64 * j + 8 * wave;
            const v4u r0 = *(const v4u*)vp, r1 = *(const v4u*)(vp + NAIN);
#pragma unroll
            for (int e = 0; e < 8; ++e) *(LAS unsigned*)(lds + ML_VT + (8 * wave + e) * ML_VTS + 4 * lane) = bfel(r0, e) | (bfel(r1, e) << 16);
        }
        ML_LOAD_K(0);
        __syncthreads();
        const float decay = ga[640];
        f32x4 aqc[5], as_[8];
#pragma unroll
        for (int vb = 0; vb < 5; ++vb) { aqc[vb] = (f32x4){0.f, 0.f, 0.f, 0.f};
#pragma unroll
            for (int ks = 0; ks < 8; ++ks) { const bf16x8 bfr = *(const LAS bf16x8*)(lds + ML_CTB + (16 * vb + i16) * ML_CTBS + (32 * ks + 8 * g) * 2); aqc[vb] = MFMA16(qf[ks], bfr, aqc[vb]); } }
#pragma unroll
        for (int jb = 0; jb < 8; ++jb) as_[jb] = (f32x4){0.f, 0.f, 0.f, 0.f};
        ML_HALF(0);
        __syncthreads();
        ML_PUT_CTB(0);
        ML_LOAD_K(1);
        __syncthreads();
        ML_HALF(1);
        ML_PUT_CTB(1);
        const int tl = 16 * wave + i16; const float pmt = ga[128 + tl];
        bf16x8 pf[4];
#pragma unroll
        for (int kk = 0; kk < 4; ++kk) { float pv[8];
#pragma unroll
            for (int hb = 0; hb < 2; ++hb) { const int jb = 2 * kk + hb; const f32x4 av = *(const LAS f32x4*)(ga + 16 * jb + 4 * g);
#pragma unroll
                for (int r = 0; r < 4; ++r) { const int s = 16 * jb + 4 * g + r; const float wgt = (s <= tl) ? __expf(av[r] - pmt) : 0.f; pv[4 * hb + r] = as_[jb][r] * wgt; } }
            v4u w; w.x = pk2(pv[0], pv[1]); w.y = pk2(pv[2], pv[3]); w.z = pk2(pv[4], pv[5]); w.w = pk2(pv[6], pv[7]); pf[kk] = __builtin_bit_cast(bf16x8, w); }
        f32x4 apv[5];
#pragma unroll
        for (int vb = 0; vb < 5; ++vb) { apv[vb] = (f32x4){0.f, 0.f, 0.f, 0.f};
#pragma unroll
            for (int kk = 0; kk < 4; ++kk) { const LAS unsigned char* vp = lds + ML_VT + (16 * vb + i16) * ML_VTS + (32 * kk + 4 * g) * 2;
                const v2u lo = *(const LAS v2u*)vp, hi = *(const LAS v2u*)(vp + 32); const v4u w = (v4u){lo.x, lo.y, hi.x, hi.y};
                apv[vb] = MFMA16(pf[kk], __builtin_bit_cast(bf16x8, w), apv[vb]); } }
        const f32x4 wi4 = *(const LAS f32x4*)(ga + 256 + 16 * wave + 4 * g), ef4 = *(const LAS f32x4*)(ga + 384 + 16 * wave + 4 * g);
#pragma unroll
        for (int r = 0; r < 4; ++r) { const int tr = 16 * wave + 4 * g + r; const float wi = wi4[r];
            float den = apv[4][r] + wi * aqc[4][r]; den = __shfl(den, lane & 48); den = fmaxf(fabsf(den), ef4[r]);
            const float inv = 1.0f / den; float ss = 0.f; const bool ok = tr < nvalid;
#pragma unroll
            for (int vb = 0; vb < 4; ++vb) { const float hv = (apv[vb][r] + wi * aqc[vb][r]) * inv; ss += hv * hv;
                if (ok) HM[(rowbase + tr) * DM + h * ADV + 64 * j + 16 * vb + i16] = hv; }
            ss += __shfl_xor(ss, 1); ss += __shfl_xor(ss, 2); ss += __shfl_xor(ss, 4); ss += __shfl_xor(ss, 8);
            if (ok && i16 == 0) HSSQ[(rowbase + tr) * 32 + h * 8 + j] = ss; }
    }
    const size_t bh = (size_t)b * AH + h;
#pragma unroll
    for (int dh = 0; dh < 2; ++dh) { const int d = 128 * dh + 16 * wave + i16;
#pragma unroll
        for (int vb = 0; vb < 4; ++vb) *(f32x4*)(out + O_CP + (bh * ADK + d) * ADV + 64 * j + 16 * vb + 4 * g) = accC[dh][vb];
        if (j == 0 && g == 0) out[O_NP + bh * ADK + d] = accC[dh][4][0]; }
    if (j == 0 && tid == 0) out[O_MP + bh] = m_prev;
}

__device__ __forceinline__ void mlstm_sample_unit(LAS unsigned char* lds, const bf16* QKVO, const float* GATES, const float* stC, const float* stN, const float* stM,
                                                  float* HM, float* HSSQ, float* out, int b, int h, int tid, int wave, int lane) {
    LAS float* qT = (LAS float*)lds;
    LAS float* wkT = (LAS float*)(lds + 4096);
    LAS float* qN = (LAS float*)(lds + 8192);
    LAS float* kN = (LAS float*)(lds + 12288);
    LAS float* dots = (LAS float*)(lds + 16384);
    LAS float* red = (LAS float*)(lds + 16640);
    const int row0 = MPR + DECS * b; const size_t bh = (size_t)b * AH + h;
    float ig[4], bb[4], a_[4], pm[4], wint[4], efl[4], wst[4];
    const float mprev = stM[bh];
    { float run = 0.f, pmax = -INFINITY;
#pragma unroll
      for (int s = 0; s < 4; ++s) { ig[s] = GATES[(size_t)(row0 + s) * 8 + h]; run += GATES[(size_t)(row0 + s) * 8 + 4 + h]; bb[s] = run; a_[s] = ig[s] - bb[s]; pmax = fmaxf(pmax, a_[s]);
          pm[s] = fmaxf(mprev, pmax); wint[s] = __expf(mprev - pm[s]); efl[s] = __expf(-(bb[s] + pm[s])); } }
    const float Mx = pm[3], decay = __expf(mprev - Mx), mnew = bb[3] + Mx;
#pragma unroll
    for (int s = 0; s < 4; ++s) wst[s] = __expf(a_[s] - Mx);
    __syncthreads();
    { const int s = tid >> 7, d2 = (tid & 127) * 2; const bf16* qp = QKVO + (size_t)(row0 + s) * NAIN + h * ADK + d2;
      const unsigned qq = *(const unsigned*)qp, kk = *(const unsigned*)(qp + 1024);
      const float q0 = bflo(qq), q1 = bfhi(qq), k0 = bflo(kk), k1 = bfhi(kk);
      const float w = s == 0 ? wst[0] : s == 1 ? wst[1] : s == 2 ? wst[2] : wst[3];
      qT[d2 * 4 + s] = q0; qT[(d2 + 1) * 4 + s] = q1; wkT[d2 * 4 + s] = w * k0; wkT[(d2 + 1) * 4 + s] = w * k1;
      qN[s * 256 + d2] = q0; qN[s * 256 + d2 + 1] = q1; kN[s * 256 + d2] = k0; kN[s * 256 + d2 + 1] = k1; }
    __syncthreads();
    for (int x = wave; x < 20; x += 8) { float p = 0.f;
        if (x < 16) { const int t = x >> 2, s = x & 3;
#pragma unroll
            for (int i = 0; i < 4; ++i) p += qN[t * 256 + lane + 64 * i] * kN[s * 256 + lane + 64 * i]; }
        else { const int t = x - 16;
#pragma unroll
            for (int i = 0; i < 4; ++i) p += qN[t * 256 + lane + 64 * i] * stN[bh * ADK + lane + 64 * i]; }
        p = wave_sum(p); if (lane == 0) dots[x] = p; }
    __syncthreads();
    float P[4][4], deninv[4];
#pragma unroll
    for (int t = 0; t < 4; ++t) { float den = 0.f;
#pragma unroll
        for (int s = 0; s < 4; ++s) { P[t][s] = s <= t ? dots[4 * t + s] * __expf(a_[s] - pm[t]) : 0.f; den += P[t][s]; }
        den += wint[t] * dots[16 + t]; deninv[t] = 1.0f / fmaxf(fabsf(den), efl[t]); }
    const int eq = tid & 127, dq = tid >> 7;
    f32x4 vv[4];
#pragma unroll
    for (int s = 0; s < 4; ++s) { const v2u w = *(const v2u*)(QKVO + (size_t)(row0 + s) * NAIN + 2048 + h * ADV + 4 * eq); vv[s] = (f32x4){bflo(w.x), bfhi(w.x), bflo(w.y), bfhi(w.y)}; }
    f32x4 qc[4];
#pragma unroll
    for (int t = 0; t < 4; ++t) qc[t] = (f32x4){0.f, 0.f, 0.f, 0.f};
    const float* Cin = stC + bh * ADK * ADV + 4 * eq; float* Cout = out + O_CS + bh * ADK * ADV + 4 * eq;
#pragma unroll 8
    for (int dd = 0; dd < 64; ++dd) { const int d = 64 * dq + dd;
        const f32x4 c = *(const f32x4*)(Cin + (size_t)d * ADV); const f32x4 q4 = *(const LAS f32x4*)(qT + 4 * d), k4 = *(const LAS f32x4*)(wkT + 4 * d);
#pragma unroll
        for (int t = 0; t < 4; ++t) qc[t] += c * q4[t];
        *(f32x4*)(Cout + (size_t)d * ADV) = c * decay + vv[0] * k4[0] + vv[1] * k4[1] + vv[2] * k4[2] + vv[3] * k4[3]; }
#pragma unroll
    for (int t = 0; t < 4; ++t) *(LAS f32x4*)(red + (dq * 4 + t) * 512 + 4 * eq) = qc[t];
    __syncthreads();
    { const int e = tid; float ve[4];
#pragma unroll
      for (int s = 0; s < 4; ++s) ve[s] = __uint_as_float((unsigned)QKVO[(size_t)(row0 + s) * NAIN + 2048 + h * ADV + e] << 16);
#pragma unroll
      for (int t = 0; t < 4; ++t) { const float qcs = (red[(0 * 4 + t) * 512 + e] + red[(1 * 4 + t) * 512 + e]) + (red[(2 * 4 + t) * 512 + e] + red[(3 * 4 + t) * 512 + e]);
          float pvv = 0.f;
#pragma unroll
          for (int s = 0; s < 4; ++s) pvv += P[t][s] * ve[s];
          const float hv = (pvv + wint[t] * qcs) * deninv[t];
          HM[(size_t)(row0 + t) * DM + h * ADV + e] = hv;
          const float ss = wave_sum(hv * hv); if (lane == 0) HSSQ[(size_t)(row0 + t) * 32 + h * 8 + wave] = ss; } }
    if (tid < ADK) { const f32x4 k4 = *(const LAS f32x4*)(wkT + 4 * tid); out[O_NS + bh * ADK + tid] = decay * stN[bh * ADK + tid] + ((k4[0] + k4[1]) + (k4[2] + k4[3])); }
    if (tid == 0) out[O_MS + bh] = mnew;
}

__device__ __forceinline__ void mlstm_gate_rows(const float* HM, const float* HSSQ, const bf16* QKVO, const float* gain, bf16* AM, int gw, int NGW, int lane) {
    for (int row = gw; row < MREAL; row += NGW) {
#pragma unroll
        for (int i = 0; i < 4; ++i) {
            const f32x4 s0 = *(const f32x4*)(HSSQ + (size_t)row * 32 + 8 * i), s1 = *(const f32x4*)(HSSQ + (size_t)row * 32 + 8 * i + 4);
            const float rs = rsqrtf((((s0[0] + s0[1]) + (s0[2] + s0[3])) + ((s1[0] + s1[1]) + (s1[2] + s1[3]))) * (1.0f / ADV) + EPS);
            const int c = 512 * i + 8 * lane;
            const f32x4 h0 = *(const f32x4*)(HM + (size_t)row * DM + c), h1 = *(const f32x4*)(HM + (size_t)row * DM + c + 4);
            const f32x4 g0 = *(const f32x4*)(gain + c), g1 = *(const f32x4*)(gain + c + 4);
            const v4u ow = *(const v4u*)(QKVO + (size_t)row * NAIN + 4096 + c);
            float o[8];
#pragma unroll
            for (int e = 0; e < 8; ++e) { const float ov = __uint_as_float(bfel(ow, e) << 16); const float sg = __builtin_amdgcn_rcpf(1.0f + __expf(-ov));
                const float hv = e < 4 ? h0[e & 3] * g0[e & 3] : h1[e & 3] * g1[e & 3]; o[e] = hv * rs * sg; }
            v4u w; w.x = pk2(o[0], o[1]); w.y = pk2(o[2], o[3]); w.z = pk2(o[4], o[5]); w.w = pk2(o[6], o[7]);
            *(v4u*)(AM + (size_t)row * DM + c) = w;
        }
    }
}

template <int NKEY> struct AttnLds { static constexpr int KNS = 144, KN = 0, VT = NKEY * 144, VTS = NKEY * 2 + 16, END = VT + 64 * VTS; };

template <int NKEY, class MaskF>
__device__ __forceinline__ void attn_tblock(LAS unsigned char* lds, const bf16* qlane  , float slope, float sink, const MaskF& mask,
                                            bf16* orow  , int nq_valid, int lane) {
    typedef AttnLds<NKEY> L; constexpr int NJB = NKEY / 16;
    const int i16 = lane & 15, g = lane >> 4;
    bf16x8 qf[2];
    qf[0] = *(const bf16x8*)qlane; qf[1] = *(const bf16x8*)(qlane + 32);
    f32x4 sacc[NJB];
#pragma unroll
    for (int jb = 0; jb < NJB; ++jb) { sacc[jb] = (f32x4){0.f, 0.f, 0.f, 0.f};
#pragma unroll
        for (int ks = 0; ks < 2; ++ks) { const bf16x8 af = *(const LAS bf16x8*)(lds + L::KN + (16 * jb + i16) * L::KNS + (32 * ks + 8 * g) * 2); sacc[jb] = MFMA16(af, qf[ks], sacc[jb]); } }
    float mx = sink;
#pragma unroll
    for (int jb = 0; jb < NJB; ++jb)
#pragma unroll
        for (int r = 0; r < 4; ++r) { float dist; const bool ok = mask(16 * jb + 4 * g + r, i16, dist); const float sv = ok ? sacc[jb][r] - slope * dist : -INFINITY; sacc[jb][r] = sv; mx = fmaxf(mx, sv); }
    mx = fmaxf(mx, __shfl_xor(mx, 16)); mx = fmaxf(mx, __shfl_xor(mx, 32));
    float sum = 0.f;
#pragma unroll
    for (int jb = 0; jb < NJB; ++jb)
#pragma unroll
        for (int r = 0; r < 4; ++r) { const float p = __expf(sacc[jb][r] - mx); sacc[jb][r] = p; sum += p; }
    sum += __shfl_xor(sum, 16); sum += __shfl_xor(sum, 32);
    sum += __expf(sink - mx);
    const float inv = 1.0f / sum;
    f32x4 oacc[4];
#pragma unroll
    for (int db = 0; db < 4; ++db) oacc[db] = (f32x4){0.f, 0.f, 0.f, 0.f};
#pragma unroll
    for (int kk = 0; kk < NJB / 2; ++kk) {
        v4u w; w.x = pk2(sacc[2 * kk][0], sacc[2 * kk][1]); w.y = pk2(sacc[2 * kk][2], sacc[2 * kk][3]); w.z = pk2(sacc[2 * kk + 1][0], sacc[2 * kk + 1][1]); w.w = pk2(sacc[2 * kk + 1][2], sacc[2 * kk + 1][3]);
        const bf16x8 pf = __builtin_bit_cast(bf16x8, w);
#pragma unroll
        for (int db = 0; db < 4; ++db) { const LAS unsigned char* vp = lds + L::VT + (16 * db + i16) * L::VTS + (32 * kk + 4 * g) * 2;
            const v2u lo = *(const LAS v2u*)vp, hi = *(const LAS v2u*)(vp + 32); const v4u bw = (v4u){lo.x, lo.y, hi.x, hi.y};
            oacc[db] = MFMA16(pf, __builtin_bit_cast(bf16x8, bw), oacc[db]); } }
#pragma unroll
    for (int r = 0; r < 4; ++r) { const float ir = __shfl(inv, 4 * g + r);
        if (4 * g + r < nq_valid) {
#pragma unroll
            for (int db = 0; db < 4; ++db) orow[(size_t)(4 * g + r) * DM + 16 * db + i16] = (bf16)(pk2(oacc[db][r] * ir, 0.f) & 0xffffu); } }
}

struct MaskPrompt { int tpos0  , band0  ;
    __device__ __forceinline__ bool operator()(int kk, int tq, float& dist) const {
        const int tpos = tpos0 + tq;
        if (kk < NMETA) { dist = (float)WIN; return tpos - kk >= WIN; }
        const int pos = band0 + kk - NMETA, rel = tpos - pos; dist = (float)rel;
        return kk < NMETA + 256 && rel >= 0 && rel < WIN && pos >= 0 && pos < TP; } };
struct MaskSample {
    __device__ __forceinline__ bool operator()(int kk, int tq, float& dist) const {
        if (kk < NMETA) { dist = (float)WIN; return true; }
        if (kk < NMETA + WIN) { const int rel = WIN + tq - (kk - NMETA); dist = (float)rel; return rel >= 0 && rel < WIN; }
        const int rel = tq - (kk - NMETA - WIN); dist = (float)rel; return kk < NMETA + WIN + DECS && rel >= 0; } };

__device__ __forceinline__ void attn_prompt_unit(LAS unsigned char* lds, const bf16* QB, const bf16* KB, const bf16* VB, const float* sinks, bf16* AM, int b, int g, int n, int tid, int wave, int lane) {
    typedef AttnLds<288> L;
    __syncthreads();
    for (int it = tid; it < 288 * 8; it += 512) { const int kk = it >> 3, ch = it & 7;
        const int pos = kk < NMETA ? kk : 128 * (n - 1) + kk - NMETA; v4u r = (v4u){0u, 0u, 0u, 0u};
        if (kk < NMETA + 256 && pos >= 0 && pos < TP) r = *(const v4u*)(KB + ((size_t)b * TP + pos) * 256 + g * 64 + 8 * ch);
        *(LAS v4u*)(lds + L::KN + kk * L::KNS + 16 * ch) = r; }
    for (int it = tid; it < 144 * 8; it += 512) { const int ch = it / 144, p = it - ch * 144; v4u r0 = (v4u){0u, 0u, 0u, 0u}, r1 = r0;
        { const int kk = 2 * p, pos = kk < NMETA ? kk : 128 * (n - 1) + kk - NMETA; if (kk < NMETA + 256 && pos >= 0 && pos < TP) r0 = *(const v4u*)(VB + ((size_t)b * TP + pos) * 256 + g * 64 + 8 * ch); }
        { const int kk = 2 * p + 1, pos = kk < NMETA ? kk : 128 * (n - 1) + kk - NMETA; if (kk < NMETA + 256 && pos >= 0 && pos < TP) r1 = *(const v4u*)(VB + ((size_t)b * TP + pos) * 256 + g * 64 + 8 * ch); }
#pragma unroll
        for (int e = 0; e < 8; ++e) *(LAS unsigned*)(lds + L::VT + (8 * ch + e) * L::VTS + 4 * p) = bfel(r0, e) | (bfel(r1, e) << 16); }
    __syncthreads();
    const int hh = 8 * g + wave; const float slope = exp2f(-0.25f * (float)(hh + 1)), sink = sinks[hh];
    for (int tb = 0; tb < 8; ++tb) { const int tpos0 = 128 * n + 16 * tb; if (tpos0 >= TP) break;
        const size_t row0 = (size_t)b * TP + tpos0;
        MaskPrompt mk{tpos0, 128 * (n - 1)};
        attn_tblock<288>(lds, QB + (row0 + (lane & 15)) * DM + hh * 64 + 8 * (lane >> 4), slope, sink, mk, AM + row0 * DM + hh * 64, 16, lane); }
}
__device__ __forceinline__ void attn_sample_unit(LAS unsigned char* lds, const bf16* QB, const bf16* KB, const bf16* VB, const float* ckm, const float* cvm, const float* ckw, const float* cvw,
                                                 const float* sinks, bf16* AM, int b, int g, int tid, int wave, int lane) {
    typedef AttnLds<160> L;
    __syncthreads();
    for (int it = tid; it < 160 * 8; it += 512) { const int kk = it >> 3, ch = it & 7; v4u r = (v4u){0u, 0u, 0u, 0u};
        if (kk < NMETA + WIN) { const float* src = kk < NMETA ? ckm + (((size_t)b * NMETA + kk) * BKV + g) * 64 + 8 * ch : ckw + (((size_t)b * WIN + (kk - NMETA)) * BKV + g) * 64 + 8 * ch;
            const f32x4 f0 = *(const f32x4*)src, f1 = *(const f32x4*)(src + 4); r.x = pk2(f0[0], f0[1]); r.y = pk2(f0[2], f0[3]); r.z = pk2(f1[0], f1[1]); r.w = pk2(f1[2], f1[3]); }
        else if (kk < NMETA + WIN + DECS) r = *(const v4u*)(KB + ((size_t)MPR + DECS * b + (kk - NMETA - WIN)) * 256 + g * 64 + 8 * ch);
        *(LAS v4u*)(lds + L::KN + kk * L::KNS + 16 * ch) = r; }
    for (int it = tid; it < 80 * 8; it += 512) { const int ch = it / 80, p = it - ch * 80; v4u rr[2];
#pragma unroll
        for (int q = 0; q < 2; ++q) { const int kk = 2 * p + q; v4u r = (v4u){0u, 0u, 0u, 0u};
            if (kk < NMETA + WIN) { const float* src = kk < NMETA ? cvm + (((size_t)b * NMETA + kk) * BKV + g) * 64 + 8 * ch : cvw + (((size_t)b * WIN + (kk - NMETA)) * BKV + g) * 64 + 8 * ch;
                const f32x4 f0 = *(const f32x4*)src, f1 = *(const f32x4*)(src + 4); r.x = pk2(f0[0], f0[1]); r.y = pk2(f0[2], f0[3]); r.z = pk2(f1[0], f1[1]); r.w = pk2(f1[2], f1[3]); }
            else if (kk < NMETA + WIN + DECS) r = *(const v4u*)(VB + ((size_t)MPR + DECS * b + (kk - NMETA - WIN)) * 256 + g * 64 + 8 * ch);
            rr[q] = r; }
#pragma unroll
        for (int e = 0; e < 8; ++e) *(LAS unsigned*)(lds + L::VT + (8 * ch + e) * L::VTS + 4 * p) = bfel(rr[0], e) | (bfel(rr[1], e) << 16); }
    __syncthreads();
    const int hh = 8 * g + wave; const float slope = exp2f(-0.25f * (float)(hh + 1)), sink = sinks[hh];
    const size_t row0 = (size_t)MPR + DECS * b;
    MaskSample mk;
    attn_tblock<160>(lds, QB + (row0 + (lane & 15)) * DM + hh * 64 + 8 * (lane >> 4), slope, sink, mk, AM + row0 * DM + hh * 64, DECS, lane);
}
__device__ __forceinline__ void kv_outputs(const Args& a, const bf16* KB, const bf16* VB, size_t gtid, size_t gthreads) {
    float* out = a.out;
    for (size_t i = gtid; i < (size_t)NBATCH * (NMETA + WIN) * 256; i += gthreads) { const int c = (int)(i & 255); const int rr = (int)(i >> 8); const int b = rr / (NMETA + WIN), q = rr - b * (NMETA + WIN);
        const int t = q < NMETA ? q : TP - WIN + (q - NMETA); const size_t src = ((size_t)b * TP + t) * 256 + c;
        const float kv = __uint_as_float((unsigned)KB[src] << 16), vv = __uint_as_float((unsigned)VB[src] << 16);
        if (q < NMETA) { out[O_KMP + ((size_t)b * NMETA + q) * 256 + c] = kv; out[O_VMP + ((size_t)b * NMETA + q) * 256 + c] = vv; }
        else { out[O_KWP + ((size_t)b * WIN + (q - NMETA)) * 256 + c] = kv; out[O_VWP + ((size_t)b * WIN + (q - NMETA)) * 256 + c] = vv; } }
    for (size_t i = gtid; i < (size_t)DECB * WIN * 64; i += gthreads) { const int c4 = (int)(i & 63) * 4; const int rr = (int)(i >> 6); const int b = rr >> 7, jj = rr & 127;
        f32x4 kv, vv;
        if (jj < WIN - DECS) { kv = *(const f32x4*)(a.in[I_CKW] + ((size_t)b * WIN + jj + DECS) * 256 + c4); vv = *(const f32x4*)(a.in[I_CVW] + ((size_t)b * WIN + jj + DECS) * 256 + c4); }
        else { const size_t src = ((size_t)MPR + DECS * b + (jj - (WIN - DECS))) * 256 + c4; const v2u kw = *(const v2u*)(KB + src), vw = *(const v2u*)(VB + src);
            kv = (f32x4){bflo(kw.x), bfhi(kw.x), bflo(kw.y), bfhi(kw.y)}; vv = (f32x4){bflo(vw.x), bfhi(vw.x), bflo(vw.y), bfhi(vw.y)}; }
        *(f32x4*)(out + O_KWS + ((size_t)b * WIN + jj) * 256 + c4) = kv; *(f32x4*)(out + O_VWS + ((size_t)b * WIN + jj) * 256 + c4) = vv; }
}

#define GEMM_PHASE(EPI_T, E, Aptr, Bptr, N_, K_) do { pg8::Gemm gg{(const pg8::bf16_t*)(Aptr), (const pg8::bf16_t*)(Bptr), MP, (N_), (K_)}; int bx_ = (int)blockIdx.x; asm volatile("" : "+s"(bx_)); pg8::StaticOrder SS; SS.init(MP, (N_), G, bx_); \
    pg8::gemm_phase<EPI_T, pg8::StaticOrder, true, true>(lds, gg, SS, (E)); } while (0)

__global__ void __launch_bounds__(NWAVES * 64, 2) yoco_fwd(Args args) {
    extern __shared__ __attribute__((aligned(16))) unsigned char lds_raw[];
    LAS unsigned char* lds = (LAS unsigned char*)lds_raw;
    volatile LAS unsigned* MISC = (volatile LAS unsigned*)(lds + MISC_OFF);
    const int tid = threadIdx.x, lane = tid & 63, wave = __builtin_amdgcn_readfirstlane(tid >> 6);
    const int G = gridDim.x, gw = blockIdx.x * NWAVES + wave, NGW = G * NWAVES;
    unsigned char* ws = args.ws;
    for (int u = tid; u < (LDS_BYTES - MISC_OFF) / 4; u += NWAVES * 64) ((LAS unsigned*)(lds + MISC_OFF))[u] = 0u;
    __syncthreads();
    XcdBarrier bar = xcd_barrier_post((unsigned*)(ws + WS_CTL) + CW_BAR, MISC + 8);

    float* H = (float*)(ws + WS_H); bf16* AB = (bf16*)(ws + WS_AB); bf16* ACT = (bf16*)(ws + WS_ACT); bf16* QKVO = (bf16*)(ws + WS_ACT);
    float* HM = (float*)(ws + WS_HM); bf16* AM = (bf16*)(ws + WS_AM); bf16* QB = (bf16*)(ws + WS_QB); bf16* KB = (bf16*)(ws + WS_KB); bf16* VB = (bf16*)(ws + WS_VB);
    float* SSQ = (float*)(ws + WS_SSQ); float* HSSQ = (float*)(ws + WS_HSSQ); float* GATES = (float*)(ws + WS_GATES);

    p0_prologue(args, lds, gw, NGW, wave, lane);
    xcd_barrier(bar);

    { EpiSwiglu E{ACT, SSQ}; GEMM_PHASE(EpiSwiglu, E, AB, ws + WS_W1 + 0 * SZ_W1, 2 * DFF, DM); }
    xcd_barrier(bar);
    { EpiResid<false> E{H, AB, SSQ, 0.5f, nullptr}; GEMM_PHASE(EpiResid<false>, E, ACT, ws + WS_W2 + 0 * SZ_W2, DM, DFF); }
    xcd_barrier(bar);

    { EpiQkvo E{QKVO, SSQ, GATES, args.in[I_BAG]}; GEMM_PHASE(EpiQkvo, E, AB, ws + WS_WAIN, NAIN_PAD, DM); }
    xcd_barrier(bar);
    for (int u = blockIdx.x; u < NBATCH * AH * 8; u += G) mlstm_prompt_unit(lds, QKVO, GATES, HM, HSSQ, args.out, u >> 5, (u >> 3) & 3, u & 7, tid, wave, lane);
    for (int u = blockIdx.x; u < DECB * AH; u += G) mlstm_sample_unit(lds, QKVO, GATES, args.in[I_SC], args.in[I_SN], args.in[I_SM], HM, HSSQ, args.out, u >> 2, u & 3, tid, wave, lane);
    xcd_barrier(bar);
    mlstm_gate_rows(HM, HSSQ, QKVO, args.in[I_AHN], AM, gw, NGW, lane);
    xcd_barrier(bar);
    { EpiResid<false> E{H, AB, SSQ, 1.0f, nullptr}; GEMM_PHASE(EpiResid<false>, E, AM, ws + WS_WAOUT, DM, DM); }
    xcd_barrier(bar);

    { EpiSwiglu E{ACT, SSQ}; GEMM_PHASE(EpiSwiglu, E, AB, ws + WS_W1 + 1 * SZ_W1, 2 * DFF, DM); }
    xcd_barrier(bar);
    { EpiResid<false> E{H, AB, SSQ, 0.5f, nullptr}; GEMM_PHASE(EpiResid<false>, E, ACT, ws + WS_W2 + 1 * SZ_W2, DM, DFF); }
    xcd_barrier(bar);

    { EpiHead E{KB, 256, VB, 256, 1, SSQ, args.in[I_KN], 1.0f}; GEMM_PHASE(EpiHead, E, AB, ws + WS_WKV, 512, DM); }
    { EpiSwiglu E{ACT, SSQ}; GEMM_PHASE(EpiSwiglu, E, AB, ws + WS_W1 + 2 * SZ_W1, 2 * DFF, DM); }
    xcd_barrier(bar);
    { EpiResid<false> E{H, AB, SSQ, 0.5f, nullptr}; GEMM_PHASE(EpiResid<false>, E, ACT, ws + WS_W2 + 2 * SZ_W2, DM, DFF); }
    xcd_barrier(bar);

    { EpiHead E{QB, DM, QB, DM, 8, SSQ, args.in[I_QN], 0.125f}; GEMM_PHASE(EpiHead, E, AB, ws + WS_WQ, DM, DM); }
    xcd_barrier(bar);
    kv_outputs(args, KB, VB, (size_t)blockIdx.x * (NWAVES * 64) + tid, (size_t)G * NWAVES * 64);
    for (int u = blockIdx.x; u < NBATCH * BKV * 17; u += G) { const int n = u % 17, bg = u / 17; attn_prompt_unit(lds, QB, KB, VB, args.in[I_SINK], AM, bg >> 2, bg & 3, n, tid, wave, lane); }
    for (int u = blockIdx.x; u < DECB * BKV; u += G) attn_sample_unit(lds, QB, KB, VB, args.in[I_CKM], args.in[I_CVM], args.in[I_CKW], args.in[I_CVW], args.in[I_SINK], AM, u >> 2, u & 3, tid, wave, lane);
    xcd_barrier(bar);
    { EpiResid<false> E{H, AB, SSQ, 1.0f, nullptr}; GEMM_PHASE(EpiResid<false>, E, AM, ws + WS_WBO, DM, DM); }
    xcd_barrier(bar);

    { EpiSwiglu E{ACT, SSQ}; GEMM_PHASE(EpiSwiglu, E, AB, ws + WS_W1 + 3 * SZ_W1, 2 * DFF, DM); }
    xcd_barrier(bar);
    { EpiResid<true> E{H, AB, SSQ, 0.5f, args.out}; GEMM_PHASE(EpiResid<true>, E, ACT, ws + WS_W2 + 3 * SZ_W2, DM, DFF); }
}

extern "C" void kernel_launch(void* const* d_in, const int* in_sizes, int n_in, void* d_out, int out_size, void* d_ws, size_t ws_size, hipStream_t stream) {
    static int grid = 0;
    if (grid == 0) {
        if (n_in != 25 || (size_t)out_size != O_END || ws_size < WS_END) { fprintf(stderr, "kernel_launch: unexpected shapes (n_in %d, out %d vs %zu, ws %zu vs %zu); nothing launched\n", n_in, out_size, (size_t)O_END, ws_size, (size_t)WS_END); grid = -1; return; }
        int dev = 0, cus = 0, per_cu = 0;
        if (hipGetDevice(&dev) != hipSuccess || hipDeviceGetAttribute(&cus, hipDeviceAttributeMultiprocessorCount, dev) != hipSuccess) { grid = -1; return; }
        if (hipFuncSetAttribute((const void*)yoco_fwd, hipFuncAttributeMaxDynamicSharedMemorySize, LDS_BYTES) != hipSuccess) { fprintf(stderr, "kernel_launch: hipFuncSetAttribute failed\n"); grid = -1; return; }
        if (hipOccupancyMaxActiveBlocksPerMultiprocessor(&per_cu, (const void*)yoco_fwd, NWAVES * 64, LDS_BYTES) != hipSuccess || per_cu < 1) fprintf(stderr, "kernel_launch: occupancy query says %d\n", per_cu);
        (void)hipGetLastError();
        grid = cus;
    }
    if (grid < 0) return;
    (void)in_sizes;
    if (hipMemsetAsync((char*)d_ws + WS_CTL, 0, CTL_ZERO_BYTES, stream) != hipSuccess) return;
    Args a{};
    for (int i = 0; i < 25; ++i) a.in[i] = (const float*)d_in[i];
    a.out = (float*)d_out; a.ws = (unsigned char*)d_ws;
    hipLaunchKernelGGL(yoco_fwd, dim3(grid), dim3(NWAVES * 64), LDS_BYTES, stream, a);
}
```

```cpp
#include <hip/hip_runtime.h>
#include <cstdio>
#include <cstdint>
namespace pg8 {
#define PG8_LAS __attribute__((address_space(3)))
typedef unsigned short bf16_t;
typedef short bf16x8 __attribute__((ext_vector_type(8)));
typedef float f32x4 __attribute__((ext_vector_type(4)));
typedef unsigned u32x4 __attribute__((ext_vector_type(4)));
constexpr int BM = 256, BK = 64, HALF = 128, HTB = HALF * BK * 2  , STAGE_BYTES = 8 * HTB, NXCD = 8, WGM = 8;

__host__ __device__ __forceinline__ int lds_byte(int r, int c) { const int st = (r >> 4) * 2 + (c >> 5), rr = r & 15, cc = c & 31, ob = rr * 64 + cc * 2; return st * 1024 + (ob ^ (((ob >> 9) & 1) << 5)); }
__host__ __device__ __forceinline__ void stage_rc(int b, int& R, int& C) { const int st = b / 1024, sb = b % 1024, swz = sb ^ (((sb >> 9) & 1) << 5); R = (st >> 1) * 16 + swz / 64; C = (st & 1) * 32 + (swz % 64) / 2; }
__host__ __device__ __forceinline__ int perm32(int rho) { const int n = rho >> 4, i = rho & 15; return 8 * (i >> 2) + 4 * n + (i & 3); }

struct Unit { int pm, pn; };
struct Gemm { const bf16_t* A; const bf16_t* Bt; int M, N, K; };

struct StaticOrder {
    int nM, nN, nwg, G, c;
    __host__ __device__ void init(int M, int N, int G_, int c_) { nM = M / BM; nN = N / BM; nwg = nM * nN; G = G_; c = c_; }
    __host__ __device__ bool next(int i, Unit& u) const {
        const long L = (long)i * G + c; if (L >= nwg) return false;
        int wgid = (int)L; { const int q = nwg / NXCD, r = nwg % NXCD, xcd = wgid % NXCD, off = wgid / NXCD; wgid = (xcd < r ? xcd * (q + 1) : r * (q + 1) + (xcd - r) * q) + off; }
        const int nig = WGM * nN, gid = wgid / nig, fm = gid * WGM, gsz = (nM - fm) < WGM ? (nM - fm) : WGM;
        u.pm = fm + ((wgid % nig) % gsz); u.pn = (wgid % nig) / gsz; return true;
    }
    __device__ __forceinline__ void a_ready(const Unit&) const {}
    __device__ __forceinline__ void done(const Unit&) const {}
};

__device__ __forceinline__ unsigned cvt_pk_bf16(float lo, float hi) { unsigned r; asm volatile("v_cvt_pk_bf16_f32 %0, %1, %2" : "=v"(r) : "v"(lo), "v"(hi)); return r; }
typedef float f32x2 __attribute__((ext_vector_type(2)));
template <class Epi, class Sched, bool ALIGN_EPI = false, bool SP2 = false>
__device__ __forceinline__ void gemm_phase(PG8_LAS unsigned char* lds, const Gemm g, const Sched& S, const Epi& E) {
    int tid_l = threadIdx.x; asm volatile("" : "+v"(tid_l));
    const int tid = tid_l, wid = __builtin_amdgcn_readfirstlane(tid >> 6), lane = tid & 63, wr = wid >> 2, wc = wid & 3, fr = lane & 15, fq = lane >> 4;
    const int K = g.K, nt = K / BK;
    unsigned voffA[2], voffB[2];
#pragma unroll
    for (int i = 0; i < 2; ++i) { int R, C; stage_rc(tid * 16 + i * 8192, R, C); const int Rb = Epi::PERM ? ((R & ~31) + perm32(R & 31)) : R;
        voffA[i] = (unsigned)(R * K + C) * 2u; voffB[i] = (unsigned)(Rb * K + C) * 2u; }
    const size_t kstep = (size_t)(BK * 2);
    const size_t hstep = (size_t)HALF * K * 2;
    const size_t tstep = 2 * hstep;
    const unsigned ldsw = (unsigned)wid * 1024u;
    const int aoff = lds_byte(wr * 64 + fr, fq * 8), boff = lds_byte(wc * 32 + fr, fq * 8);
#define PG8_SA(b, h) (((b) * 2 + (h)) * HTB)
#define PG8_SB(b, h) ((4 + (b) * 2 + (h)) * HTB)
#define PG8_STAGE(bufoff, gbase, voff) do { _Pragma("unroll") for (int _i = 0; _i < 2; ++_i) \
        __builtin_amdgcn_global_load_lds((const unsigned*)((const char*)(gbase) + (voff)[_i]), (PG8_LAS unsigned*)(lds + (bufoff) + ldsw + _i * 8192), 16, 0, 0); } while (0)
#define PG8_LDA(dst, b, h) do { _Pragma("unroll") for (int m = 0; m < 4; ++m) _Pragma("unroll") for (int k = 0; k < 2; ++k) dst[m][k] = *(const PG8_LAS bf16x8*)(lds + PG8_SA(b, h) + aoff + m * 2048 + k * 1024); } while (0)
#define PG8_LDB(dst, b, h) do { _Pragma("unroll") for (int n = 0; n < 2; ++n) _Pragma("unroll") for (int k = 0; k < 2; ++k) dst[n][k] = *(const PG8_LAS bf16x8*)(lds + PG8_SB(b, h) + boff + n * 2048 + k * 1024); } while (0)
#define PG8_MMA(ai, bj, At, Bt) do { __builtin_amdgcn_s_setprio(1); _Pragma("unroll") for (int m = 0; m < 4; ++m) _Pragma("unroll") for (int n = 0; n < 2; ++n) _Pragma("unroll") for (int k = 0; k < 2; ++k) \
        acc[ai][bj][m][n] = __builtin_amdgcn_mfma_f32_16x16x32_bf16(Bt[n][k], At[m][k], acc[ai][bj][m][n], 0, 0, 0); __builtin_amdgcn_s_setprio(0); } while (0)
#define PG8_WAIT_V(n) asm volatile("s_waitcnt vmcnt(" #n ")" ::: "memory")
#define PG8_WAIT_L(n) asm volatile("s_waitcnt lgkmcnt(" #n ")" ::: "memory")
#define PG8_BAR __builtin_amdgcn_s_barrier()
#define PG8_SCHED __builtin_amdgcn_sched_barrier(0)
    Unit cur, nxt; int ui = 0;
    if (!S.next(0, cur)) return;
    f32x4 acc[2][2][4][2];
#pragma unroll
    for (int a = 0; a < 2; ++a)
#pragma unroll
        for (int b = 0; b < 2; ++b)
#pragma unroll
            for (int m = 0; m < 4; ++m)
#pragma unroll
                for (int n = 0; n < 2; ++n) acc[a][b][m][n] = (f32x4){0.f, 0.f, 0.f, 0.f};
    bf16x8 At[4][2], B0[2][2], B1[2][2];
    const char* cA = (const char*)g.A + (size_t)cur.pm * tstep; const char* cB = (const char*)g.Bt + (size_t)cur.pn * tstep;
    S.a_ready(cur);
    if constexpr (SP2) {
        PG8_STAGE(PG8_SB(0, 0), cB, voffB); PG8_STAGE(PG8_SB(0, 1), cB + hstep, voffB); PG8_STAGE(PG8_SA(0, 0), cA, voffA); PG8_STAGE(PG8_SA(0, 1), cA + hstep, voffA);
        if (wr == 1) PG8_BAR;
        PG8_WAIT_V(2); PG8_BAR;
        PG8_STAGE(PG8_SB(1, 0), cB + kstep, voffB); PG8_STAGE(PG8_SA(1, 0), cA + kstep, voffA); PG8_STAGE(PG8_SB(1, 1), cB + hstep + kstep, voffB);
        PG8_WAIT_V(6); PG8_BAR;
    } else {
        PG8_STAGE(PG8_SB(0, 0), cB, voffB); PG8_STAGE(PG8_SA(0, 0), cA, voffA); PG8_STAGE(PG8_SB(0, 1), cB + hstep, voffB); PG8_STAGE(PG8_SA(0, 1), cA + hstep, voffA);
        if (wr == 1) PG8_BAR;
        PG8_WAIT_V(4); PG8_BAR;
        PG8_STAGE(PG8_SB(1, 0), cB + kstep, voffB); PG8_STAGE(PG8_SA(1, 0), cA + kstep, voffA); PG8_STAGE(PG8_SB(1, 1), cB + hstep + kstep, voffB);
        PG8_WAIT_V(6); PG8_BAR;
    }
    for (;;) {
        const bool has_next = S.next(ui + 1, nxt);
        const char* nA = has_next ? (const char*)g.A + (size_t)nxt.pm * tstep : cA; const char* nB = has_next ? (const char*)g.Bt + (size_t)nxt.pn * tstep : cB;
        for (int t = 0; t < nt; t += 2) {
            const bool last = (t == nt - 2);
            const char* a1 = cA + (size_t)(t + 1) * kstep;
            const char* a2 = last ? nA : cA + (size_t)(t + 2) * kstep; const char* b2 = last ? nB : cB + (size_t)(t + 2) * kstep;
            const char* a3 = a2 + kstep; const char* b3 = b2 + kstep;
            if (last && has_next) S.a_ready(nxt);
            if constexpr (SP2) {
            PG8_LDB(B0, 0, 0); PG8_LDB(B1, 0, 1); PG8_SCHED; PG8_LDA(At, 0, 0); PG8_STAGE(PG8_SA(1, 1), a1 + hstep, voffA);
            PG8_WAIT_V(8); PG8_WAIT_L(0); PG8_BAR; PG8_MMA(0, 0, At, B0); PG8_MMA(0, 1, At, B1); PG8_BAR; PG8_SCHED;
            PG8_LDA(At, 0, 1); PG8_STAGE(PG8_SB(0, 0), b2, voffB); PG8_STAGE(PG8_SB(0, 1), b2 + hstep, voffB); PG8_STAGE(PG8_SA(0, 0), a2, voffA);
            PG8_WAIT_V(8); PG8_WAIT_L(0); PG8_BAR; PG8_MMA(1, 0, At, B0); PG8_MMA(1, 1, At, B1); PG8_BAR; PG8_SCHED;
            PG8_LDB(B0, 1, 0); PG8_LDB(B1, 1, 1); PG8_SCHED; PG8_LDA(At, 1, 0); PG8_STAGE(PG8_SA(0, 1), a2 + hstep, voffA);
            PG8_WAIT_V(8); PG8_WAIT_L(0); PG8_BAR; PG8_MMA(0, 0, At, B0); PG8_MMA(0, 1, At, B1); PG8_BAR; PG8_SCHED;
            PG8_LDA(At, 1, 1); PG8_STAGE(PG8_SB(1, 0), b3, voffB); PG8_STAGE(PG8_SB(1, 1), b3 + hstep, voffB); PG8_STAGE(PG8_SA(1, 0), a3, voffA);
            PG8_WAIT_V(8); PG8_WAIT_L(0); PG8_BAR; PG8_MMA(1, 0, At, B0); PG8_MMA(1, 1, At, B1); PG8_BAR; PG8_SCHED;
            } else {
            PG8_LDB(B0, 0, 0); PG8_SCHED; PG8_LDA(At, 0, 0); PG8_STAGE(PG8_SA(1, 1), a1 + hstep, voffA);
            PG8_WAIT_L(8); PG8_BAR; PG8_WAIT_L(0); PG8_MMA(0, 0, At, B0); PG8_BAR; PG8_SCHED;
            PG8_LDB(B1, 0, 1); PG8_STAGE(PG8_SB(0, 0), b2, voffB);
            PG8_BAR; PG8_WAIT_L(0); PG8_MMA(0, 1, At, B1); PG8_BAR;
            PG8_LDA(At, 0, 1); PG8_STAGE(PG8_SA(0, 0), a2, voffA);
            PG8_BAR; PG8_WAIT_L(0); PG8_MMA(1, 0, At, B0); PG8_BAR; PG8_SCHED;
            PG8_STAGE(PG8_SB(0, 1), b2 + hstep, voffB);
            PG8_WAIT_V(6); PG8_BAR; PG8_MMA(1, 1, At, B1); PG8_BAR;
            PG8_LDB(B0, 1, 0); PG8_SCHED; PG8_LDA(At, 1, 0); PG8_STAGE(PG8_SA(0, 1), a2 + hstep, voffA);
            PG8_WAIT_L(8); PG8_BAR; PG8_WAIT_L(0); PG8_MMA(0, 0, At, B0); PG8_BAR; PG8_SCHED;
            PG8_LDB(B1, 1, 1); PG8_STAGE(PG8_SB(1, 0), b3, voffB);
            PG8_BAR; PG8_WAIT_L(0); PG8_MMA(0, 1, At, B1); PG8_BAR;
            PG8_LDA(At, 1, 1); PG8_STAGE(PG8_SA(1, 0), a3, voffA);
            PG8_BAR; PG8_WAIT_L(0); PG8_MMA(1, 0, At, B0); PG8_BAR; PG8_SCHED;
            PG8_STAGE(PG8_SB(1, 1), b3 + hstep, voffB);
            PG8_WAIT_V(6); PG8_BAR; PG8_MMA(1, 1, At, B1); PG8_BAR;
            }
        }
        if constexpr (ALIGN_EPI) { if (wr == 0) PG8_BAR; }
        if constexpr (!Epi::AFTER_DRAIN) { E(acc, cur, wr, wc, fr, fq); S.done(cur); }
        if (!has_next) break;
#pragma unroll
        for (int a = 0; a < 2; ++a)
#pragma unroll
            for (int b = 0; b < 2; ++b)
#pragma unroll
                for (int m = 0; m < 4; ++m)
#pragma unroll
                    for (int n = 0; n < 2; ++n) acc[a][b][m][n] = (f32x4){0.f, 0.f, 0.f, 0.f};
        cur = nxt; cA = nA; cB = nB; ++ui;
        if constexpr (ALIGN_EPI) { if (wr == 1) PG8_BAR; }
    }
    PG8_WAIT_V(0);
    if constexpr (!ALIGN_EPI) { if (wr == 0) PG8_BAR; }
    PG8_BAR;
    if constexpr (Epi::AFTER_DRAIN) { E.fused(acc, cur, wr, wc, fr, fq, lds, wid, lane); S.done(cur); }
#undef PG8_SA
#undef PG8_SB
#undef PG8_STAGE
#undef PG8_LDA
#undef PG8_LDB
#undef PG8_MMA
#undef PG8_WAIT_V
#undef PG8_WAIT_L
#undef PG8_BAR
#undef PG8_SCHED
}
}

constexpr int NWAVES = 8;
constexpr int DM = 2048, DFF = 5632, NBATCH = 8, SEQ = 2048, NMETA = 16, TP = SEQ + NMETA;
constexpr int DECB = 128, DECS = 4, MPR = NBATCH * TP  , MSM = DECB * DECS  , MREAL = MPR + MSM  , MP = 17152  ;
constexpr int AH = 4, ADK = 256, ADV = 512, NAIN = 6144, NAIN_PAD = 6400;
constexpr int BH = 32, BDH = 64, BKV = 4, WIN = 128;
constexpr float EPS = 1e-6f;

constexpr size_t MiB = 1u << 20;
constexpr size_t WS_CTL = 0, CTL_ZERO_BYTES = 1 * MiB;
constexpr size_t SZ_W1 = (size_t)2 * DFF * DM * 2, SZ_W2 = (size_t)DM * DFF * 2;
constexpr size_t WS_W1 = 1 * MiB;
constexpr size_t WS_W2 = WS_W1 + 4 * SZ_W1;
constexpr size_t WS_WAIN = WS_W2 + 4 * SZ_W2;
constexpr size_t WS_WAOUT = WS_WAIN + (size_t)NAIN_PAD * DM * 2;
constexpr size_t WS_WKV = WS_WAOUT + (size_t)DM * DM * 2;
constexpr size_t WS_WQ = WS_WKV + (size_t)512 * DM * 2;
constexpr size_t WS_WBO = WS_WQ + (size_t)DM * DM * 2;
constexpr size_t WS_H = WS_WBO + (size_t)DM * DM * 2;
constexpr size_t WS_AB = WS_H + (size_t)MP * DM * 4;
constexpr size_t WS_ACT = WS_AB + (size_t)MP * DM * 2;
constexpr size_t WS_HM = WS_ACT + (size_t)MP * NAIN * 2;
constexpr size_t WS_AM = WS_HM + (size_t)MP * DM * 4;
constexpr size_t WS_QB = WS_AM + (size_t)MP * DM * 2;
constexpr size_t WS_KB = WS_QB + (size_t)MP * DM * 2;
constexpr size_t WS_VB = WS_KB + (size_t)MP * 256 * 2;
constexpr size_t WS_SSQ = WS_VB + (size_t)MP * 256 * 2;
constexpr size_t WS_HSSQ = WS_SSQ + (size_t)MP * 32 * 4;
constexpr size_t WS_GATES = WS_HSSQ + (size_t)MP * 32 * 4;
constexpr size_t WS_END = WS_GATES + (size_t)MP * 8 * 4;
constexpr int CW_BAR = 4096;

constexpr size_t O_YP = 0, O_YS = O_YP + (size_t)NBATCH * SEQ * DM, O_CP = O_YS + (size_t)MSM * DM, O_NP = O_CP + (size_t)NBATCH * AH * ADK * ADV,
                 O_MP = O_NP + NBATCH * AH * ADK, O_KMP = O_MP + NBATCH * AH, O_VMP = O_KMP + NBATCH * NMETA * 256, O_KWP = O_VMP + NBATCH * NMETA * 256,
                 O_VWP = O_KWP + NBATCH * WIN * 256, O_CS = O_VWP + NBATCH * WIN * 256, O_NS = O_CS + (size_t)DECB * AH * ADK * ADV, O_MS = O_NS + DECB * AH * ADK,
                 O_KWS = O_MS + DECB * AH, O_VWS = O_KWS + (size_t)DECB * WIN * 256, O_END = O_VWS + (size_t)DECB * WIN * 256;

constexpr int SCR_BYTES = 143360;
constexpr int MISC_OFF = SCR_BYTES;
constexpr int LDS_BYTES = 147456;

#define GAS __attribute__((address_space(1)))
#define LAS __attribute__((address_space(3)))
typedef unsigned short bf16;
typedef unsigned v4u __attribute__((ext_vector_type(4)));
typedef unsigned v2u __attribute__((ext_vector_type(2)));
typedef float f32x4 __attribute__((ext_vector_type(4)));
typedef short bf16x8 __attribute__((ext_vector_type(8)));
#define LDS_WAIT() asm volatile("s_waitcnt lgkmcnt(0)" ::: "memory")
#define MFMA16(a, b, c) __builtin_amdgcn_mfma_f32_16x16x32_bf16((a), (b), (c), 0, 0, 0)
__device__ __forceinline__ unsigned pk2(float lo, float hi) { return pg8::cvt_pk_bf16(lo, hi); }
__device__ __forceinline__ float bflo(unsigned w) { return __uint_as_float(w << 16); }
__device__ __forceinline__ float bfhi(unsigned w) { return __uint_as_float(w & 0xffff0000u); }
__device__ __forceinline__ unsigned bfel(const v4u& r, int e) { return (r[e >> 1] >> (16 * (e & 1))) & 0xffffu; }
__device__ __forceinline__ float wave_sum(float v) {
#pragma unroll
    for (int o = 1; o < 64; o <<= 1) v += __shfl_xor(v, o);
    return v;
}
#define XB_TMO      128
#define XB_XCNT(j)  (256  + 64 * (j))
#define XB_XSUB(j)  (1280 + 64 * (j))
#define XB_XGEN(j)  (2304 + 64 * (j))
#define XB_TOP      3328
#define XB_TOPGEN   3392
#define XCD_BAR_WORDS 3456
#define XB_SPIN_CAP (1u << 18)

__device__ __forceinline__ unsigned xb_ld(unsigned* p)              { return __hip_atomic_load(p, __ATOMIC_RELAXED, __HIP_MEMORY_SCOPE_AGENT); }
__device__ __forceinline__ unsigned xb_add(unsigned* p, unsigned v) { return __hip_atomic_fetch_add(p, v, __ATOMIC_RELAXED, __HIP_MEMORY_SCOPE_AGENT); }
__device__ __forceinline__ unsigned xb_xcc_id() { return (unsigned)__builtin_amdgcn_s_getreg((3 << 11) | 20) & 0xFu; }
#define XB_SPIN(cond, bar) do { unsigned _sp = 0; while (cond) { __builtin_amdgcn_s_sleep(1); \
    if ((++_sp & 255u) == 0u) { if (xb_ld(&(bar)[XB_TMO])) break; if (_sp > XB_SPIN_CAP) { atomicAdd(&(bar)[XB_TMO], 1u); break; } } } } while (0)

struct XcdBarrier {
    unsigned* bar; unsigned x;
    volatile LAS unsigned* st;
};

__device__ __forceinline__ XcdBarrier xcd_barrier_post(unsigned* bar, volatile LAS unsigned* st) {
    XcdBarrier b; b.bar = bar; b.x = xb_xcc_id(); b.st = st;
    if (threadIdx.x == 0) (void)xb_add(&bar[XB_XCNT(b.x)], 1u);
    return b;
}
__device__ __forceinline__ void xcd_barrier_complete(unsigned* bar, unsigned x, unsigned& nloc, unsigned& nx) {
    const unsigned G = gridDim.x * gridDim.y * gridDim.z;
    unsigned sum, cnt, mine, sp = 0u;
    for (;;) {
        sum = 0u; cnt = 0u; mine = 0u;
#pragma unroll
        for (unsigned j = 0; j < 16; ++j) { const unsigned c = xb_ld(&bar[XB_XCNT(j)]); sum += c; cnt += (c > 0u) ? 1u : 0u; mine = (j == x) ? c : mine; }
        if (sum == G) break;
        __builtin_amdgcn_s_sleep(1);
        if ((++sp & 255u) == 0u) { if (xb_ld(&bar[XB_TMO])) break; if (sp > XB_SPIN_CAP) { atomicAdd(&bar[XB_TMO], 1u); break; } }
    }
    nloc = mine > 0u ? mine : 1u; nx = cnt > 0u ? cnt : 1u;
}

__device__ __forceinline__ void xcd_barrier(const XcdBarrier& b) {
    asm volatile("s_waitcnt vmcnt(0)" ::: "memory");
    __syncthreads();
    if (threadIdx.x == 0) {
        unsigned* bar = b.bar;
        __builtin_amdgcn_s_waitcnt(0);
        unsigned nloc = b.st[0], nx = b.st[1];
        if (nloc == 0u) { xcd_barrier_complete(bar, b.x, nloc, nx); b.st[0] = nloc; b.st[1] = nx; }
        const unsigned old = xb_add(&bar[XB_XSUB(b.x)], 1u);
        const unsigned gen = old / nloc;
        if (old + 1u == (gen + 1u) * nloc) {
            __builtin_amdgcn_fence(__ATOMIC_RELEASE, "agent");
            asm volatile("s_waitcnt vmcnt(0)" ::: "memory");
            const unsigned og = xb_add(&bar[XB_TOP], 1u);
            const unsigned tg = og / nx;
            if (og + 1u == (tg + 1u) * nx) xb_add(&bar[XB_TOPGEN], 1u);
            else XB_SPIN(xb_ld(&bar[XB_TOPGEN]) == tg, bar);
            __builtin_amdgcn_fence(__ATOMIC_ACQUIRE, "agent");
            xb_add(&bar[XB_XGEN(b.x)], 1u);
            asm volatile("s_waitcnt vmcnt(0)" ::: "memory");
        } else {
            XB_SPIN(xb_ld(&bar[XB_XGEN(b.x)]) == gen, bar);
            __builtin_amdgcn_fence(__ATOMIC_ACQUIRE, "agent");
            asm volatile("s_waitcnt vmcnt(0)" ::: "memory");
        }
    }
    __syncthreads();
}

__device__ __forceinline__ float row_rscale(const float* ssq, int row, int fq) {
    const f32x4* p = (const f32x4*)(ssq + (size_t)row * 32 + 8 * fq);
    const f32x4 a = p[0], b = p[1];
    float s = ((a.x + a.y) + (a.z + a.w)) + ((b.x + b.y) + (b.z + b.w));
    s += __shfl_xor(s, 16); s += __shfl_xor(s, 32);
    return rsqrtf(s * (1.0f / DM) + EPS);
}
__device__ __forceinline__ float silu_f(float g) { return g * __builtin_amdgcn_rcpf(1.0f + __expf(-g)); }

struct EpiSwiglu {
    static constexpr bool PERM = true, AFTER_DRAIN = false;
    bf16* O; const float* ssq;
    __device__ __forceinline__ void operator()(const f32x4 (&acc)[2][2][4][2], const pg8::Unit& u, int wr, int wc, int fr, int fq) const {
        const int row0 = u.pm * 256 + wr * 64 + fr, col0 = u.pn * 128 + wc * 32 + 8 * fq;
#pragma unroll
        for (int ai = 0; ai < 2; ++ai)
#pragma unroll
            for (int m = 0; m < 4; ++m) {
                const int row = row0 + ai * 128 + m * 16;
                const float r = row_rscale(ssq, row, fq);
                float o[8];
#pragma unroll
                for (int n = 0; n < 2; ++n)
#pragma unroll
                    for (int j = 0; j < 4; ++j) o[4 * n + j] = silu_f(acc[ai][0][m][n][j] * r) * (acc[ai][1][m][n][j] * r);
                v4u w; w.x = pk2(o[0], o[1]); w.y = pk2(o[2], o[3]); w.z = pk2(o[4], o[5]); w.w = pk2(o[6], o[7]);
                *(v4u*)(O + (size_t)row * DFF + col0) = w;
            }
    }
};
template <bool FINAL> struct EpiResid {
    static constexpr bool PERM = true, AFTER_DRAIN = false;
    float* H; bf16* AB; float* ssq; float sc; float* out;
    __device__ __forceinline__ void operator()(const f32x4 (&acc)[2][2][4][2], const pg8::Unit& u, int wr, int wc, int fr, int fq) const {
        const int row0 = u.pm * 256 + wr * 64 + fr, col0 = u.pn * 256 + wc * 32 + 8 * fq;
#pragma unroll
        for (int ai = 0; ai < 2; ++ai)
#pragma unroll
            for (int m = 0; m < 4; ++m) {
                const int row = row0 + ai * 128 + m * 16;
                const float* hp = H + (size_t)row * DM + col0;
                float ss = 0.f;
                float* op = nullptr;
                if (FINAL) {
                    if (row < MPR) { const int b = row / TP, t = row - b * TP; if (t >= NMETA) op = out + O_YP + ((size_t)b * SEQ + (t - NMETA)) * DM + col0; }
                    else if (row < MREAL) op = out + O_YS + (size_t)(row - MPR) * DM + col0;
                }
#pragma unroll
                for (int bj = 0; bj < 2; ++bj) {
                    const f32x4 h0 = *(const f32x4*)(hp + bj * 128), h1 = *(const f32x4*)(hp + bj * 128 + 4);
                    const f32x4 n0 = h0 + acc[ai][bj][m][0] * sc, n1 = h1 + acc[ai][bj][m][1] * sc;
                    if (FINAL) { if (op) { *(f32x4*)(op + bj * 128) = n0; *(f32x4*)(op + bj * 128 + 4) = n1; } }
                    else {
                        *(f32x4*)(H + (size_t)row * DM + col0 + bj * 128) = n0; *(f32x4*)(H + (size_t)row * DM + col0 + bj * 128 + 4) = n1;
                        v4u w; w.x = pk2(n0[0], n0[1]); w.y = pk2(n0[2], n0[3]); w.z = pk2(n1[0], n1[1]); w.w = pk2(n1[2], n1[3]);
                        *(v4u*)(AB + (size_t)row * DM + col0 + bj * 128) = w;
                        ss += (n0[0] * n0[0] + n0[1] * n0[1]) + (n0[2] * n0[2] + n0[3] * n0[3]) + (n1[0] * n1[0] + n1[1] * n1[1]) + (n1[2] * n1[2] + n1[3] * n1[3]);
                    }
                }
                if (!FINAL) { ss += __shfl_xor(ss, 16); ss += __shfl_xor(ss, 32); if (fq == 0) ssq[(size_t)row * 32 + u.pn * 4 + wc] = ss; }
            }
    }
};
struct EpiQkvo {
    static constexpr bool PERM = true, AFTER_DRAIN = false;
    bf16* O; const float* ssq; float* gates; const float* bias;
    __device__ __forceinline__ void operator()(const f32x4 (&acc)[2][2][4][2], const pg8::Unit& u, int wr, int wc, int fr, int fq) const {
        const int row0 = u.pm * 256 + wr * 64 + fr, col0 = u.pn * 256 + wc * 32 + 8 * fq;
        const bool gate_tile = (u.pn == NAIN / 256);
        f32x4 bi = (f32x4){0.f, 0.f, 0.f, 0.f}, bf = bi;
        if (gate_tile) { bi = *(const f32x4*)bias; bf = *(const f32x4*)(bias + 4); }
#pragma unroll
        for (int ai = 0; ai < 2; ++ai)
#pragma unroll
            for (int m = 0; m < 4; ++m) {
                const int row = row0 + ai * 128 + m * 16;
                const float r = row_rscale(ssq, row, fq);
                if (!gate_tile) {
#pragma unroll
                    for (int bj = 0; bj < 2; ++bj) { const f32x4 v0 = acc[ai][bj][m][0] * r, v1 = acc[ai][bj][m][1] * r;
                        v4u w; w.x = pk2(v0[0], v0[1]); w.y = pk2(v0[2], v0[3]); w.z = pk2(v1[0], v1[1]); w.w = pk2(v1[2], v1[3]);
                        *(v4u*)(O + (size_t)row * NAIN + col0 + bj * 128) = w; }
                } else if (wc == 0 && fq == 0) {
                    const f32x4 xi = acc[ai][0][m][0] * r + bi, xf = acc[ai][0][m][1] * r + bf;
                    f32x4 gi, gf;
#pragma unroll
                    for (int j = 0; j < 4; ++j) { gi[j] = 15.0f * tanhf(xi[j] * (1.0f / 15.0f)); const float c = 15.0f * tanhf(xf[j] * (1.0f / 15.0f));
                        gf[j] = fminf(c, 0.f) - log1pf(expf(-fabsf(c))); }
                    *(f32x4*)(gates + (size_t)row * 8) = gi; *(f32x4*)(gates + (size_t)row * 8 + 4) = gf;
                }
            }
    }
};
struct EpiHead {
    static constexpr bool PERM = true, AFTER_DRAIN = false;
    bf16* O0; int ld0; bf16* O1; int ld1; int norm_tiles; const float* ssq; const float* gain; float post;
    __device__ __forceinline__ void operator()(const f32x4 (&acc)[2][2][4][2], const pg8::Unit& u, int wr, int wc, int fr, int fq) const {
        const int row0 = u.pm * 256 + wr * 64 + fr;
        const bool normed = u.pn < norm_tiles;
        bf16* base = normed ? O0 + (size_t)u.pn * 256 : O1 + (size_t)(u.pn - norm_tiles) * 256;
        const int ld = normed ? ld0 : ld1;
        f32x4 gn[2][2];
#pragma unroll
        for (int bj = 0; bj < 2; ++bj)
#pragma unroll
            for (int n = 0; n < 2; ++n) gn[bj][n] = normed ? *(const f32x4*)(gain + 32 * bj + 8 * fq + 4 * n) * post : (f32x4){1.f, 1.f, 1.f, 1.f};
#pragma unroll
        for (int ai = 0; ai < 2; ++ai)
#pragma unroll
            for (int m = 0; m < 4; ++m) {
                const int row = row0 + ai * 128 + m * 16;
                const float r = row_rscale(ssq, row, fq);
                f32x4 x[2][2]; float ms = 0.f;
#pragma unroll
                for (int bj = 0; bj < 2; ++bj)
#pragma unroll
                    for (int n = 0; n < 2; ++n) { x[bj][n] = acc[ai][bj][m][n] * r; const f32x4 q = x[bj][n] * x[bj][n]; ms += (q[0] + q[1]) + (q[2] + q[3]); }
                ms += __shfl_xor(ms, 16); ms += __shfl_xor(ms, 32);
                const float inv = normed ? rsqrtf(ms * (1.0f / 64.0f) + EPS) : 1.0f;
#pragma unroll
                for (int bj = 0; bj < 2; ++bj) { const f32x4 v0 = x[bj][0] * inv * gn[bj][0], v1 = x[bj][1] * inv * gn[bj][1];
                    v4u w; w.x = pk2(v0[0], v0[1]); w.y = pk2(v0[2], v0[3]); w.z = pk2(v1[0], v1[1]); w.w = pk2(v1[2], v1[3]);
                    *(v4u*)(base + (size_t)row * ld + wc * 64 + 32 * bj + 8 * fq) = w; }
            }
    }
};

struct Args { const float* in[25]; float* out; unsigned char* ws; };
enum { I_XP = 0, I_XS, I_SC, I_SN, I_SM, I_CKM, I_CVM, I_CKW, I_CVW, I_META, I_FFNN, I_WFI, I_WFO, I_MIXN, I_WAI, I_BAG, I_AHN, I_WAO, I_KVN, I_WKV, I_KN, I_WQ, I_QN, I_SINK, I_WBO };
struct CvtItem { const float* lp; const float* gain; bf16* dp; int ldw; int valid; float scale; int K; };
constexpr int IT_W1 = (DM / 64) * (2 * DFF / 64), IT_W2 = (DFF / 64) * (DM / 64), IT_AIN = (DM / 64) * (NAIN_PAD / 64), IT_SQ = (DM / 64) * (DM / 64), IT_KV = (DM / 64) * (512 / 64);
constexpr int CVT_NITEMS = 4 * IT_W1 + 4 * IT_W2 + IT_AIN + IT_SQ + IT_KV + IT_SQ + IT_SQ;
__device__ __forceinline__ CvtItem cvt_decode(const Args& a, int it, int lane) {
    unsigned char* ws = a.ws; const int l16 = lane & 15, q = lane >> 4, nl = 4 * l16;
    CvtItem c; c.valid = 1; c.scale = 1.0f; c.gain = nullptr;
    int r = it, kb, n0, col; const float* W; bf16* dst;
    if (r < 4 * IT_W1) { const int f = r / IT_W1; r -= f * IT_W1; const int nblk = 2 * DFF / 64; kb = r / nblk; n0 = 64 * (r % nblk); const int tile = n0 >> 8, within = (n0 & 255) + nl;
        col = within < 128 ? 128 * tile + within : DFF + 128 * tile + (within - 128);
        W = a.in[I_WFI] + (size_t)f * DM * 2 * DFF; c.ldw = 2 * DFF; c.K = DM; c.gain = a.in[I_FFNN] + f * DM; dst = (bf16*)(ws + WS_W1 + f * SZ_W1); }
    else if ((r -= 4 * IT_W1) < 4 * IT_W2) { const int f = r / IT_W2; r -= f * IT_W2; const int nblk = DM / 64; kb = r / nblk; n0 = 64 * (r % nblk); col = n0 + nl;
        W = a.in[I_WFO] + (size_t)f * DFF * DM; c.ldw = DM; c.K = DFF; dst = (bf16*)(ws + WS_W2 + f * SZ_W2); }
    else if ((r -= 4 * IT_W2) < IT_AIN) { const int nblk = NAIN_PAD / 64; kb = r / nblk; n0 = 64 * (r % nblk); col = n0 + nl;
        c.valid = col < NAIN + 8 ? 1 : 0; if (!c.valid) col = 0; c.scale = (n0 >= 1024 && n0 < 2048) ? 0.0625f : 1.0f;
        W = a.in[I_WAI]; c.ldw = NAIN + 8; c.K = DM; c.gain = a.in[I_MIXN]; dst = (bf16*)(ws + WS_WAIN); }
    else if ((r -= IT_AIN) < IT_SQ) { const int nblk = DM / 64; kb = r / nblk; n0 = 64 * (r % nblk); col = n0 + nl; W = a.in[I_WAO]; c.ldw = DM; c.K = DM; dst = (bf16*)(ws + WS_WAOUT); }
    else if ((r -= IT_SQ) < IT_KV) { const int nblk = 512 / 64; kb = r / nblk; n0 = 64 * (r % nblk); const int d = n0 + nl, tile = d >> 8, within = d & 255, bj = within >> 7, wc = (within >> 5) & 3;
        col = 256 * tile + 64 * wc + 32 * bj + (within & 31); W = a.in[I_WKV]; c.ldw = 512; c.K = DM; c.gain = a.in[I_KVN]; dst = (bf16*)(ws + WS_WKV); }
    else if ((r -= IT_KV) < IT_SQ) { const int nblk = DM / 64; kb = r / nblk; n0 = 64 * (r % nblk); const int d = n0 + nl, tile = d >> 8, within = d & 255, bj = within >> 7, wc = (within >> 5) & 3;
        col = 256 * tile + 64 * wc + 32 * bj + (within & 31); W = a.in[I_WQ]; c.ldw = DM; c.K = DM; c.gain = a.in[I_MIXN] + DM; dst = (bf16*)(ws + WS_WQ); }
    else { r -= IT_SQ; const int nblk = DM / 64; kb = r / nblk; n0 = 64 * (r % nblk); col = n0 + nl; W = a.in[I_WBO]; c.ldw = DM; c.K = DM; dst = (bf16*)(ws + WS_WBO); }
    c.lp = W + (size_t)(64 * kb + q) * c.ldw + col;
    if (c.gain) c.gain += 64 * kb;
    c.dp = dst + (size_t)n0 * c.K + 64 * kb;
    return c;
}
__device__ __forceinline__ void cvt_load(const CvtItem& c, f32x4 (&r)[16]) {
#pragma unroll
    for (int i = 0; i < 16; ++i) r[i] = c.valid ? *(const f32x4*)(c.lp + (size_t)(4 * i) * c.ldw) : (f32x4){0.f, 0.f, 0.f, 0.f};
}
__device__ __forceinline__ void cvt_store(const CvtItem& c, const f32x4 (&r)[16], LAS float* scr, int lane) {
    const int l16 = lane & 15, q = lane >> 4;
#pragma unroll
    for (int i = 0; i < 16; ++i) { LAS float* s = scr + (4 * i + q) * 65 + 4 * l16; s[0] = r[i][0]; s[1] = r[i][1]; s[2] = r[i][2]; s[3] = r[i][3]; }
    LDS_WAIT(); asm volatile("" ::: "memory");
    const int ch = lane & 7;
    f32x4 g0 = (f32x4){c.scale, c.scale, c.scale, c.scale}, g1 = g0;
    if (c.gain) { g0 = *(const f32x4*)(c.gain + 8 * ch) * c.scale; g1 = *(const f32x4*)(c.gain + 8 * ch + 4) * c.scale; }
#pragma unroll
    for (int j = 0; j < 8; ++j) { const int n = (lane >> 3) + 8 * j; const LAS float* s = scr + (8 * ch) * 65 + n;
        v4u o; o.x = pk2(s[0 * 65] * g0[0], s[1 * 65] * g0[1]); o.y = pk2(s[2 * 65] * g0[2], s[3 * 65] * g0[3]); o.z = pk2(s[4 * 65] * g1[0], s[5 * 65] * g1[1]); o.w = pk2(s[6 * 65] * g1[2], s[7 * 65] * g1[3]);
        *(v4u*)(c.dp + (size_t)n * c.K + 8 * ch) = o; }
    LDS_WAIT(); asm volatile("" ::: "memory");
}

__device__ __forceinline__ void p0_prologue(const Args& a, LAS unsigned char* lds, int gw, int NGW, int wave, int lane) {
    LAS float* scr = (LAS float*)(lds + wave * 16640);
    unsigned char* ws = a.ws;
    {
        f32x4 r0[16], r1[16]; int it = gw;
        if (it < CVT_NITEMS) {
            CvtItem c0 = cvt_decode(a, it, lane); CvtItem c1 = cvt_decode(a, it, lane); cvt_load(c0, r0);
            for (;;) {
                it += NGW; const bool h1 = it < CVT_NITEMS; if (h1) { c1 = cvt_decode(a, it, lane); cvt_load(c1, r1); }
                cvt_store(c0, r0, scr, lane);
                if (!h1) break;
                it += NGW; const bool h0 = it < CVT_NITEMS; if (h0) { c0 = cvt_decode(a, it, lane); cvt_load(c0, r0); }
                cvt_store(c1, r1, scr, lane);
                if (!h0) break;
            }
        }
    }
    float* H = (float*)(ws + WS_H); bf16* AB = (bf16*)(ws + WS_AB); float* SSQ = (float*)(ws + WS_SSQ);
    for (int row = gw; row < MP; row += NGW) {
        const float* src = nullptr;
        if (row < MPR) { const int b = row / TP, t = row - b * TP; src = t < NMETA ? a.in[I_META] + (size_t)t * DM : a.in[I_XP] + ((size_t)b * SEQ + (t - NMETA)) * DM; }
        else if (row < MREAL) src = a.in[I_XS] + (size_t)(row - MPR) * DM;
        float ss = 0.f;
#pragma unroll
        for (int j = 0; j < 4; ++j) {
            f32x4 v0 = (f32x4){0.f, 0.f, 0.f, 0.f}, v1 = v0;
            if (src) { v0 = *(const f32x4*)(src + 512 * j + 8 * lane); v1 = *(const f32x4*)(src + 512 * j + 8 * lane + 4); }
            *(f32x4*)(H + (size_t)row * DM + 512 * j + 8 * lane) = v0; *(f32x4*)(H + (size_t)row * DM + 512 * j + 8 * lane + 4) = v1;
            v4u w; w.x = pk2(v0[0], v0[1]); w.y = pk2(v0[2], v0[3]); w.z = pk2(v1[0], v1[1]); w.w = pk2(v1[2], v1[3]);
            *(v4u*)(AB + (size_t)row * DM + 512 * j + 8 * lane) = w;
            ss += (v0[0] * v0[0] + v0[1] * v0[1]) + (v0[2] * v0[2] + v0[3] * v0[3]) + (v1[0] * v1[0] + v1[1] * v1[1]) + (v1[2] * v1[2] + v1[3] * v1[3]);
        }
        ss = wave_sum(ss);
        if (lane < 32) SSQ[(size_t)row * 32 + lane] = lane == 0 ? ss : 0.f;
    }
}

constexpr int ML_KN = 0, ML_KNS = 272, ML_KT = 34816, ML_KTS = 272, ML_VT = 69632, ML_VTS = 272, ML_CTB = ML_VT + 80 * 272  , ML_CTBS = 528, ML_GA = ML_CTB + 80 * 528  ;
static_assert(ML_GA + 2816 <= SCR_BYTES, "mLSTM LDS map");

#define ML_HALF(DH) do { \
    _Pragma("unroll") for (int jb = 0; jb < 8; ++jb) _Pragma("unroll") for (int ks = 0; ks < 4; ++ks) { \
        const bf16x8 af = *(const LAS bf16x8*)(lds + ML_KN + (16 * jb + i16) * ML_KNS + (32 * ks + 8 * g) * 2); as_[jb] = MFMA16(af, qf[4 * (DH) + ks], as_[jb]); } \
    _Pragma("unroll") for (int vb = 0; vb < 5; ++vb) accC[DH][vb] = accC[DH][vb] * decay; \
    _Pragma("unroll") for (int ks = 0; ks < 4; ++ks) { \
        const bf16x8 bfr = *(const LAS bf16x8*)(lds + ML_KT + (16 * wave + i16) * ML_KTS + (32 * ks + 8 * g) * 2); \
        _Pragma("unroll") for (int vb = 0; vb < 5; ++vb) { const bf16x8 afr = *(const LAS bf16x8*)(lds + ML_VT + (16 * vb + i16) * ML_VTS + (32 * ks + 8 * g) * 2); accC[DH][vb] = MFMA16(afr, bfr, accC[DH][vb]); } } \
} while (0)
#define ML_PUT_CTB(DH) do { _Pragma("unroll") for (int vb = 0; vb < 5; ++vb) _Pragma("unroll") for (int r = 0; r < 4; ++r) \
    *(LAS bf16*)(lds + ML_CTB + (16 * vb + 4 * g + r) * ML_CTBS + (128 * (DH) + 16 * wave + i16) * 2) = (bf16)(pk2(accC[DH][vb][r], 0.f) & 0xffffu); } while (0)
#define ML_LOAD_K(DH) do { _Pragma("unroll") for (int it = 0; it < 2; ++it) { const int dc = wave + 8 * it; \
    const bf16* kp = QKVO + (rowbase + 2 * lane) * NAIN + 1024 + h * ADK + 128 * (DH) + 8 * dc; \
    const v4u r0 = *(const v4u*)kp, r1 = *(const v4u*)(kp + NAIN); \
    *(LAS v4u*)(lds + ML_KN + (2 * lane) * ML_KNS + 16 * dc) = r0; *(LAS v4u*)(lds + ML_KN + (2 * lane + 1) * ML_KNS + 16 * dc) = r1; \
    const float w0 = ga[512 + 2 * lane], w1 = ga[512 + 2 * lane + 1]; \
    _Pragma("unroll") for (int e = 0; e < 8; ++e) *(LAS unsigned*)(lds + ML_KT + (8 * dc + e) * ML_KTS + 4 * lane) = pk2(__uint_as_float(bfel(r0, e) << 16) * w0, __uint_as_float(bfel(r1, e) << 16) * w1); } } while (0)

__device__ __forceinline__ void mlstm_prompt_unit(LAS unsigned char* lds, const bf16* QKVO, const float* GATES, float* HM, float* HSSQ, float* out, int b, int h, int j, int tid, int wave, int lane) {
    const int i16 = lane & 15, g = lane >> 4;
    LAS float* ga = (LAS float*)(lds + ML_GA);
    f32x4 accC[2][5];
#pragma unroll
    for (int dh = 0; dh < 2; ++dh)
#pragma unroll
        for (int vb = 0; vb < 5; ++vb) accC[dh][vb] = (f32x4){0.f, 0.f, 0.f, 0.f};
    __syncthreads();
    for (int o = tid * 16; o < 80 * ML_CTBS; o += 512 * 16) *(LAS v4u*)(lds + ML_CTB + o) = (v4u){0u, 0u, 0u, 0u};
    for (int o = tid; o < 16 * 64; o += 512) { const int rr = o >> 6, cc = o & 63; *(LAS unsigned*)(lds + ML_VT + (64 + rr) * ML_VTS + cc * 4) = rr == 0 ? 0x3F803F80u : 0u; }
    float m_prev = 0.f;
    for (int c = 0; c < 17; ++c) {
        const int tok0 = c == 0 ? 0 : NMETA + 128 * (c - 1), nvalid = c == 0 ? NMETA : 128;
        const size_t rowbase = (size_t)b * TP + tok0;
        __syncthreads();
        bf16x8 qf[8];
        { const bf16* qp = QKVO + (rowbase + 16 * wave + i16) * NAIN + h * ADK + 8 * g;
#pragma unroll
          for (int ks = 0; ks < 8; ++ks) qf[ks] = *(const bf16x8*)(qp + 32 * ks); }
        if (wave == 0) {
            const int t0 = 2 * lane, t1 = t0 + 1;
            float ig0 = -1e30f, ig1 = -1e30f, lf0 = 0.f, lf1 = 0.f;
            if (t0 < nvalid) { const float* gp = GATES + (rowbase + t0) * 8; ig0 = gp[h]; lf0 = gp[4 + h]; }
            if (t1 < nvalid) { const float* gp = GATES + (rowbase + t1) * 8; ig1 = gp[h]; lf1 = gp[4 + h]; }
            const float c1 = lf0 + lf1; float sc = c1;
#pragma unroll
            for (int o = 1; o < 64; o <<= 1) { const float t = __shfl_up(sc, o); if (lane >= o) sc += t; }
            const float excl = sc - c1, b0 = excl + lf0, b1 = excl + c1;
            const float a0 = ig0 - b0, a1 = ig1 - b1;
            float smx = fmaxf(a0, a1);
#pragma unroll
            for (int o = 1; o < 64; o <<= 1) { const float t = __shfl_up(smx, o); if (lane >= o) smx = fmaxf(smx, t); }
            float exm = __shfl_up(smx, 1); if (lane == 0) exm = -INFINITY;
            const float p0 = fmaxf(exm, a0), p1 = fmaxf(p0, a1);
            const float pm0 = fmaxf(m_prev, p0), pm1 = fmaxf(m_prev, p1);
            const float Mx = fmaxf(m_prev, __shfl(smx, 63)), blast = __shfl(b1, 63);
            ga[t0] = a0; ga[t1] = a1; ga[128 + t0] = pm0; ga[128 + t1] = pm1;
            ga[256 + t0] = __expf(m_prev - pm0); ga[256 + t1] = __expf(m_prev - pm1);
            ga[384 + t0] = __expf(-(b0 + pm0)); ga[384 + t1] = __expf(-(b1 + pm1));
            ga[512 + t0] = __expf(a0 - Mx); ga[512 + t1] = __expf(a1 - Mx);
            if (lane == 0) ga[640] = __expf(m_prev - Mx);
            m_prev = blast + Mx;
        }
        __syncthreads();
        {
            const bf16* vp = QKVO + (rowbase + 2 * lane) * NAIN + 2048 + h * ADV + 64 * j + 8 * wave;
            const v4u r0 = *(const v4u*)vp, r1 = *(const v4u*)(vp + NAIN);
#pragma unroll
            for (int e = 0; e < 8; ++e) *(LAS unsigned*)(lds + ML_VT + (8 * wave + e) * ML_VTS + 4 * lane) = bfel(r0, e) | (bfel(r1, e) << 16);
        }
        ML_LOAD_K(0);
        __syncthreads();
        const float decay = ga[640];
        f32x4 aqc[5], as_[8];
#pragma unroll
        for (int vb = 0; vb < 5; ++vb) { aqc[vb] = (f32x4){0.f, 0.f, 0.f, 0.f};
#pragma unroll
            for (int ks = 0; ks < 8; ++ks) { const bf16x8 bfr = *(const LAS bf16x8*)(lds + ML_CTB + (16 * vb + i16) * ML_CTBS + (32 * ks + 8 * g) * 2); aqc[vb] = MFMA16(qf[ks], bfr, aqc[vb]); } }
#pragma unroll
        for (int jb = 0; jb < 8; ++jb) as_[jb] = (f32x4){0.f, 0.f, 0.f, 0.f};
        ML_HALF(0);
        __syncthreads();
        ML_PUT_CTB(0);
        ML_LOAD_K(1);
        __syncthreads();
        ML_HALF(1);
        ML_PUT_CTB(1);
        const int tl = 16 * wave + i16; const float pmt = ga[128 + tl];
        bf16x8 pf[4];
#pragma unroll
        for (int kk = 0; kk < 4; ++kk) { float pv[8];
#pragma unroll
            for (int hb = 0; hb < 2; ++hb) { const int jb = 2 * kk + hb; const f32x4 av = *(const LAS f32x4*)(ga + 16 * jb + 4 * g);
#pragma unroll
                for (int r = 0; r < 4; ++r) { const int s = 16 * jb + 4 * g + r; const float wgt = (s <= tl) ? __expf(av[r] - pmt) : 0.f; pv[4 * hb + r] = as_[jb][r] * wgt; } }
            v4u w; w.x = pk2(pv[0], pv[1]); w.y = pk2(pv[2], pv[3]); w.z = pk2(pv[4], pv[5]); w.w = pk2(pv[6], pv[7]); pf[kk] = __builtin_bit_cast(bf16x8, w); }
        f32x4 apv[5];
#pragma unroll
        for (int vb = 0; vb < 5; ++vb) { apv[vb] = (f32x4){0.f, 0.f, 0.f, 0.f};
#pragma unroll
            for (int kk = 0; kk < 4; ++kk) { const LAS unsigned char* vp = lds + ML_VT + (16 * vb + i16) * ML_VTS + (32 * kk + 4 * g) * 2;
                const v2u lo = *(const LAS v2u*)vp, hi = *(const LAS v2u*)(vp + 32); const v4u w = (v4u){lo.x, lo.y, hi.x, hi.y};
                apv[vb] = MFMA16(pf[kk], __builtin_bit_cast(bf16x8, w), apv[vb]); } }
        const f32x4 wi4 = *(const LAS f32x4*)(ga + 256 + 16 * wave + 4 * g), ef4 = *(const LAS f32x4*)(ga + 384 + 16 * wave + 4 * g);
#pragma unroll
        for (int r = 0; r < 4; ++r) { const int tr = 16 * wave + 4 * g + r; const float wi = wi4[r];
            float den = apv[4][r] + wi * aqc[4][r]; den = __shfl(den, lane & 48); den = fmaxf(fabsf(den), ef4[r]);
            const float inv = 1.0f / den; float ss = 0.f; const bool ok = tr < nvalid;
#pragma unroll
            for (int vb = 0; vb < 4; ++vb) { const float hv = (apv[vb][r] + wi * aqc[vb][r]) * inv; ss += hv * hv;
                if (ok) HM[(rowbase + tr) * DM + h * ADV + 64 * j + 16 * vb + i16] = hv; }
            ss += __shfl_xor(ss, 1); ss += __shfl_xor(ss, 2); ss += __shfl_xor(ss, 4); ss += __shfl_xor(ss, 8);
            if (ok && i16 == 0) HSSQ[(rowbase + tr) * 32 + h * 8 + j] = ss; }
    }
    const size_t bh = (size_t)b * AH + h;
#pragma unroll
    for (int dh = 0; dh < 2; ++dh) { const int d = 128 * dh + 16 * wave + i16;
#pragma unroll
        for (int vb = 0; vb < 4; ++vb) *(f32x4*)(out + O_CP + (bh * ADK + d) * ADV + 64 * j + 16 * vb + 4 * g) = accC[dh][vb];
        if (j == 0 && g == 0) out[O_NP + bh * ADK + d] = accC[dh][4][0]; }
    if (j == 0 && tid == 0) out[O_MP + bh] = m_prev;
}

__device__ __forceinline__ void mlstm_sample_unit(LAS unsigned char* lds, const bf16* QKVO, const float* GATES, const float* stC, const float* stN, const float* stM,
                                                  float* HM, float* HSSQ, float* out, int b, int h, int tid, int wave, int lane) {
    LAS float* qT = (LAS float*)lds;
    LAS float* wkT = (LAS float*)(lds + 4096);
    LAS float* qN = (LAS float*)(lds + 8192);
    LAS float* kN = (LAS float*)(lds + 12288);
    LAS float* dots = (LAS float*)(lds + 16384);
    LAS float* red = (LAS float*)(lds + 16640);
    const int row0 = MPR + DECS * b; const size_t bh = (size_t)b * AH + h;
    float ig[4], bb[4], a_[4], pm[4], wint[4], efl[4], wst[4];
    const float mprev = stM[bh];
    { float run = 0.f, pmax = -INFINITY;
#pragma unroll
      for (int s = 0; s < 4; ++s) { ig[s] = GATES[(size_t)(row0 + s) * 8 + h]; run += GATES[(size_t)(row0 + s) * 8 + 4 + h]; bb[s] = run; a_[s] = ig[s] - bb[s]; pmax = fmaxf(pmax, a_[s]);
          pm[s] = fmaxf(mprev, pmax); wint[s] = __expf(mprev - pm[s]); efl[s] = __expf(-(bb[s] + pm[s])); } }
    const float Mx = pm[3], decay = __expf(mprev - Mx), mnew = bb[3] + Mx;
#pragma unroll
    for (int s = 0; s < 4; ++s) wst[s] = __expf(a_[s] - Mx);
    __syncthreads();
    { const int s = tid >> 7, d2 = (tid & 127) * 2; const bf16* qp = QKVO + (size_t)(row0 + s) * NAIN + h * ADK + d2;
      const unsigned qq = *(const unsigned*)qp, kk = *(const unsigned*)(qp + 1024);
      const float q0 = bflo(qq), q1 = bfhi(qq), k0 = bflo(kk), k1 = bfhi(kk);
      const float w = s == 0 ? wst[0] : s == 1 ? wst[1] : s == 2 ? wst[2] : wst[3];
      qT[d2 * 4 + s] = q0; qT[(d2 + 1) * 4 + s] = q1; wkT[d2 * 4 + s] = w * k0; wkT[(d2 + 1) * 4 + s] = w * k1;
      qN[s * 256 + d2] = q0; qN[s * 256 + d2 + 1] = q1; kN[s * 256 + d2] = k0; kN[s * 256 + d2 + 1] = k1; }
    __syncthreads();
    for (int x = wave; x < 20; x += 8) { float p = 0.f;
        if (x < 16) { const int t = x >> 2, s = x & 3;
#pragma unroll
            for (int i = 0; i < 4; ++i) p += qN[t * 256 + lane + 64 * i] * kN[s * 256 + lane + 64 * i]; }
        else { const int t = x - 16;
#pragma unroll
            for (int i = 0; i < 4; ++i) p += qN[t * 256 + lane + 64 * i] * stN[bh * ADK + lane + 64 * i]; }
        p = wave_sum(p); if (lane == 0) dots[x] = p; }
    __syncthreads();
    float P[4][4], deninv[4];
#pragma unroll
    for (int t = 0; t < 4; ++t) { float den = 0.f;
#pragma unroll
        for (int s = 0; s < 4; ++s) { P[t][s] = s <= t ? dots[4 * t + s] * __expf(a_[s] - pm[t]) : 0.f; den += P[t][s]; }
        den += wint[t] * dots[16 + t]; deninv[t] = 1.0f / fmaxf(fabsf(den), efl[t]); }
    const int eq = tid & 127, dq = tid >> 7;
    f32x4 vv[4];
#pragma unroll
    for (int s = 0; s < 4; ++s) { const v2u w = *(const v2u*)(QKVO + (size_t)(row0 + s) * NAIN + 2048 + h * ADV + 4 * eq); vv[s] = (f32x4){bflo(w.x), bfhi(w.x), bflo(w.y), bfhi(w.y)}; }
    f32x4 qc[4];
#pragma unroll
    for (int t = 0; t < 4; ++t) qc[t] = (f32x4){0.f, 0.f, 0.f, 0.f};
    const float* Cin = stC + bh * ADK * ADV + 4 * eq; float* Cout = out + O_CS + bh * ADK * ADV + 4 * eq;
#pragma unroll 8
    for (int dd = 0; dd < 64; ++dd) { const int d = 64 * dq + dd;
        const f32x4 c = *(const f32x4*)(Cin + (size_t)d * ADV); const f32x4 q4 = *(const LAS f32x4*)(qT + 4 * d), k4 = *(const LAS f32x4*)(wkT + 4 * d);
#pragma unroll
        for (int t = 0; t < 4; ++t) qc[t] += c * q4[t];
        *(f32x4*)(Cout + (size_t)d * ADV) = c * decay + vv[0] * k4[0] + vv[1] * k4[1] + vv[2] * k4[2] + vv[3] * k4[3]; }
#pragma unroll
    for (int t = 0; t < 4; ++t) *(LAS f32x4*)(red + (dq * 4 + t) * 512 + 4 * eq) = qc[t];
    __syncthreads();
    { const int e = tid; float ve[4];
#pragma unroll
      for (int s = 0; s < 4; ++s) ve[s] = __uint_as_float((unsigned)QKVO[(size_t)(row0 + s) * NAIN + 2048 + h * ADV + e] << 16);
#pragma unroll
      for (int t = 0; t < 4; ++t) { const float qcs = (red[(0 * 4 + t) * 512 + e] + red[(1 * 4 + t) * 512 + e]) + (red[(2 * 4 + t) * 512 + e] + red[(3 * 4 + t) * 512 + e]);
          float pvv = 0.f;
#pragma unroll
          for (int s = 0; s < 4; ++s) pvv += P[t][s] * ve[s];
          const float hv = (pvv + wint[t] * qcs) * deninv[t];
          HM[(size_t)(row0 + t) * DM + h * ADV + e] = hv;
          const float ss = wave_sum(hv * hv); if (lane == 0) HSSQ[(size_t)(row0 + t) * 32 + h * 8 + wave] = ss; } }
    if (tid < ADK) { const f32x4 k4 = *(const LAS f32x4*)(wkT + 4 * tid); out[O_NS + bh * ADK + tid] = decay * stN[bh * ADK + tid] + ((k4[0] + k4[1]) + (k4[2] + k4[3])); }
    if (tid == 0) out[O_MS + bh] = mnew;
}

__device__ __forceinline__ void mlstm_gate_rows(const float* HM, const float* HSSQ, const bf16* QKVO, const float* gain, bf16* AM, int gw, int NGW, int lane) {
    for (int row = gw; row < MREAL; row += NGW) {
#pragma unroll
        for (int i = 0; i < 4; ++i) {
            const f32x4 s0 = *(const f32x4*)(HSSQ + (size_t)row * 32 + 8 * i), s1 = *(const f32x4*)(HSSQ + (size_t)row * 32 + 8 * i + 4);
            const float rs = rsqrtf((((s0[0] + s0[1]) + (s0[2] + s0[3])) + ((s1[0] + s1[1]) + (s1[2] + s1[3]))) * (1.0f / ADV) + EPS);
            const int c = 512 * i + 8 * lane;
            const f32x4 h0 = *(const f32x4*)(HM + (size_t)row * DM + c), h1 = *(const f32x4*)(HM + (size_t)row * DM + c + 4);
            const f32x4 g0 = *(const f32x4*)(gain + c), g1 = *(const f32x4*)(gain + c + 4);
            const v4u ow = *(const v4u*)(QKVO + (size_t)row * NAIN + 4096 + c);
            float o[8];
#pragma unroll
            for (int e = 0; e < 8; ++e) { const float ov = __uint_as_float(bfel(ow, e) << 16); const float sg = __builtin_amdgcn_rcpf(1.0f + __expf(-ov));
                const float hv = e < 4 ? h0[e & 3] * g0[e & 3] : h1[e & 3] * g1[e & 3]; o[e] = hv * rs * sg; }
            v4u w; w.x = pk2(o[0], o[1]); w.y = pk2(o[2], o[3]); w.z = pk2(o[4], o[5]); w.w = pk2(o[6], o[7]);
            *(v4u*)(AM + (size_t)row * DM + c) = w;
        }
    }
}

template <int NKEY> struct AttnLds { static constexpr int KNS = 144, KN = 0, VT = NKEY * 144, VTS = NKEY * 2 + 16, END = VT + 64 * VTS; };

template <int NKEY, class MaskF>
__device__ __forceinline__ void attn_tblock(LAS unsigned char* lds, const bf16* qlane  , float slope, float sink, const MaskF& mask,
                                            bf16* orow  , int nq_valid, int lane) {
    typedef AttnLds<NKEY> L; constexpr int NJB = NKEY / 16;
    const int i16 = lane & 15, g = lane >> 4;
    bf16x8 qf[2];
    qf[0] = *(const bf16x8*)qlane; qf[1] = *(const bf16x8*)(qlane + 32);
    f32x4 sacc[NJB];
#pragma unroll
    for (int jb = 0; jb < NJB; ++jb) { sacc[jb] = (f32x4){0.f, 0.f, 0.f, 0.f};
#pragma unroll
        for (int ks = 0; ks < 2; ++ks) { const bf16x8 af = *(const LAS bf16x8*)(lds + L::KN + (16 * jb + i16) * L::KNS + (32 * ks + 8 * g) * 2); sacc[jb] = MFMA16(af, qf[ks], sacc[jb]); } }
    float mx = sink;
#pragma unroll
    for (int jb = 0; jb < NJB; ++jb)
#pragma unroll
        for (int r = 0; r < 4; ++r) { float dist; const bool ok = mask(16 * jb + 4 * g + r, i16, dist); const float sv = ok ? sacc[jb][r] - slope * dist : -INFINITY; sacc[jb][r] = sv; mx = fmaxf(mx, sv); }
    mx = fmaxf(mx, __shfl_xor(mx, 16)); mx = fmaxf(mx, __shfl_xor(mx, 32));
    float sum = 0.f;
#pragma unroll
    for (int jb = 0; jb < NJB; ++jb)
#pragma unroll
        for (int r = 0; r < 4; ++r) { const float p = __expf(sacc[jb][r] - mx); sacc[jb][r] = p; sum += p; }
    sum += __shfl_xor(sum, 16); sum += __shfl_xor(sum, 32);
    sum += __expf(sink - mx);
    const float inv = 1.0f / sum;
    f32x4 oacc[4];
#pragma unroll
    for (int db = 0; db < 4; ++db) oacc[db] = (f32x4){0.f, 0.f, 0.f, 0.f};
#pragma unroll
    for (int kk = 0; kk < NJB / 2; ++kk) {
        v4u w; w.x = pk2(sacc[2 * kk][0], sacc[2 * kk][1]); w.y = pk2(sacc[2 * kk][2], sacc[2 * kk][3]); w.z = pk2(sacc[2 * kk + 1][0], sacc[2 * kk + 1][1]); w.w = pk2(sacc[2 * kk + 1][2], sacc[2 * kk + 1][3]);
        const bf16x8 pf = __builtin_bit_cast(bf16x8, w);
#pragma unroll
        for (int db = 0; db < 4; ++db) { const LAS unsigned char* vp = lds + L::VT + (16 * db + i16) * L::VTS + (32 * kk + 4 * g) * 2;
            const v2u lo = *(const LAS v2u*)vp, hi = *(const LAS v2u*)(vp + 32); const v4u bw = (v4u){lo.x, lo.y, hi.x, hi.y};
            oacc[db] = MFMA16(pf, __builtin_bit_cast(bf16x8, bw), oacc[db]); } }
#pragma unroll
    for (int r = 0; r < 4; ++r) { const float ir = __shfl(inv, 4 * g + r);
        if (4 * g + r < nq_valid) {
#pragma unroll
            for (int db = 0; db < 4; ++db) orow[(size_t)(4 * g + r) * DM + 16 * db + i16] = (bf16)(pk2(oacc[db][r] * ir, 0.f) & 0xffffu); } }
}

struct MaskPrompt { int tpos0  , band0  ;
    __device__ __forceinline__ bool operator()(int kk, int tq, float& dist) const {
        const int tpos = tpos0 + tq;
        if (kk < NMETA) { dist = (float)WIN; return tpos - kk >= WIN; }
        const int pos = band0 + kk - NMETA, rel = tpos - pos; dist = (float)rel;
        return kk < NMETA + 256 && rel >= 0 && rel < WIN && pos >= 0 && pos < TP; } };
struct MaskSample {
    __device__ __forceinline__ bool operator()(int kk, int tq, float& dist) const {
        if (kk < NMETA) { dist = (float)WIN; return true; }
        if (kk < NMETA + WIN) { const int rel = WIN + tq - (kk - NMETA); dist = (float)rel; return rel >= 0 && rel < WIN; }
        const int rel = tq - (kk - NMETA - WIN); dist = (float)rel; return kk < NMETA + WIN + DECS && rel >= 0; } };

__device__ __forceinline__ void attn_prompt_unit(LAS unsigned char* lds, const bf16* QB, const bf16* KB, const bf16* VB, const float* sinks, bf16* AM, int b, int g, int n, int tid, int wave, int lane) {
    typedef AttnLds<288> L;
    __syncthreads();
    for (int it = tid; it < 288 * 8; it += 512) { const int kk = it >> 3, ch = it & 7;
        const int pos = kk < NMETA ? kk : 128 * (n - 1) + kk - NMETA; v4u r = (v4u){0u, 0u, 0u, 0u};
        if (kk < NMETA + 256 && pos >= 0 && pos < TP) r = *(const v4u*)(KB + ((size_t)b * TP + pos) * 256 + g * 64 + 8 * ch);
        *(LAS v4u*)(lds + L::KN + kk * L::KNS + 16 * ch) = r; }
    for (int it = tid; it < 144 * 8; it += 512) { const int ch = it / 144, p = it - ch * 144; v4u r0 = (v4u){0u, 0u, 0u, 0u}, r1 = r0;
        { const int kk = 2 * p, pos = kk < NMETA ? kk : 128 * (n - 1) + kk - NMETA; if (kk < NMETA + 256 && pos >= 0 && pos < TP) r0 = *(const v4u*)(VB + ((size_t)b * TP + pos) * 256 + g * 64 + 8 * ch); }
        { const int kk = 2 * p + 1, pos = kk < NMETA ? kk : 128 * (n - 1) + kk - NMETA; if (kk < NMETA + 256 && pos >= 0 && pos < TP) r1 = *(const v4u*)(VB + ((size_t)b * TP + pos) * 256 + g * 64 + 8 * ch); }
#pragma unroll
        for (int e = 0; e < 8; ++e) *(LAS unsigned*)(lds + L::VT + (8 * ch + e) * L::VTS + 4 * p) = bfel(r0, e) | (bfel(r1, e) << 16); }
    __syncthreads();
    const int hh = 8 * g + wave; const float slope = exp2f(-0.25f * (float)(hh + 1)), sink = sinks[hh];
    for (int tb = 0; tb < 8; ++tb) { const int tpos0 = 128 * n + 16 * tb; if (tpos0 >= TP) break;
        const size_t row0 = (size_t)b * TP + tpos0;
        MaskPrompt mk{tpos0, 128 * (n - 1)};
        attn_tblock<288>(lds, QB + (row0 + (lane & 15)) * DM + hh * 64 + 8 * (lane >> 4), slope, sink, mk, AM + row0 * DM + hh * 64, 16, lane); }
}
__device__ __forceinline__ void attn_sample_unit(LAS unsigned char* lds, const bf16* QB, const bf16* KB, const bf16* VB, const float* ckm, const float* cvm, const float* ckw, const float* cvw,
                                                 const float* sinks, bf16* AM, int b, int g, int tid, int wave, int lane) {
    typedef AttnLds<160> L;
    __syncthreads();
    for (int it = tid; it < 160 * 8; it += 512) { const int kk = it >> 3, ch = it & 7; v4u r = (v4u){0u, 0u, 0u, 0u};
        if (kk < NMETA + WIN) { const float* src = kk < NMETA ? ckm + (((size_t)b * NMETA + kk) * BKV + g) * 64 + 8 * ch : ckw + (((size_t)b * WIN + (kk - NMETA)) * BKV + g) * 64 + 8 * ch;
            const f32x4 f0 = *(const f32x4*)src, f1 = *(const f32x4*)(src + 4); r.x = pk2(f0[0], f0[1]); r.y = pk2(f0[2], f0[3]); r.z = pk2(f1[0], f1[1]); r.w = pk2(f1[2], f1[3]); }
        else if (kk < NMETA + WIN + DECS) r = *(const v4u*)(KB + ((size_t)MPR + DECS * b + (kk - NMETA - WIN)) * 256 + g * 64 + 8 * ch);
        *(LAS v4u*)(lds + L::KN + kk * L::KNS + 16 * ch) = r; }
    for (int it = tid; it < 80 * 8; it += 512) { const int ch = it / 80, p = it - ch * 80; v4u rr[2];
#pragma unroll
        for (int q = 0; q < 2; ++q) { const int kk = 2 * p + q; v4u r = (v4u){0u, 0u, 0u, 0u};
            if (kk < NMETA + WIN) { const float* src = kk < NMETA ? cvm + (((size_t)b * NMETA + kk) * BKV + g) * 64 + 8 * ch : cvw + (((size_t)b * WIN + (kk - NMETA)) * BKV + g) * 64 + 8 * ch;
                const f32x4 f0 = *(const f32x4*)src, f1 = *(const f32x4*)(src + 4); r.x = pk2(f0[0], f0[1]); r.y = pk2(f0[2], f0[3]); r.z = pk2(f1[0], f1[1]); r.w = pk2(f1[2], f1[3]); }
            else if (kk < NMETA + WIN + DECS) r = *(const v4u*)(VB + ((size_t)MPR + DECS * b + (kk - NMETA - WIN)) * 256 + g * 64 + 8 * ch);
            rr[q] = r; }
#pragma unroll
        for (int e = 0; e < 8; ++e) *(LAS unsigned*)(lds + L::VT + (8 * ch + e) * L::VTS + 4 * p) = bfel(rr[0], e) | (bfel(rr[1], e) << 16); }
    __syncthreads();
    const int hh = 8 * g + wave; const float slope = exp2f(-0.25f * (float)(hh + 1)), sink = sinks[hh];
    const size_t row0 = (size_t)MPR + DECS * b;
    MaskSample mk;
    attn_tblock<160>(lds, QB + (row0 + (lane & 15)) * DM + hh * 64 + 8 * (lane >> 4), slope, sink, mk, AM + row0 * DM + hh * 64, DECS, lane);
}
__device__ __forceinline__ void kv_outputs(const Args& a, const bf16* KB, const bf16* VB, size_t gtid, size_t gthreads) {
    float* out = a.out;
    for (size_t i = gtid; i < (size_t)NBATCH * (NMETA + WIN) * 256; i += gthreads) { const int c = (int)(i & 255); const int rr = (int)(i >> 8); const int b = rr / (NMETA + WIN), q = rr - b * (NMETA + WIN);
        const int t = q < NMETA ? q : TP - WIN + (q - NMETA); const size_t src = ((size_t)b * TP + t) * 256 + c;
        const float kv = __uint_as_float((unsigned)KB[src] << 16), vv = __uint_as_float((unsigned)VB[src] << 16);
        if (q < NMETA) { out[O_KMP + ((size_t)b * NMETA + q) * 256 + c] = kv; out[O_VMP + ((size_t)b * NMETA + q) * 256 + c] = vv; }
        else { out[O_KWP + ((size_t)b * WIN + (q - NMETA)) * 256 + c] = kv; out[O_VWP + ((size_t)b * WIN + (q - NMETA)) * 256 + c] = vv; } }
    for (size_t i = gtid; i < (size_t)DECB * WIN * 64; i += gthreads) { const int c4 = (int)(i & 63) * 4; const int rr = (int)(i >> 6); const int b = rr >> 7, jj = rr & 127;
        f32x4 kv, vv;
        if (jj < WIN - DECS) { kv = *(const f32x4*)(a.in[I_CKW] + ((size_t)b * WIN + jj + DECS) * 256 + c4); vv = *(const f32x4*)(a.in[I_CVW] + ((size_t)b * WIN + jj + DECS) * 256 + c4); }
        else { const size_t src = ((size_t)MPR + DECS * b + (jj - (WIN - DECS))) * 256 + c4; const v2u kw = *(const v2u*)(KB + src), vw = *(const v2u*)(VB + src);
            kv = (f32x4){bflo(kw.x), bfhi(kw.x), bflo(kw.y), bfhi(kw.y)}; vv = (f32x4){bflo(vw.x), bfhi(vw.x), bflo(vw.y), bfhi(vw.y)}; }
        *(f32x4*)(out + O_KWS + ((size_t)b * WIN + jj) * 256 + c4) = kv; *(f32x4*)(out + O_VWS + ((size_t)b * WIN + jj) * 256 + c4) = vv; }
}

#define GEMM_PHASE(EPI_T, E, Aptr, Bptr, N_, K_) do { pg8::Gemm gg{(const pg8::bf16_t*)(Aptr), (const pg8::bf16_t*)(Bptr), MP, (N_), (K_)}; int bx_ = (int)blockIdx.x; asm volatile("" : "+s"(bx_)); pg8::StaticOrder SS; SS.init(MP, (N_), G, bx_); \
    pg8::gemm_phase<EPI_T, pg8::StaticOrder, true, true>(lds, gg, SS, (E)); } while (0)

__global__ void __launch_bounds__(NWAVES * 64, 2) yoco_fwd(Args args) {
    extern __shared__ __attribute__((aligned(16))) unsigned char lds_raw[];
    LAS unsigned char* lds = (LAS unsigned char*)lds_raw;
    volatile LAS unsigned* MISC = (volatile LAS unsigned*)(lds + MISC_OFF);
    const int tid = threadIdx.x, lane = tid & 63, wave = __builtin_amdgcn_readfirstlane(tid >> 6);
    const int G = gridDim.x, gw = blockIdx.x * NWAVES + wave, NGW = G * NWAVES;
    unsigned char* ws = args.ws;
    for (int u = tid; u < (LDS_BYTES - MISC_OFF) / 4; u += NWAVES * 64) ((LAS unsigned*)(lds + MISC_OFF))[u] = 0u;
    __syncthreads();
    XcdBarrier bar = xcd_barrier_post((unsigned*)(ws + WS_CTL) + CW_BAR, MISC + 8);

    float* H = (float*)(ws + WS_H); bf16* AB = (bf16*)(ws + WS_AB); bf16* ACT = (bf16*)(ws + WS_ACT); bf16* QKVO = (bf16*)(ws + WS_ACT);
    float* HM = (float*)(ws + WS_HM); bf16* AM = (bf16*)(ws + WS_AM); bf16* QB = (bf16*)(ws + WS_QB); bf16* KB = (bf16*)(ws + WS_KB); bf16* VB = (bf16*)(ws + WS_VB);
    float* SSQ = (float*)(ws + WS_SSQ); float* HSSQ = (float*)(ws + WS_HSSQ); float* GATES = (float*)(ws + WS_GATES);

    p0_prologue(args, lds, gw, NGW, wave, lane);
    xcd_barrier(bar);

    { EpiSwiglu E{ACT, SSQ}; GEMM_PHASE(EpiSwiglu, E, AB, ws + WS_W1 + 0 * SZ_W1, 2 * DFF, DM); }
    xcd_barrier(bar);
    { EpiResid<false> E{H, AB, SSQ, 0.5f, nullptr}; GEMM_PHASE(EpiResid<false>, E, ACT, ws + WS_W2 + 0 * SZ_W2, DM, DFF); }
    xcd_barrier(bar);

    { EpiQkvo E{QKVO, SSQ, GATES, args.in[I_BAG]}; GEMM_PHASE(EpiQkvo, E, AB, ws + WS_WAIN, NAIN_PAD, DM); }
    xcd_barrier(bar);
    for (int u = blockIdx.x; u < NBATCH * AH * 8; u += G) mlstm_prompt_unit(lds, QKVO, GATES, HM, HSSQ, args.out, u >> 5, (u >> 3) & 3, u & 7, tid, wave, lane);
    for (int u = blockIdx.x; u < DECB * AH; u += G) mlstm_sample_unit(lds, QKVO, GATES, args.in[I_SC], args.in[I_SN], args.in[I_SM], HM, HSSQ, args.out, u >> 2, u & 3, tid, wave, lane);
    xcd_barrier(bar);
    mlstm_gate_rows(HM, HSSQ, QKVO, args.in[I_AHN], AM, gw, NGW, lane);
    xcd_barrier(bar);
    { EpiResid<false> E{H, AB, SSQ, 1.0f, nullptr}; GEMM_PHASE(EpiResid<false>, E, AM, ws + WS_WAOUT, DM, DM); }
    xcd_barrier(bar);

    { EpiSwiglu E{ACT, SSQ}; GEMM_PHASE(EpiSwiglu, E, AB, ws + WS_W1 + 1 * SZ_W1, 2 * DFF, DM); }
    xcd_barrier(bar);
    { EpiResid<false> E{H, AB, SSQ, 0.5f, nullptr}; GEMM_PHASE(EpiResid<false>, E, ACT, ws + WS_W2 + 1 * SZ_W2, DM, DFF); }
    xcd_barrier(bar);

    { EpiHead E{KB, 256, VB, 256, 1, SSQ, args.in[I_KN], 1.0f}; GEMM_PHASE(EpiHead, E, AB, ws + WS_WKV, 512, DM); }
    { EpiSwiglu E{ACT, SSQ}; GEMM_PHASE(EpiSwiglu, E, AB, ws + WS_W1 + 2 * SZ_W1, 2 * DFF, DM); }
    xcd_barrier(bar);
    { EpiResid<false> E{H, AB, SSQ, 0.5f, nullptr}; GEMM_PHASE(EpiResid<false>, E, ACT, ws + WS_W2 + 2 * SZ_W2, DM, DFF); }
    xcd_barrier(bar);

    { EpiHead E{QB, DM, QB, DM, 8, SSQ, args.in[I_QN], 0.125f}; GEMM_PHASE(EpiHead, E, AB, ws + WS_WQ, DM, DM); }
    xcd_barrier(bar);
    kv_outputs(args, KB, VB, (size_t)blockIdx.x * (NWAVES * 64) + tid, (size_t)G * NWAVES * 64);
    for (int u = blockIdx.x; u < NBATCH * BKV * 17; u += G) { const int n = u % 17, bg = u / 17; attn_prompt_unit(lds, QB, KB, VB, args.in[I_SINK], AM, bg >> 2, bg & 3, n, tid, wave, lane); }
    for (int u = blockIdx.x; u < DECB * BKV; u += G) attn_sample_unit(lds, QB, KB, VB, args.in[I_CKM], args.in[I_CVM], args.in[I_CKW], args.in[I_CVW], args.in[I_SINK], AM, u >> 2, u & 3, tid, wave, lane);
    xcd_barrier(bar);
    { EpiResid<false> E{H, AB, SSQ, 1.0f, nullptr}; GEMM_PHASE(EpiResid<false>, E, AM, ws + WS_WBO, DM, DM); }
    xcd_barrier(bar);

    { EpiSwiglu E{ACT, SSQ}; GEMM_PHASE(EpiSwiglu, E, AB, ws + WS_W1 + 3 * SZ_W1, 2 * DFF, DM); }
    xcd_barrier(bar);
    { EpiResid<true> E{H, AB, SSQ, 0.5f, args.out}; GEMM_PHASE(EpiResid<true>, E, ACT, ws + WS_W2 + 3 * SZ_W2, DM, DFF); }
}

extern "C" void kernel_launch(void* const* d_in, const int* in_sizes, int n_in, void* d_out, int out_size, void* d_ws, size_t ws_size, hipStream_t stream) {
    static int grid = 0;
    if (grid == 0) {
        if (n_in != 25 || (size_t)out_size != O_END || ws_size < WS_END) { fprintf(stderr, "kernel_launch: unexpected shapes (n_in %d, out %d vs %zu, ws %zu vs %zu); nothing launched\n", n_in, out_size, (size_t)O_END, ws_size, (size_t)WS_END); grid = -1; return; }
        int dev = 0, cus = 0, per_cu = 0;
        if (hipGetDevice(&dev) != hipSuccess || hipDeviceGetAttribute(&cus, hipDeviceAttributeMultiprocessorCount, dev) != hipSuccess) { grid = -1; return; }
        if (hipFuncSetAttribute((const void*)yoco_fwd, hipFuncAttributeMaxDynamicSharedMemorySize, LDS_BYTES) != hipSuccess) { fprintf(stderr, "kernel_launch: hipFuncSetAttribute failed\n"); grid = -1; return; }
        if (hipOccupancyMaxActiveBlocksPerMultiprocessor(&per_cu, (const void*)yoco_fwd, NWAVES * 64, LDS_BYTES) != hipSuccess || per_cu < 1) fprintf(stderr, "kernel_launch: occupancy query says %d\n", per_cu);
        (void)hipGetLastError();
        grid = cus;
    }
    if (grid < 0) return;
    (void)in_sizes;
    if (hipMemsetAsync((char*)d_ws + WS_CTL, 0, CTL_ZERO_BYTES, stream) != hipSuccess) return;
    Args a{};
    for (int i = 0; i < 25; ++i) a.in[i] = (const float*)d_in[i];
    a.out = (float*)d_out; a.ws = (unsigned char*)d_ws;
    hipLaunchKernelGGL(yoco_fwd, dim3(grid), dim3(NWAVES * 64), LDS_BYTES, stream, a);
}
```

```cpp
#include <hip/hip_runtime.h>
#include <cstdio>
#include <cstdint>
namespace pg8 {
#define PG8_LAS __attribute__((address_space(3)))
typedef unsigned short bf16_t;
typedef short bf16x8 __attribute__((ext_vector_type(8)));
typedef float f32x4 __attribute__((ext_vector_type(4)));
typedef unsigned u32x4 __attribute__((ext_vector_type(4)));
constexpr int BM = 256, BK = 64, HALF = 128, HTB = HALF * BK * 2  , STAGE_BYTES = 8 * HTB, NXCD = 8, WGM = 8;

__host__ __device__ __forceinline__ int lds_byte(int r, int c) { const int st = (r >> 4) * 2 + (c >> 5), rr = r & 15, cc = c & 31, ob = rr * 64 + cc * 2; return st * 1024 + (ob ^ (((ob >> 9) & 1) << 5)); }
__host__ __device__ __forceinline__ void stage_rc(int b, int& R, int& C) { const int st = b / 1024, sb = b % 1024, swz = sb ^ (((sb >> 9) & 1) << 5); R = (st >> 1) * 16 + swz / 64; C = (st & 1) * 32 + (swz % 64) / 2; }
__host__ __device__ __forceinline__ int perm32(int rho) { const int n = rho >> 4, i = rho & 15; return 8 * (i >> 2) + 4 * n + (i & 3); }

struct Unit { int pm, pn; };
struct Gemm { const bf16_t* A; const bf16_t* Bt; int M, N, K; };

struct StaticOrder {
    int nM, nN, nwg, G, c;
    __host__ __device__ void init(int M, int N, int G_, int c_) { nM = M / BM; nN = N / BM; nwg = nM * nN; G = G_; c = c_; }
    __host__ __device__ bool next(int i, Unit& u) const {
        const long L = (long)i * G + c; if (L >= nwg) return false;
        int wgid = (int)L; { const int q = nwg / NXCD, r = nwg % NXCD, xcd = wgid % NXCD, off = wgid / NXCD; wgid = (xcd < r ? xcd * (q + 1) : r * (q + 1) + (xcd - r) * q) + off; }
        const int nig = WGM * nN, gid = wgid / nig, fm = gid * WGM, gsz = (nM - fm) < WGM ? (nM - fm) : WGM;
        u.pm = fm + ((wgid % nig) % gsz); u.pn = (wgid % nig) / gsz; return true;
    }
    __device__ __forceinline__ void a_ready(const Unit&) const {}
    __device__ __forceinline__ void done(const Unit&) const {}
};

__device__ __forceinline__ unsigned cvt_pk_bf16(float lo, float hi) { unsigned r; asm volatile("v_cvt_pk_bf16_f32 %0, %1, %2" : "=v"(r) : "v"(lo), "v"(hi)); return r; }
typedef float f32x2 __attribute__((ext_vector_type(2)));
template <class Epi, class Sched, bool ALIGN_EPI = false, bool SP2 = false>
__device__ __forceinline__ void gemm_phase(PG8_LAS unsigned char* lds, const Gemm g, const Sched& S, const Epi& E) {
    int tid_l = threadIdx.x; asm volatile("" : "+v"(tid_l));
    const int tid = tid_l, wid = __builtin_amdgcn_readfirstlane(tid >> 6), lane = tid & 63, wr = wid >> 2, wc = wid & 3, fr = lane & 15, fq = lane >> 4;
    const int K = g.K, nt = K / BK;
    unsigned voffA[2], voffB[2];
#pragma unroll
    for (int i = 0; i < 2; ++i) { int R, C; stage_rc(tid * 16 + i * 8192, R, C); const int Rb = Epi::PERM ? ((R & ~31) + perm32(R & 31)) : R;
        voffA[i] = (unsigned)(R * K + C) * 2u; voffB[i] = (unsigned)(Rb * K + C) * 2u; }
    const size_t kstep = (size_t)(BK * 2);
    const size_t hstep = (size_t)HALF * K * 2;
    const size_t tstep = 2 * hstep;
    const unsigned ldsw = (unsigned)wid * 1024u;
    const int aoff = lds_byte(wr * 64 + fr, fq * 8), boff = lds_byte(wc * 32 + fr, fq * 8);
#define PG8_SA(b, h) (((b) * 2 + (h)) * HTB)
#define PG8_SB(b, h) ((4 + (b) * 2 + (h)) * HTB)
#define PG8_STAGE(bufoff, gbase, voff) do { _Pragma("unroll") for (int _i = 0; _i < 2; ++_i) \
        __builtin_amdgcn_global_load_lds((const unsigned*)((const char*)(gbase) + (voff)[_i]), (PG8_LAS unsigned*)(lds + (bufoff) + ldsw + _i * 8192), 16, 0, 0); } while (0)
#define PG8_LDA(dst, b, h) do { _Pragma("unroll") for (int m = 0; m < 4; ++m) _Pragma("unroll") for (int k = 0; k < 2; ++k) dst[m][k] = *(const PG8_LAS bf16x8*)(lds + PG8_SA(b, h) + aoff + m * 2048 + k * 1024); } while (0)
#define PG8_LDB(dst, b, h) do { _Pragma("unroll") for (int n = 0; n < 2; ++n) _Pragma("unroll") for (int k = 0; k < 2; ++k) dst[n][k] = *(const PG8_LAS bf16x8*)(lds + PG8_SB(b, h) + boff + n * 2048 + k * 1024); } while (0)
#define PG8_MMA(ai, bj, At, Bt) do { __builtin_amdgcn_s_setprio(1); _Pragma("unroll") for (int m = 0; m < 4; ++m) _Pragma("unroll") for (int n = 0; n < 2; ++n) _Pragma("unroll") for (int k = 0; k < 2; ++k) \
        acc[ai][bj][m][n] = __builtin_amdgcn_mfma_f32_16x16x32_bf16(Bt[n][k], At[m][k], acc[ai][bj][m][n], 0, 0, 0); __builtin_amdgcn_s_setprio(0); } while (0)
#define PG8_WAIT_V(n) asm volatile("s_waitcnt vmcnt(" #n ")" ::: "memory")
#define PG8_WAIT_L(n) asm volatile("s_waitcnt lgkmcnt(" #n ")" ::: "memory")
#define PG8_BAR __builtin_amdgcn_s_barrier()
#define PG8_SCHED __builtin_amdgcn_sched_barrier(0)
    Unit cur, nxt; int ui = 0;
    if (!S.next(0, cur)) return;
    f32x4 acc[2][2][4][2];
#pragma unroll
    for (int a = 0; a < 2; ++a)
#pragma unroll
        for (int b = 0; b < 2; ++b)
#pragma unroll
            for (int m = 0; m < 4; ++m)
#pragma unroll
                for (int n = 0; n < 2; ++n) acc[a][b][m][n] = (f32x4){0.f, 0.f, 0.f, 0.f};
    bf16x8 At[4][2], B0[2][2], B1[2][2];
    const char* cA = (const char*)g.A + (size_t)cur.pm * tstep; const char* cB = (const char*)g.Bt + (size_t)cur.pn * tstep;
    S.a_ready(cur);
    if constexpr (SP2) {
        PG8_STAGE(PG8_SB(0, 0), cB, voffB); PG8_STAGE(PG8_SB(0, 1), cB + hstep, voffB); PG8_STAGE(PG8_SA(0, 0), cA, voffA); PG8_STAGE(PG8_SA(0, 1), cA + hstep, voffA);
        if (wr == 1) PG8_BAR;
        PG8_WAIT_V(2); PG8_BAR;
        PG8_STAGE(PG8_SB(1, 0), cB + kstep, voffB); PG8_STAGE(PG8_SA(1, 0), cA + kstep, voffA); PG8_STAGE(PG8_SB(1, 1), cB + hstep + kstep, voffB);
        PG8_WAIT_V(6); PG8_BAR;
    } else {
        PG8_STAGE(PG8_SB(0, 0), cB, voffB); PG8_STAGE(PG8_SA(0, 0), cA, voffA); PG8_STAGE(PG8_SB(0, 1), cB + hstep, voffB); PG8_STAGE(PG8_SA(0, 1), cA + hstep, voffA);
        if (wr == 1) PG8_BAR;
        PG8_WAIT_V(4); PG8_BAR;
        PG8_STAGE(PG8_SB(1, 0), cB + kstep, voffB); PG8_STAGE(PG8_SA(1, 0), cA + kstep, voffA); PG8_STAGE(PG8_SB(1, 1), cB + hstep + kstep, voffB);
        PG8_WAIT_V(6); PG8_BAR;
    }
    for (;;) {
        const bool has_next = S.next(ui + 1, nxt);
        const char* nA = has_next ? (const char*)g.A + (size_t)nxt.pm * tstep : cA; const char* nB = has_next ? (const char*)g.Bt + (size_t)nxt.pn * tstep : cB;
        for (int t = 0; t < nt; t += 2) {
            const bool last = (t == nt - 2);
            const char* a1 = cA + (size_t)(t + 1) * kstep;
            const char* a2 = last ? nA : cA + (size_t)(t + 2) * kstep; const char* b2 = last ? nB : cB + (size_t)(t + 2) * kstep;
            const char* a3 = a2 + kstep; const char* b3 = b2 + kstep;
            if (last && has_next) S.a_ready(nxt);
            if constexpr (SP2) {
            PG8_LDB(B0, 0, 0); PG8_LDB(B1, 0, 1); PG8_SCHED; PG8_LDA(At, 0, 0); PG8_STAGE(PG8_SA(1, 1), a1 + hstep, voffA);
            PG8_WAIT_V(8); PG8_WAIT_L(0); PG8_BAR; PG8_MMA(0, 0, At, B0); PG8_MMA(0, 1, At, B1); PG8_BAR; PG8_SCHED;
            PG8_LDA(At, 0, 1); PG8_STAGE(PG8_SB(0, 0), b2, voffB); PG8_STAGE(PG8_SB(0, 1), b2 + hstep, voffB); PG8_STAGE(PG8_SA(0, 0), a2, voffA);
            PG8_WAIT_V(8); PG8_WAIT_L(0); PG8_BAR; PG8_MMA(1, 0, At, B0); PG8_MMA(1, 1, At, B1); PG8_BAR; PG8_SCHED;
            PG8_LDB(B0, 1, 0); PG8_LDB(B1, 1, 1); PG8_SCHED; PG8_LDA(At, 1, 0); PG8_STAGE(PG8_SA(0, 1), a2 + hstep, voffA);
            PG8_WAIT_V(8); PG8_WAIT_L(0); PG8_BAR; PG8_MMA(0, 0, At, B0); PG8_MMA(0, 1, At, B1); PG8_BAR; PG8_SCHED;
            PG8_LDA(At, 1, 1); PG8_STAGE(PG8_SB(1, 0), b3, voffB); PG8_STAGE(PG8_SB(1, 1), b3 + hstep, voffB); PG8_STAGE(PG8_SA(1, 0), a3, voffA);
            PG8_WAIT_V(8); PG8_WAIT_L(0); PG8_BAR; PG8_MMA(1, 0, At, B0); PG8_MMA(1, 1, At, B1); PG8_BAR; PG8_SCHED;
            } else {
            PG8_LDB(B0, 0, 0); PG8_SCHED; PG8_LDA(At, 0, 0); PG8_STAGE(PG8_SA(1, 1), a1 + hstep, voffA);
            PG8_WAIT_L(8); PG8_BAR; PG8_WAIT_L(0); PG8_MMA(0, 0, At, B0); PG8_BAR; PG8_SCHED;
            PG8_LDB(B1, 0, 1); PG8_STAGE(PG8_SB(0, 0), b2, voffB);
            PG8_BAR; PG8_WAIT_L(0); PG8_MMA(0, 1, At, B1); PG8_BAR;
            PG8_LDA(At, 0, 1); PG8_STAGE(PG8_SA(0, 0), a2, voffA);
            PG8_BAR; PG8_WAIT_L(0); PG8_MMA(1, 0, At, B0); PG8_BAR; PG8_SCHED;
            PG8_STAGE(PG8_SB(0, 1), b2 + hstep, voffB);
            PG8_WAIT_V(6); PG8_BAR; PG8_MMA(1, 1, At, B1); PG8_BAR;
            PG8_LDB(B0, 1, 0); PG8_SCHED; PG8_LDA(At, 1, 0); PG8_STAGE(PG8_SA(0, 1), a2 + hstep, voffA);
            PG8_WAIT_L(8); PG8_BAR; PG8_WAIT_L(0); PG8_MMA(0, 0, At, B0); PG8_BAR; PG8_SCHED;
            PG8_LDB(B1, 1, 1); PG8_STAGE(PG8_SB(1, 0), b3, voffB);
            PG8_BAR; PG8_WAIT_L(0); PG8_MMA(0, 1, At, B1); PG8_BAR;
            PG8_LDA(At, 1, 1); PG8_STAGE(PG8_SA(1, 0), a3, voffA);
            PG8_BAR; PG8_WAIT_L(0); PG8_MMA(1, 0, At, B0); PG8_BAR; PG8_SCHED;
            PG8_STAGE(PG8_SB(1, 1), b3 + hstep, voffB);
            PG8_WAIT_V(6); PG8_BAR; PG8_MMA(1, 1, At, B1); PG8_BAR;
            }
        }
        if constexpr (ALIGN_EPI) { if (wr == 0) PG8_BAR; }
        if constexpr (!Epi::AFTER_DRAIN) { E(acc, cur, wr, wc, fr, fq); S.done(cur); }
        if (!has_next) break;
#pragma unroll
        for (int a = 0; a < 2; ++a)
#pragma unroll
            for (int b = 0; b < 2; ++b)
#pragma unroll
                for (int m = 0; m < 4; ++m)
#pragma unroll
                    for (int n = 0; n < 2; ++n) acc[a][b][m][n] = (f32x4){0.f, 0.f, 0.f, 0.f};
        cur = nxt; cA = nA; cB = nB; ++ui;
        if constexpr (ALIGN_EPI) { if (wr == 1) PG8_BAR; }
    }
    PG8_WAIT_V(0);
    if constexpr (!ALIGN_EPI) { if (wr == 0) PG8_BAR; }
    PG8_BAR;
    if constexpr (Epi::AFTER_DRAIN) { E.fused(acc, cur, wr, wc, fr, fq, lds, wid, lane); S.done(cur); }
#undef PG8_SA
#undef PG8_SB
#undef PG8_STAGE
#undef PG8_LDA
#undef PG8_LDB
#undef PG8_MMA
#undef PG8_WAIT_V
#undef PG8_WAIT_L
#undef PG8_BAR
#undef PG8_SCHED
}
}

constexpr int NWAVES = 8;
constexpr int DM = 2048, DFF = 5632, NBATCH = 8, SEQ = 2048, NMETA = 16, TP = SEQ + NMETA;
constexpr int DECB = 128, DECS = 4, MPR = NBATCH * TP  , MSM = DECB * DECS  , MREAL = MPR + MSM  , MP = 17152  ;
constexpr int AH = 4, ADK = 256, ADV = 512, NAIN = 6144, NAIN_PAD = 6400;
constexpr int BH = 32, BDH = 64, BKV = 4, WIN = 128;
constexpr float EPS = 1e-6f;

constexpr size_t MiB = 1u << 20;
constexpr size_t WS_CTL = 0, CTL_ZERO_BYTES = 1 * MiB;
constexpr size_t SZ_W1 = (size_t)2 * DFF * DM * 2, SZ_W2 = (size_t)DM * DFF * 2;
constexpr size_t WS_W1 = 1 * MiB;
constexpr size_t WS_W2 = WS_W1 + 4 * SZ_W1;
constexpr size_t WS_WAIN = WS_W2 + 4 * SZ_W2;
constexpr size_t WS_WAOUT = WS_WAIN + (size_t)NAIN_PAD * DM * 2;
constexpr size_t WS_WKV = WS_WAOUT + (size_t)DM * DM * 2;
constexpr size_t WS_WQ = WS_WKV + (size_t)512 * DM * 2;
constexpr size_t WS_WBO = WS_WQ + (size_t)DM * DM * 2;
constexpr size_t WS_H = WS_WBO + (size_t)DM * DM * 2;
constexpr size_t WS_AB = WS_H + (size_t)MP * DM * 4;
constexpr size_t WS_ACT = WS_AB + (size_t)MP * DM * 2;
constexpr size_t WS_HM = WS_ACT + (size_t)MP * NAIN * 2;
constexpr size_t WS_AM = WS_HM + (size_t)MP * DM * 4;
constexpr size_t WS_QB = WS_AM + (size_t)MP * DM * 2;
constexpr size_t WS_KB = WS_QB + (size_t)MP * DM * 2;
constexpr size_t WS_VB = WS_KB + (size_t)MP * 256 * 2;
constexpr size_t WS_SSQ = WS_VB + (size_t)MP * 256 * 2;
constexpr size_t WS_HSSQ = WS_SSQ + (size_t)MP * 32 * 4;
constexpr size_t WS_GATES = WS_HSSQ + (size_t)MP * 32 * 4;
constexpr size_t WS_END = WS_GATES + (size_t)MP * 8 * 4;
constexpr int CW_BAR = 4096;

constexpr size_t O_YP = 0, O_YS = O_YP + (size_t)NBATCH * SEQ * DM, O_CP = O_YS + (size_t)MSM * DM, O_NP = O_CP + (size_t)NBATCH * AH * ADK * ADV,
                 O_MP = O_NP + NBATCH * AH * ADK, O_KMP = O_MP + NBATCH * AH, O_VMP = O_KMP + NBATCH * NMETA * 256, O_KWP = O_VMP + NBATCH * NMETA * 256,
                 O_VWP = O_KWP + NBATCH * WIN * 256, O_CS = O_VWP + NBATCH * WIN * 256, O_NS = O_CS + (size_t)DECB * AH * ADK * ADV, O_MS = O_NS + DECB * AH * ADK,
                 O_KWS = O_MS + DECB * AH, O_VWS = O_KWS + (size_t)DECB * WIN * 256, O_END = O_VWS + (size_t)DECB * WIN * 256;

constexpr int SCR_BYTES = 143360;
constexpr int MISC_OFF = SCR_BYTES;
constexpr int LDS_BYTES = 147456;

#define GAS __attribute__((address_space(1)))
#define LAS __attribute__((address_space(3)))
typedef unsigned short bf16;
typedef unsigned v4u __attribute__((ext_vector_type(4)));
typedef unsigned v2u __attribute__((ext_vector_type(2)));
typedef float f32x4 __attribute__((ext_vector_type(4)));
typedef short bf16x8 __attribute__((ext_vector_type(8)));
#define LDS_WAIT() asm volatile("s_waitcnt lgkmcnt(0)" ::: "memory")
#define MFMA16(a, b, c) __builtin_amdgcn_mfma_f32_16x16x32_bf16((a), (b), (c), 0, 0, 0)
__device__ __forceinline__ unsigned pk2(float lo, float hi) { return pg8::cvt_pk_bf16(lo, hi); }
__device__ __forceinline__ float bflo(unsigned w) { return __uint_as_float(w << 16); }
__device__ __forceinline__ float bfhi(unsigned w) { return __uint_as_float(w & 0xffff0000u); }
__device__ __forceinline__ unsigned bfel(const v4u& r, int e) { return (r[e >> 1] >> (16 * (e & 1))) & 0xffffu; }
__device__ __forceinline__ float wave_sum(float v) {
#pragma unroll
    for (int o = 1; o < 64; o <<= 1) v += __shfl_xor(v, o);
    return v;
}
#define XB_TMO      128
#define XB_XCNT(j)  (256  + 64 * (j))
#define XB_XSUB(j)  (1280 + 64 * (j))
#define XB_XGEN(j)  (2304 + 64 * (j))
#define XB_TOP      3328
#define XB_TOPGEN   3392
#define XCD_BAR_WORDS 3456
#define XB_SPIN_CAP (1u << 18)

__device__ __forceinline__ unsigned xb_ld(unsigned* p)              { return __hip_atomic_load(p, __ATOMIC_RELAXED, __HIP_MEMORY_SCOPE_AGENT); }
__device__ __forceinline__ unsigned xb_add(unsigned* p, unsigned v) { return __hip_atomic_fetch_add(p, v, __ATOMIC_RELAXED, __HIP_MEMORY_SCOPE_AGENT); }
__device__ __forceinline__ unsigned xb_xcc_id() { return (unsigned)__builtin_amdgcn_s_getreg((3 << 11) | 20) & 0xFu; }
#define XB_SPIN(cond, bar) do { unsigned _sp = 0; while (cond) { __builtin_amdgcn_s_sleep(1); \
    if ((++_sp & 255u) == 0u) { if (xb_ld(&(bar)[XB_TMO])) break; if (_sp > XB_SPIN_CAP) { atomicAdd(&(bar)[XB_TMO], 1u); break; } } } } while (0)

struct XcdBarrier {
    unsigned* bar; unsigned x;
    volatile LAS unsigned* st;
};

__device__ __forceinline__ XcdBarrier xcd_barrier_post(unsigned* bar, volatile LAS unsigned* st) {
    XcdBarrier b; b.bar = bar; b.x = xb_xcc_id(); b.st = st;
    if (threadIdx.x == 0) (void)xb_add(&bar[XB_XCNT(b.x)], 1u);
    return b;
}
__device__ __forceinline__ void xcd_barrier_complete(unsigned* bar, unsigned x, unsigned& nloc, unsigned& nx) {
    const unsigned G = gridDim.x * gridDim.y * gridDim.z;
    unsigned sum, cnt, mine, sp = 0u;
    for (;;) {
        sum = 0u; cnt = 0u; mine = 0u;
#pragma unroll
        for (unsigned j = 0; j < 16; ++j) { const unsigned c = xb_ld(&bar[XB_XCNT(j)]); sum += c; cnt += (c > 0u) ? 1u : 0u; mine = (j == x) ? c : mine; }
        if (sum == G) break;
        __builtin_amdgcn_s_sleep(1);
        if ((++sp & 255u) == 0u) { if (xb_ld(&bar[XB_TMO])) break; if (sp > XB_SPIN_CAP) { atomicAdd(&bar[XB_TMO], 1u); break; } }
    }
    nloc = mine > 0u ? mine : 1u; nx = cnt > 0u ? cnt : 1u;
}

__device__ __forceinline__ void xcd_barrier(const XcdBarrier& b) {
    asm volatile("s_waitcnt vmcnt(0)" ::: "memory");
    __syncthreads();
    if (threadIdx.x == 0) {
        unsigned* bar = b.bar;
        __builtin_amdgcn_s_waitcnt(0);
        unsigned nloc = b.st[0], nx = b.st[1];
        if (nloc == 0u) { xcd_barrier_complete(bar, b.x, nloc, nx); b.st[0] = nloc; b.st[1] = nx; }
        const unsigned old = xb_add(&bar[XB_XSUB(b.x)], 1u);
        const unsigned gen = old / nloc;
        if (old + 1u == (gen + 1u) * nloc) {
            __builtin_amdgcn_fence(__ATOMIC_RELEASE, "agent");
            asm volatile("s_waitcnt vmcnt(0)" ::: "memory");
            const unsigned og = xb_add(&bar[XB_TOP], 1u);
            const unsigned tg = og / nx;
            if (og + 1u == (tg + 1u) * nx) xb_add(&bar[XB_TOPGEN], 1u);
            else XB_SPIN(xb_ld(&bar[XB_TOPGEN]) == tg, bar);
            __builtin_amdgcn_fence(__ATOMIC_ACQUIRE, "agent");
            xb_add(&bar[XB_XGEN(b.x)], 1u);
            asm volatile("s_waitcnt vmcnt(0)" ::: "memory");
        } else {
            XB_SPIN(xb_ld(&bar[XB_XGEN(b.x)]) == gen, bar);
            __builtin_amdgcn_fence(__ATOMIC_ACQUIRE, "agent");
            asm volatile("s_waitcnt vmcnt(0)" ::: "memory");
        }
    }
    __syncthreads();
}

__device__ __forceinline__ float row_rscale(const float* ssq, int row, int fq) {
    const f32x4* p = (const f32x4*)(ssq + (size_t)row * 32 + 8 * fq);
    const f32x4 a = p[0], b = p[1];
    float s = ((a.x + a.y) + (a.z + a.w)) + ((b.x + b.y) + (b.z + b.w));
    s += __shfl_xor(s, 16); s += __shfl_xor(s, 32);
    return rsqrtf(s * (1.0f / DM) + EPS);
}
__device__ __forceinline__ float silu_f(float g) { return g * __builtin_amdgcn_rcpf(1.0f + __expf(-g)); }

struct EpiSwiglu {
    static constexpr bool PERM = true, AFTER_DRAIN = false;
    bf16* O; const float* ssq;
    __device__ __forceinline__ void operator()(const f32x4 (&acc)[2][2][4][2], const pg8::Unit& u, int wr, int wc, int fr, int fq) const {
        const int row0 = u.pm * 256 + wr * 64 + fr, col0 = u.pn * 128 + wc * 32 + 8 * fq;
#pragma unroll
        for (int ai = 0; ai < 2; ++ai)
#pragma unroll
            for (int m = 0; m < 4; ++m) {
                const int row = row0 + ai * 128 + m * 16;
                const float r = row_rscale(ssq, row, fq);
                float o[8];
#pragma unroll
                for (int n = 0; n < 2; ++n)
#pragma unroll
                    for (int j = 0; j < 4; ++j) o[4 * n + j] = silu_f(acc[ai][0][m][n][j] * r) * (acc[ai][1][m][n][j] * r);
                v4u w; w.x = pk2(o[0], o[1]); w.y = pk2(o[2], o[3]); w.z = pk2(o[4], o[5]); w.w = pk2(o[6], o[7]);
                *(v4u*)(O + (size_t)row * DFF + col0) = w;
            }
    }
};
template <bool FINAL> struct EpiResid {
    static constexpr bool PERM = true, AFTER_DRAIN = false;
    float* H; bf16* AB; float* ssq; float sc; float* out;
    __device__ __forceinline__ void operator()(const f32x4 (&acc)[2][2][4][2], const pg8::Unit& u, int wr, int wc, int fr, int fq) const {
        const int row0 = u.pm * 256 + wr * 64 + fr, col0 = u.pn * 256 + wc * 32 + 8 * fq;
#pragma unroll
        for (int ai = 0; ai < 2; ++ai)
#pragma unroll
            for (int m = 0; m < 4; ++m) {
                const int row = row0 + ai * 128 + m * 16;
                const float* hp = H + (size_t)row * DM + col0;
                float ss = 0.f;
                float* op = nullptr;
                if (FINAL) {
                    if (row < MPR) { const int b = row / TP, t = row - b * TP; if (t >= NMETA) op = out + O_YP + ((size_t)b * SEQ + (t - NMETA)) * DM + col0; }
                    else if (row < MREAL) op = out + O_YS + (size_t)(row - MPR) * DM + col0;
                }
#pragma unroll
                for (int bj = 0; bj < 2; ++bj) {
                    const f32x4 h0 = *(const f32x4*)(hp + bj * 128), h1 = *(const f32x4*)(hp + bj * 128 + 4);
                    const f32x4 n0 = h0 + acc[ai][bj][m][0] * sc, n1 = h1 + acc[ai][bj][m][1] * sc;
                    if (FINAL) { if (op) { *(f32x4*)(op + bj * 128) = n0; *(f32x4*)(op + bj * 128 + 4) = n1; } }
                    else {
                        *(f32x4*)(H + (size_t)row * DM + col0 + bj * 128) = n0; *(f32x4*)(H + (size_t)row * DM + col0 + bj * 128 + 4) = n1;
                        v4u w; w.x = pk2(n0[0], n0[1]); w.y = pk2(n0[2], n0[3]); w.z = pk2(n1[0], n1[1]); w.w = pk2(n1[2], n1[3]);
                        *(v4u*)(AB + (size_t)row * DM + col0 + bj * 128) = w;
                        ss += (n0[0] * n0[0] + n0[1] * n0[1]) + (n0[2] * n0[2] + n0[3] * n0[3]) + (n1[0] * n1[0] + n1[1] * n1[1]) + (n1[2] * n1[2] + n1[3] * n1[3]);
                    }
                }
                if (!FINAL) { ss += __shfl_xor(ss, 16); ss += __shfl_xor(ss, 32); if (fq == 0) ssq[(size_t)row * 32 + u.pn * 4 + wc] = ss; }
            }
    }
};
struct EpiQkvo {
    static constexpr bool PERM = true, AFTER_DRAIN = false;
    bf16* O; const float* ssq; float* gates; const float* bias;
    __device__ __forceinline__ void operator()(const f32x4 (&acc)[2][2][4][2], const pg8::Unit& u, int wr, int wc, int fr, int fq) const {
        const int row0 = u.pm * 256 + wr * 64 + fr, col0 = u.pn * 256 + wc * 32 + 8 * fq;
        const bool gate_tile = (u.pn == NAIN / 256);
        f32x4 bi = (f32x4){0.f, 0.f, 0.f, 0.f}, bf = bi;
        if (gate_tile) { bi = *(const f32x4*)bias; bf = *(const f32x4*)(bias + 4); }
#pragma unroll
        for (int ai = 0; ai < 2; ++ai)
#pragma unroll
            for (int m = 0; m < 4; ++m) {
                const int row = row0 + ai * 128 + m * 16;
                const float r = row_rscale(ssq, row, fq);
                if (!gate_tile) {
#pragma unroll
                    for (int bj = 0; bj < 2; ++bj) { const f32x4 v0 = acc[ai][bj][m][0] * r, v1 = acc[ai][bj][m][1] * r;
                        v4u w; w.x = pk2(v0[0], v0[1]); w.y = pk2(v0[2], v0[3]); w.z = pk2(v1[0], v1[1]); w.w = pk2(v1[2], v1[3]);
                        *(v4u*)(O + (size_t)row * NAIN + col0 + bj * 128) = w; }
                } else if (wc == 0 && fq == 0) {
                    const f32x4 xi = acc[ai][0][m][0] * r + bi, xf = acc[ai][0][m][1] * r + bf;
                    f32x4 gi, gf;
#pragma unroll
                    for (int j = 0; j < 4; ++j) { gi[j] = 15.0f * tanhf(xi[j] * (1.0f / 15.0f)); const float c = 15.0f * tanhf(xf[j] * (1.0f / 15.0f));
                        gf[j] = fminf(c, 0.f) - log1pf(expf(-fabsf(c))); }
                    *(f32x4*)(gates + (size_t)row * 8) = gi; *(f32x4*)(gates + (size_t)row * 8 + 4) = gf;
                }
            }
    }
};
struct EpiHead {
    static constexpr bool PERM = true, AFTER_DRAIN = false;
    bf16* O0; int ld0; bf16* O1; int ld1; int norm_tiles; const float* ssq; const float* gain; float post;
    __device__ __forceinline__ void operator()(const f32x4 (&acc)[2][2][4][2], const pg8::Unit& u, int wr, int wc, int fr, int fq) const {
        const int row0 = u.pm * 256 + wr * 64 + fr;
        const bool normed = u.pn < norm_tiles;
        bf16* base = normed ? O0 + (size_t)u.pn * 256 : O1 + (size_t)(u.pn - norm_tiles) * 256;
        const int ld = normed ? ld0 : ld1;
        f32x4 gn[2][2];
#pragma unroll
        for (int bj = 0; bj < 2; ++bj)
#pragma unroll
            for (int n = 0; n < 2; ++n) gn[bj][n] = normed ? *(const f32x4*)(gain + 32 * bj + 8 * fq + 4 * n) * post : (f32x4){1.f, 1.f, 1.f, 1.f};
#pragma unroll
        for (int ai = 0; ai < 2; ++ai)
#pragma unroll
            for (int m = 0; m < 4; ++m) {
                const int row = row0 + ai * 128 + m * 16;
                const float r = row_rscale(ssq, row, fq);
                f32x4 x[2][2]; float ms = 0.f;
#pragma unroll
                for (int bj = 0; bj < 2; ++bj)
#pragma unroll
                    for (int n = 0; n < 2; ++n) { x[bj][n] = acc[ai][bj][m][n] * r; const f32x4 q = x[bj][n] * x[bj][n]; ms += (q[0] + q[1]) + (q[2] + q[3]); }
                ms += __shfl_xor(ms, 16); ms += __shfl_xor(ms, 32);
                const float inv = normed ? rsqrtf(ms * (1.0f / 64.0f) + EPS) : 1.0f;
#pragma unroll
                for (int bj = 0; bj < 2; ++bj) { const f32x4 v0 = x[bj][0] * inv * gn[bj][0], v1 = x[bj][1] * inv * gn[bj][1];
                    v4u w; w.x = pk2(v0[0], v0[1]); w.y = pk2(v0[2], v0[3]); w.z = pk2(v1[0], v1[1]); w.w = pk2(v1[2], v1[3]);
                    *(v4u*)(base + (size_t)row * ld + wc * 64 + 32 * bj + 8 * fq) = w; }
            }
    }
};

struct Args { const float* in[25]; float* out; unsigned char* ws; };
enum { I_XP = 0, I_XS, I_SC, I_SN, I_SM, I_CKM, I_CVM, I_CKW, I_CVW, I_META, I_FFNN, I_WFI, I_WFO, I_MIXN, I_WAI, I_BAG, I_AHN, I_WAO, I_KVN, I_WKV, I_KN, I_WQ, I_QN, I_SINK, I_WBO };
struct CvtItem { const float* lp; const float* gain; bf16* dp; int ldw; int valid; float scale; int K; };
constexpr int IT_W1 = (DM / 64) * (2 * DFF / 64), IT_W2 = (DFF / 64) * (DM / 64), IT_AIN = (DM / 64) * (NAIN_PAD / 64), IT_SQ = (DM / 64) * (DM / 64), IT_KV = (DM / 64) * (512 / 64);
constexpr int CVT_NITEMS = 4 * IT_W1 + 4 * IT_W2 + IT_AIN + IT_SQ + IT_KV + IT_SQ + IT_SQ;
__device__ __forceinline__ CvtItem cvt_decode(const Args& a, int it, int lane) {
    unsigned char* ws = a.ws; const int l16 = lane & 15, q = lane >> 4, nl = 4 * l16;
    CvtItem c; c.valid = 1; c.scale = 1.0f; c.gain = nullptr;
    int r = it, kb, n0, col; const float* W; bf16* dst;
    if (r < 4 * IT_W1) { const int f = r / IT_W1; r -= f * IT_W1; const int nblk = 2 * DFF / 64; kb = r / nblk; n0 = 64 * (r % nblk); const int tile = n0 >> 8, within = (n0 & 255) + nl;
        col = within < 128 ? 128 * tile + within : DFF + 128 * tile + (within - 128);
        W = a.in[I_WFI] + (size_t)f * DM * 2 * DFF; c.ldw = 2 * DFF; c.K = DM; c.gain = a.in[I_FFNN] + f * DM; dst = (bf16*)(ws + WS_W1 + f * SZ_W1); }
    else if ((r -= 4 * IT_W1) < 4 * IT_W2) { const int f = r / IT_W2; r -= f * IT_W2; const int nblk = DM / 64; kb = r / nblk; n0 = 64 * (r % nblk); col = n0 + nl;
        W = a.in[I_WFO] + (size_t)f * DFF * DM; c.ldw = DM; c.K = DFF; dst = (bf16*)(ws + WS_W2 + f * SZ_W2); }
    else if ((r -= 4 * IT_W2) < IT_AIN) { const int nblk = NAIN_PAD / 64; kb = r / nblk; n0 = 64 * (r % nblk); col = n0 + nl;
        c.valid = col < NAIN + 8 ? 1 : 0; if (!c.valid) col = 0; c.scale = (n0 >= 1024 && n0 < 2048) ? 0.0625f : 1.0f;
        W = a.in[I_WAI]; c.ldw = NAIN + 8; c.K = DM; c.gain = a.in[I_MIXN]; dst = (bf16*)(ws + WS_WAIN); }
    else if ((r -= IT_AIN) < IT_SQ) { const int nblk = DM / 64; kb = r / nblk; n0 = 64 * (r % nblk); col = n0 + nl; W = a.in[I_WAO]; c.ldw = DM; c.K = DM; dst = (bf16*)(ws + WS_WAOUT); }
    else if ((r -= IT_SQ) < IT_KV) { const int nblk = 512 / 64; kb = r / nblk; n0 = 64 * (r % nblk); const int d = n0 + nl, tile = d >> 8, within = d & 255, bj = within >> 7, wc = (within >> 5) & 3;
        col = 256 * tile + 64 * wc + 32 * bj + (within & 31); W = a.in[I_WKV]; c.ldw = 512; c.K = DM; c.gain = a.in[I_KVN]; dst = (bf16*)(ws + WS_WKV); }
    else if ((r -= IT_KV) < IT_SQ) { const int nblk = DM / 64; kb = r / nblk; n0 = 64 * (r % nblk); const int d = n0 + nl, tile = d >> 8, within = d & 255, bj = within >> 7, wc = (within >> 5) & 3;
        col = 256 * tile + 64 * wc + 32 * bj + (within & 31); W = a.in[I_WQ]; c.ldw = DM; c.K = DM; c.gain = a.in[I_MIXN] + DM; dst = (bf16*)(ws + WS_WQ); }
    else { r -= IT_SQ; const int nblk = DM / 64; kb = r / nblk; n0 = 64 * (r % nblk); col = n0 + nl; W = a.in[I_WBO]; c.ldw = DM; c.K = DM; dst = (bf16*)(ws + WS_WBO); }
    c.lp = W + (size_t)(64 * kb + q) * c.ldw + col;
    if (c.gain) c.gain += 64 * kb;
    c.dp = dst + (size_t)n0 * c.K + 64 * kb;
    return c;
}
__device__ __forceinline__ void cvt_load(const CvtItem& c, f32x4 (&r)[16]) {
#pragma unroll
    for (int i = 0; i < 16; ++i) r[i] = c.valid ? *(const f32x4*)(c.lp + (size_t)(4 * i) * c.ldw) : (f32x4){0.f, 0.f, 0.f, 0.f};
}
__device__ __forceinline__ void cvt_store(const CvtItem& c, const f32x4 (&r)[16], LAS float* scr, int lane) {
    const int l16 = lane & 15, q = lane >> 4;
#pragma unroll
    for (int i = 0; i < 16; ++i) { LAS float* s = scr + (4 * i + q) * 65 + 4 * l16; s[0] = r[i][0]; s[1] = r[i][1]; s[2] = r[i][2]; s[3] = r[i][3]; }
    LDS_WAIT(); asm volatile("" ::: "memory");
    const int ch = lane & 7;
    f32x4 g0 = (f32x4){c.scale, c.scale, c.scale, c.scale}, g1 = g0;
    if (c.gain) { g0 = *(const f32x4*)(c.gain + 8 * ch) * c.scale; g1 = *(const f32x4*)(c.gain + 8 * ch + 4) * c.scale; }
#pragma unroll
    for (int j = 0; j < 8; ++j) { const int n = (lane >> 3) + 8 * j; const LAS float* s = scr + (8 * ch) * 65 + n;
        v4u o; o.x = pk2(s[0 * 65] * g0[0], s[1 * 65] * g0[1]); o.y = pk2(s[2 * 65] * g0[2], s[3 * 65] * g0[3]); o.z = pk2(s[4 * 65] * g1[0], s[5 * 65] * g1[1]); o.w = pk2(s[6 * 65] * g1[2], s[7 * 65] * g1[3]);
        *(v4u*)(c.dp + (size_t)n * c.K + 8 * ch) = o; }
    LDS_WAIT(); asm volatile("" ::: "memory");
}

__device__ __forceinline__ void p0_prologue(const Args& a, LAS unsigned char* lds, int gw, int NGW, int wave, int lane) {
    LAS float* scr = (LAS float*)(lds + wave * 16640);
    unsigned char* ws = a.ws;
    {
        f32x4 r0[16], r1[16]; int it = gw;
        if (it < CVT_NITEMS) {
            CvtItem c0 = cvt_decode(a, it, lane); CvtItem c1 = cvt_decode(a, it, lane); cvt_load(c0, r0);
            for (;;) {
                it += NGW; const bool h1 = it < CVT_NITEMS; if (h1) { c1 = cvt_decode(a, it, lane); cvt_load(c1, r1); }
                cvt_store(c0, r0, scr, lane);
                if (!h1) break;
                it += NGW; const bool h0 = it < CVT_NITEMS; if (h0) { c0 = cvt_decode(a, it, lane); cvt_load(c0, r0); }
                cvt_store(c1, r1, scr, lane);
                if (!h0) break;
            }
        }
    }
    float* H = (float*)(ws + WS_H); bf16* AB = (bf16*)(ws + WS_AB); float* SSQ = (float*)(ws + WS_SSQ);
    for (int row = gw; row < MP; row += NGW) {
        const float* src = nullptr;
        if (row < MPR) { const int b = row / TP, t = row - b * TP; src = t < NMETA ? a.in[I_META] + (size_t)t * DM : a.in[I_XP] + ((size_t)b * SEQ + (t - NMETA)) * DM; }
        else if (row < MREAL) src = a.in[I_XS] + (size_t)(row - MPR) * DM;
        float ss = 0.f;
#pragma unroll
        for (int j = 0; j < 4; ++j) {
            f32x4 v0 = (f32x4){0.f, 0.f, 0.f, 0.f}, v1 = v0;
            if (src) { v0 = *(const f32x4*)(src + 512 * j + 8 * lane); v1 = *(const f32x4*)(src + 512 * j + 8 * lane + 4); }
            *(f32x4*)(H + (size_t)row * DM + 512 * j + 8 * lane) = v0; *(f32x4*)(H + (size_t)row * DM + 512 * j + 8 * lane + 4) = v1;
            v4u w; w.x = pk2(v0[0], v0[1]); w.y = pk2(v0[2], v0[3]); w.z = pk2(v1[0], v1[1]); w.w = pk2(v1[2], v1[3]);
            *(v4u*)(AB + (size_t)row * DM + 512 * j + 8 * lane) = w;
            ss += (v0[0] * v0[0] + v0[1] * v0[1]) + (v0[2] * v0[2] + v0[3] * v0[3]) + (v1[0] * v1[0] + v1[1] * v1[1]) + (v1[2] * v1[2] + v1[3] * v1[3]);
        }
        ss = wave_sum(ss);
        if (lane < 32) SSQ[(size_t)row * 32 + lane] = lane == 0 ? ss : 0.f;
    }
}

constexpr int ML_KN = 0, ML_KNS = 272, ML_KT = 34816, ML_KTS = 272, ML_VT = 69632, ML_VTS = 272, ML_CTB = ML_VT + 80 * 272  , ML_CTBS = 528, ML_GA = ML_CTB + 80 * 528  ;
static_assert(ML_GA + 2816 <= SCR_BYTES, "mLSTM LDS map");

#define ML_HALF(DH) do { \
    _Pragma("unroll") for (int jb = 0; jb < 8; ++jb) _Pragma("unroll") for (int ks = 0; ks < 4; ++ks) { \
        const bf16x8 af = *(const LAS bf16x8*)(lds + ML_KN + (16 * jb + i16) * ML_KNS + (32 * ks + 8 * g) * 2); as_[jb] = MFMA16(af, qf[4 * (DH) + ks], as_[jb]); } \
    _Pragma("unroll") for (int vb = 0; vb < 5; ++vb) accC[DH][vb] = accC[DH][vb] * decay; \
    _Pragma("unroll") for (int ks = 0; ks < 4; ++ks) { \
        const bf16x8 bfr = *(const LAS bf16x8*)(lds + ML_KT + (16 * wave + i16) * ML_KTS + (32 * ks + 8 * g) * 2); \
        _Pragma("unroll") for (int vb = 0; vb < 5; ++vb) { const bf16x8 afr = *(const LAS bf16x8*)(lds + ML_VT + (16 * vb + i16) * ML_VTS + (32 * ks + 8 * g) * 2); accC[DH][vb] = MFMA16(afr, bfr, accC[DH][vb]); } } \
} while (0)
#define ML_PUT_CTB(DH) do { _Pragma("unroll") for (int vb = 0; vb < 5; ++vb) _Pragma("unroll") for (int r = 0; r < 4; ++r) \
    *(LAS bf16*)(lds + ML_CTB + (16 * vb + 4 * g + r) * ML_CTBS + (128 * (DH) + 16 * wave + i16) * 2) = (bf16)(pk2(accC[DH][vb][r], 0.f) & 0xffffu); } while (0)
#define ML_LOAD_K(DH) do { _Pragma("unroll") for (int it = 0; it < 2; ++it) { const int dc = wave + 8 * it; \
    const bf16* kp = QKVO + (rowbase + 2 * lane) * NAIN + 1024 + h * ADK + 128 * (DH) + 8 * dc; \
    const v4u r0 = *(const v4u*)kp, r1 = *(const v4u*)(kp + NAIN); \
    *(LAS v4u*)(lds + ML_KN + (2 * lane) * ML_KNS + 16 * dc) = r0; *(LAS v4u*)(lds + ML_KN + (2 * lane + 1) * ML_KNS + 16 * dc) = r1; \
    const float w0 = ga[512 + 2 * lane], w1 = ga[512 + 2 * lane + 1]; \
    _Pragma("unroll") for (int e = 0; e < 8; ++e) *(LAS unsigned*)(lds + ML_KT + (8 * dc + e) * ML_KTS + 4 * lane) = pk2(__uint_as_float(bfel(r0, e) << 16) * w0, __uint_as_float(bfel(r1, e) << 16) * w1); } } while (0)

__device__ __forceinline__ void mlstm_prompt_unit(LAS unsigned char* lds, const bf16* QKVO, const float* GATES, float* HM, float* HSSQ, float* out, int b, int h, int j, int tid, int wave, int lane) {
    const int i16 = lane & 15, g = lane >> 4;
    LAS float* ga = (LAS float*)(lds + ML_GA);
    f32x4 accC[2][5];
#pragma unroll
    for (int dh = 0; dh < 2; ++dh)
#pragma unroll
        for (int vb = 0; vb < 5; ++vb) accC[dh][vb] = (f32x4){0.f, 0.f, 0.f, 0.f};
    __syncthreads();
    for (int o = tid * 16; o < 80 * ML_CTBS; o += 512 * 16) *(LAS v4u*)(lds + ML_CTB + o) = (v4u){0u, 0u, 0u, 0u};
    for (int o = tid; o < 16 * 64; o += 512) { const int rr = o >> 6, cc = o & 63; *(LAS unsigned*)(lds + ML_VT + (64 + rr) * ML_VTS + cc * 4) = rr == 0 ? 0x3F803F80u : 0u; }
    float m_prev = 0.f;
    for (int c = 0; c < 17; ++c) {
        const int tok0 = c == 0 ? 0 : NMETA + 128 * (c - 1), nvalid = c == 0 ? NMETA : 128;
        const size_t rowbase = (size_t)b * TP + tok0;
        __syncthreads();
        bf16x8 qf[8];
        { const bf16* qp = QKVO + (rowbase + 16 * wave + i16) * NAIN + h * ADK + 8 * g;
#pragma unroll
          for (int ks = 0; ks < 8; ++ks) qf[ks] = *(const bf16x8*)(qp + 32 * ks); }
        if (wave == 0) {
            const int t0 = 2 * lane, t1 = t0 + 1;
            float ig0 = -1e30f, ig1 = -1e30f, lf0 = 0.f, lf1 = 0.f;
            if (t0 < nvalid) { const float* gp = GATES + (rowbase + t0) * 8; ig0 = gp[h]; lf0 = gp[4 + h]; }
            if (t1 < nvalid) { const float* gp = GATES + (rowbase + t1) * 8; ig1 = gp[h]; lf1 = gp[4 + h]; }
            const float c1 = lf0 + lf1; float sc = c1;
#pragma unroll
            for (int o = 1; o < 64; o <<= 1) { const float t = __shfl_up(sc, o); if (lane >= o) sc += t; }
            const float excl = sc - c1, b0 = excl + lf0, b1 = excl + c1;
            const float a0 = ig0 - b0, a1 = ig1 - b1;
            float smx = fmaxf(a0, a1);
#pragma unroll
            for (int o = 1; o < 64; o <<= 1) { const float t = __shfl_up(smx, o); if (lane >= o) smx = fmaxf(smx, t); }
            float exm = __shfl_up(smx, 1); if (lane == 0) exm = -INFINITY;
            const float p0 = fmaxf(exm, a0), p1 = fmaxf(p0, a1);
            const float pm0 = fmaxf(m_prev, p0), pm1 = fmaxf(m_prev, p1);
            const float Mx = fmaxf(m_prev, __shfl(smx, 63)), blast = __shfl(b1, 63);
            ga[t0] = a0; ga[t1] = a1; ga[128 + t0] = pm0; ga[128 + t1] = pm1;
            ga[256 + t0] = __expf(m_prev - pm0); ga[256 + t1] = __expf(m_prev - pm1);
            ga[384 + t0] = __expf(-(b0 + pm0)); ga[384 + t1] = __expf(-(b1 + pm1));
            ga[512 + t0] = __expf(a0 - Mx); ga[512 + t1] = __expf(a1 - Mx);
            if (lane == 0) ga[640] = __expf(m_prev - Mx);
            m_prev = blast + Mx;
        }
        __syncthreads();
        {
            const bf16* vp = QKVO + (rowbase + 2 * lane) * NAIN + 2048 + h * ADV + 64 * j + 8 * wave;
            const v4u r0 = *(const v4u*)vp, r1 = *(const v4u*)(vp + NAIN);
#pragma unroll
            for (int e = 0; e < 8; ++e) *(LAS unsigned*)(lds + ML_VT + (8 * wave + e) * ML_VTS + 4 * lane) = bfel(r0, e) | (bfel(r1, e) << 16);
        }
        ML_LOAD_K(0);
        __syncthreads();
        const float decay = ga[640];
        f32x4 aqc[5], as_[8];
#pragma unroll
        for (int vb = 0; vb < 5; ++vb) { aqc[vb] = (f32x4){0.f, 0.f, 0.f, 0.f};
#pragma unroll
            for (int ks = 0; ks < 8; ++ks) { const bf16x8 bfr = *(const LAS bf16x8*)(lds + ML_CTB + (16 * vb + i16) * ML_CTBS + (32 * ks + 8 * g) * 2); aqc[vb] = MFMA16(qf[ks], bfr, aqc[vb]); } }
#pragma unroll
        for (int jb = 0; jb < 8; ++jb) as_[jb] = (f32x4){0.f, 0.f, 0.f, 0.f};
        ML_HALF(0);
        __syncthreads();
        ML_PUT_CTB(0);
        ML_LOAD_K(1);
        __syncthreads();
        ML_HALF(1);
        ML_PUT_CTB(1);
        const int tl = 16 * wave + i16; const float pmt = ga[128 + tl];
        bf16x8 pf[4];
#pragma unroll
        for (int kk = 0; kk < 4; ++kk) { float pv[8];
#pragma unroll
            for (int hb = 0; hb < 2; ++hb) { const int jb = 2 * kk + hb; const f32x4 av = *(const LAS f32x4*)(ga + 16 * jb + 4 * g);
#pragma unroll
                for (int r = 0; r < 4; ++r) { const int s = 16 * jb + 4 * g + r; const float wgt = (s <= tl) ? __expf(av[r] - pmt) : 0.f; pv[4 * hb + r] = as_[jb][r] * wgt; } }
            v4u w; w.x = pk2(pv[0], pv[1]); w.y = pk2(pv[2], pv[3]); w.z = pk2(pv[4], pv[5]); w.w = pk2(pv[6], pv[7]); pf[kk] = __builtin_bit_cast(bf16x8, w); }
        f32x4 apv[5];
#pragma unroll
        for (int vb = 0; vb < 5; ++vb) { apv[vb] = (f32x4){0.f, 0.f, 0.f, 0.f};
#pragma unroll
            for (int kk = 0; kk < 4; ++kk) { const LAS unsigned char* vp = lds + ML_VT + (16 * vb + i16) * ML_VTS + (32 * kk + 4 * g) * 2;
                const v2u lo = *(const LAS v2u*)vp, hi = *(const LAS v2u*)(vp + 32); const v4u w = (v4u){lo.x, lo.y, hi.x, hi.y};
                apv[vb] = MFMA16(pf[kk], __builtin_bit_cast(bf16x8, w), apv[vb]); } }
        const f32x4 wi4 = *(const LAS f32x4*)(ga + 256 + 16 * wave + 4 * g), ef4 = *(const LAS f32x4*)(ga + 384 + 16 * wave + 4 * g);
#pragma unroll
        for (int r = 0; r < 4; ++r) { const int tr = 16 * wave + 4 * g + r; const float wi = wi4[r];
            float den = apv[4][r] + wi * aqc[4][r]; den = __shfl(den, lane & 48); den = fmaxf(fabsf(den), ef4[r]);
            const float inv = 1.0f / den; float ss = 0.f; const bool ok = tr < nvalid;
#pragma unroll
            for (int vb = 0; vb < 4; ++vb) { const float hv = (apv[vb][r] + wi * aqc[vb][r]) * inv; ss += hv * hv;
                if (ok) HM[(rowbase + tr) * DM + h * ADV + 64 * j + 16 * vb + i16] = hv; }
            ss += __shfl_xor(ss, 1); ss += __shfl_xor(ss, 2); ss += __shfl_xor(ss, 4); ss += __shfl_xor(ss, 8);
            if (ok && i16 == 0) HSSQ[(rowbase + tr) * 32 + h * 8 + j] = ss; }
    }
    const size_t bh = (size_t)b * AH + h;
#pragma unroll
    for (int dh = 0; dh < 2; ++dh) { const int d = 128 * dh + 16 * wave + i16;
#pragma unroll
        for (int vb = 0; vb < 4; ++vb) *(f32x4*)(out + O_CP + (bh * ADK + d) * ADV + 64 * j + 16 * vb + 4 * g) = accC[dh][vb];
        if (j == 0 && g == 0) out[O_NP + bh * ADK + d] = accC[dh][4][0]; }
    if (j == 0 && tid == 0) out[O_MP + bh] = m_prev;
}

__device__ __forceinline__ void mlstm_sample_unit(LAS unsigned char* lds, const bf16* QKVO, const float* GATES, const float* stC, const float* stN, const float* stM,
                                                  float* HM, float* HSSQ, float* out, int b, int h, int tid, int wave, int lane) {
    LAS float* qT = (LAS float*)lds;
    LAS float* wkT = (LAS float*)(lds + 4096);
    LAS float* qN = (LAS float*)(lds + 8192);
    LAS float* kN = (LAS float*)(lds + 12288);
    LAS float* dots = (LAS float*)(lds + 16384);
    LAS float* red = (LAS float*)(lds + 16640);
    const int row0 = MPR + DECS * b; const size_t bh = (size_t)b * AH + h;
    float ig[4], bb[4], a_[4], pm[4], wint[4], efl[4], wst[4];
    const float mprev = stM[bh];
    { float run = 0.f, pmax = -INFINITY;
#pragma unroll
      for (int s = 0; s < 4; ++s) { ig[s] = GATES[(size_t)(row0 + s) * 8 + h]; run += GATES[(size_t)(row0 + s) * 8 + 4 + h]; bb[s] = run; a_[s] = ig[s] - bb[s]; pmax = fmaxf(pmax, a_[s]);
          pm[s] = fmaxf(mprev, pmax); wint[s] = __expf(mprev - pm[s]); efl[s] = __expf(-(bb[s] + pm[s])); } }
    const float Mx = pm[3], decay = __expf(mprev - Mx), mnew = bb[3] + Mx;
#pragma unroll
    for (int s = 0; s < 4; ++s) wst[s] = __expf(a_[s] - Mx);
    __syncthreads();
    { const int s = tid >> 7, d2 = (tid & 127) * 2; const bf16* qp = QKVO + (size_t)(row0 + s) * NAIN + h * ADK + d2;
      const unsigned qq = *(const unsigned*)qp, kk = *(const unsigned*)(qp + 1024);
      const float q0 = bflo(qq), q1 = bfhi(qq), k0 = bflo(kk), k1 = bfhi(kk);
      const float w = s == 0 ? wst[0] : s == 1 ? wst[1] : s == 2 ? wst[2] : wst[3];
      qT[d2 * 4 + s] = q0; qT[(d2 + 1) * 4 + s] = q1; wkT[d2 * 4 + s] = w * k0; wkT[(d2 + 1) * 4 + s] = w * k1;
      qN[s * 256 + d2] = q0; qN[s * 256 + d2 + 1] = q1; kN[s * 256 + d2] = k0; kN[s * 256 + d2 + 1] = k1; }
    __syncthreads();
    for (int x = wave; x < 20; x += 8) { float p = 0.f;
        if (x < 16) { const int t = x >> 2, s = x & 3;
#pragma unroll
            for (int i = 0; i < 4; ++i) p += qN[t * 256 + lane + 64 * i] * kN[s * 256 + lane + 64 * i]; }
        else { const int t = x - 16;
#pragma unroll
            for (int i = 0; i < 4; ++i) p += qN[t * 256 + lane + 64 * i] * stN[bh * ADK + lane + 64 * i]; }
        p = wave_sum(p); if (lane == 0) dots[x] = p; }
    __syncthreads();
    float P[4][4], deninv[4];
#pragma unroll
    for (int t = 0; t < 4; ++t) { float den = 0.f;
#pragma unroll
        for (int s = 0; s < 4; ++s) { P[t][s] = s <= t ? dots[4 * t + s] * __expf(a_[s] - pm[t]) : 0.f; den += P[t][s]; }
        den += wint[t] * dots[16 + t]; deninv[t] = 1.0f / fmaxf(fabsf(den), efl[t]); }
    const int eq = tid & 127, dq = tid >> 7;
    f32x4 vv[4];
#pragma unroll
    for (int s = 0; s < 4; ++s) { const v2u w = *(const v2u*)(QKVO + (size_t)(row0 + s) * NAIN + 2048 + h * ADV + 4 * eq); vv[s] = (f32x4){bflo(w.x), bfhi(w.x), bflo(w.y), bfhi(w.y)}; }
    f32x4 qc[4];
#pragma unroll
    for (int t = 0; t < 4; ++t) qc[t] = (f32x4){0.f, 0.f, 0.f, 0.f};
    const float* Cin = stC + bh * ADK * ADV + 4 * eq; float* Cout = out + O_CS + bh * ADK * ADV + 4 * eq;
#pragma unroll 8
    for (int dd = 0; dd < 64; ++dd) { const int d = 64 * dq + dd;
        const f32x4 c = *(const f32x4*)(Cin + (size_t)d * ADV); const f32x4 q4 = *(const LAS f32x4*)(qT + 4 * d), k4 = *(const LAS f32x4*)(wkT + 4 * d);
#pragma unroll
        for (int t = 0; t < 4; ++t) qc[t] += c * q4[t];
        *(f32x4*)(Cout + (size_t)d * ADV) = c * decay + vv[0] * k4[0] + vv[1] * k4[1] + vv[2] * k4[2] + vv[3] * k4[3]; }
#pragma unroll
    for (int t = 0; t < 4; ++t) *(LAS f32x4*)(red + (dq * 4 + t) * 512 + 4 * eq) = qc[t];
    __syncthreads();
    { const int e = tid; float ve[4];
#pragma unroll
      for (int s = 0; s < 4; ++s) ve[s] = __uint_as_float((unsigned)QKVO[(size_t)(row0 + s) * NAIN + 2048 + h * ADV + e] << 16);
#pragma unroll
      for (int t = 0; t < 4; ++t) { const float qcs = (red[(0 * 4 + t) * 512 + e] + red[(1 * 4 + t) * 512 + e]) + (red[(2 * 4 + t) * 512 + e] + red[(3 * 4 + t) * 512 + e]);
          float pvv = 0.f;
#pragma unroll
          for (int s = 0; s < 4; ++s) pvv += P[t][s] * ve[s];
          const float hv = (pvv + wint[t] * qcs) * deninv[t];
          HM[(size_t)(row0 + t) * DM + h * ADV + e] = hv;
          const float ss = wave_sum(hv * hv); if (lane == 0) HSSQ[(size_t)(row0 + t) * 32 + h * 8 + wave] = ss; } }
    if (tid < ADK) { const f32x4 k4 = *(const LAS f32x4*)(wkT + 4 * tid); out[O_NS + bh * ADK + tid] = decay * stN[bh * ADK + tid] + ((k4[0] + k4[1]) + (k4[2] + k4[3])); }
    if (tid == 0) out[O_MS + bh] = mnew;
}

__device__ __forceinline__ void mlstm_gate_rows(const float* HM, const float* HSSQ, const bf16* QKVO, const float* gain, bf16* AM, int gw, int NGW, int lane) {
    for (int row = gw; row < MREAL; row += NGW) {
#pragma unroll
        for (int i = 0; i < 4; ++i) {
            const f32x4 s0 = *(const f32x4*)(HSSQ + (size_t)row * 32 + 8 * i), s1 = *(const f32x4*)(HSSQ + (size_t)row * 32 + 8 * i + 4);
            const float rs = rsqrtf((((s0[0] + s0[1]) + (s0[2] + s0[3])) + ((s1[0] + s1[1]) + (s1[2] + s1[3]))) * (1.0f / ADV) + EPS);
            const int c = 512 * i + 8 * lane;
            const f32x4 h0 = *(const f32x4*)(HM + (size_t)row * DM + c), h1 = *(const f32x4*)(HM + (size_t)row * DM + c + 4);
            const f32x4 g0 = *(const f32x4*)(gain + c), g1 = *(const f32x4*)(gain + c + 4);
            const v4u ow = *(const v4u*)(QKVO + (size_t)row * NAIN + 4096 + c);
            float o[8];
#pragma unroll
            for (int e = 0; e < 8; ++e) { const float ov = __uint_as_float(bfel(ow, e) << 16); const float sg = __builtin_amdgcn_rcpf(1.0f + __expf(-ov));
                const float hv = e < 4 ? h0[e & 3] * g0[e & 3] : h1[e & 3] * g1[e & 3]; o[e] = hv * rs * sg; }
            v4u w; w.x = pk2(o[0], o[1]); w.y = pk2(o[2], o[3]); w.z = pk2(o[4], o[5]); w.w = pk2(o[6], o[7]);
            *(v4u*)(AM + (size_t)row * DM + c) = w;
        }
    }
}

template <int NKEY> struct AttnLds { static constexpr int KNS = 144, KN = 0, VT = NKEY * 144, VTS = NKEY * 2 + 16, END = VT + 64 * VTS; };

struct AttnMask { int rel0, lim, mrel;
    __device__ __forceinline__ bool operator()(int jj, int blk, int r, float& dist) const {
        if (jj == 0) { dist = (float)WIN; return mrel - r >= WIN; }
        const int rel = rel0 - 16 * blk - r; dist = (float)rel; return (unsigned)rel <= (unsigned)lim; } };
template <int NKEY, int NJB, class BlkF>
__device__ __forceinline__ void attn_tblock(LAS unsigned char* lds, const bf16x8 qf0, const bf16x8 qf1, float slope, float sink, const AttnMask& mask, const BlkF& blk,
                                            bf16* orow  , int nq_valid, int lane) {
    typedef AttnLds<NKEY> L;
    const int i16 = lane & 15, g = lane >> 4;
    f32x4 sacc[NJB];
#pragma unroll
    for (int jb = 0; jb < NJB; ++jb) { sacc[jb] = (f32x4){0.f, 0.f, 0.f, 0.f};
        const LAS unsigned char* kp = lds + L::KN + (16 * blk(jb) + i16) * L::KNS + 16 * g;
        sacc[jb] = MFMA16(*(const LAS bf16x8*)kp, qf0, sacc[jb]); sacc[jb] = MFMA16(*(const LAS bf16x8*)(kp + 64), qf1, sacc[jb]); }
    float mx = sink;
#pragma unroll
    for (int jb = 0; jb < NJB; ++jb)
#pragma unroll
        for (int r = 0; r < 4; ++r) { float dist; const bool ok = mask(jb, blk(jb), r, dist); const float sv = ok ? sacc[jb][r] - slope * dist : -INFINITY; sacc[jb][r] = sv; mx = fmaxf(mx, sv); }
    mx = fmaxf(mx, __shfl_xor(mx, 16)); mx = fmaxf(mx, __shfl_xor(mx, 32));
    float sum = 0.f;
#pragma unroll
    for (int jb = 0; jb < NJB; ++jb)
#pragma unroll
        for (int r = 0; r < 4; ++r) { const float p = __expf(sacc[jb][r] - mx); sacc[jb][r] = p; sum += p; }
    sum += __shfl_xor(sum, 16); sum += __shfl_xor(sum, 32);
    sum += __expf(sink - mx);
    const float inv = 1.0f / sum;
    f32x4 oacc[4];
#pragma unroll
    for (int db = 0; db < 4; ++db) oacc[db] = (f32x4){0.f, 0.f, 0.f, 0.f};
#pragma unroll
    for (int kk = 0; kk < NJB / 2; ++kk) {
        v4u w; w.x = pk2(sacc[2 * kk][0], sacc[2 * kk][1]); w.y = pk2(sacc[2 * kk][2], sacc[2 * kk][3]); w.z = pk2(sacc[2 * kk + 1][0], sacc[2 * kk + 1][1]); w.w = pk2(sacc[2 * kk + 1][2], sacc[2 * kk + 1][3]);
        const bf16x8 pf = __builtin_bit_cast(bf16x8, w);
#pragma unroll
        for (int db = 0; db < 4; ++db) { const LAS unsigned char* vp = lds + L::VT + (16 * db + i16) * L::VTS + 8 * g;
            const v2u lo = *(const LAS v2u*)(vp + 32 * blk(2 * kk)), hi = *(const LAS v2u*)(vp + 32 * blk(2 * kk + 1)); const v4u bw = (v4u){lo.x, lo.y, hi.x, hi.y};
            oacc[db] = MFMA16(__builtin_bit_cast(bf16x8, bw), pf, oacc[db]); } }
    if (i16 < nq_valid) {
#pragma unroll
        for (int db = 0; db < 4; ++db) { const f32x4 o = oacc[db] * inv; v2u w; w.x = pk2(o[0], o[1]); w.y = pk2(o[2], o[3]); *(v2u*)(orow + (size_t)i16 * DM + 16 * db + 4 * g) = w; } }
}

__device__ __forceinline__ void attn_prompt_unit(LAS unsigned char* lds, const bf16* QB, const bf16* KB, const bf16* VB, const float* sinks, bf16* AM, int b, int g, int n, int tid, int wave, int lane) {
    typedef AttnLds<288> L;
    const int hh = 8 * g + wave; const float slope = exp2f(-0.25f * (float)(hh + 1)), sink = sinks[hh];
    const bf16* qbase = QB + ((size_t)b * TP + 128 * n + (lane & 15)) * DM + hh * 64 + 8 * (lane >> 4);
    bf16x8 q0 = *(const bf16x8*)qbase, q1 = *(const bf16x8*)(qbase + 32);
    __syncthreads();
    { v4u kr[5], vr0[3], vr1[3];
#pragma unroll
      for (int i = 0; i < 5; ++i) { const int it = tid + 512 * i, kk = it >> 3, ch = it & 7; const int pos = kk < NMETA ? kk : 128 * (n - 1) + kk - NMETA; kr[i] = (v4u){0u, 0u, 0u, 0u};
          if (it < 288 * 8 && kk < NMETA + 256 && pos >= 0 && pos < TP) kr[i] = *(const v4u*)(KB + ((size_t)b * TP + pos) * 256 + g * 64 + 8 * ch); }
#pragma unroll
      for (int i = 0; i < 3; ++i) { const int it = tid + 512 * i, ch = it / 144, p = it - ch * 144; vr0[i] = (v4u){0u, 0u, 0u, 0u}; vr1[i] = vr0[i];
          if (it < 144 * 8) {
              { const int kk = 2 * p, pos = kk < NMETA ? kk : 128 * (n - 1) + kk - NMETA; if (kk < NMETA + 256 && pos >= 0 && pos < TP) vr0[i] = *(const v4u*)(VB + ((size_t)b * TP + pos) * 256 + g * 64 + 8 * ch); }
              { const int kk = 2 * p + 1, pos = kk < NMETA ? kk : 128 * (n - 1) + kk - NMETA; if (kk < NMETA + 256 && pos >= 0 && pos < TP) vr1[i] = *(const v4u*)(VB + ((size_t)b * TP + pos) * 256 + g * 64 + 8 * ch); } } }
#pragma unroll
      for (int i = 0; i < 5; ++i) { const int it = tid + 512 * i, kk = it >> 3, ch = it & 7; if (it < 288 * 8) *(LAS v4u*)(lds + L::KN + kk * L::KNS + 16 * ch) = kr[i]; }
#pragma unroll
      for (int i = 0; i < 3; ++i) { const int it = tid + 512 * i, ch = it / 144, p = it - ch * 144;
          if (it < 144 * 8) {
#pragma unroll
              for (int e = 0; e < 8; ++e) *(LAS unsigned*)(lds + L::VT + (8 * ch + e) * L::VTS + 4 * p) = bfel(vr0[i], e) | (bfel(vr1[i], e) << 16); } } }
    __syncthreads();
    for (int tb = 0; tb < 8; ++tb) { const int tpos0 = 128 * n + 16 * tb; if (tpos0 >= TP) break;
        const size_t row0 = (size_t)b * TP + tpos0;
        const int tbn = (tb < 7 && tpos0 + 16 < TP) ? tb + 1 : tb;
        const bf16x8 n0 = *(const bf16x8*)(qbase + (size_t)tbn * 16 * DM), n1 = *(const bf16x8*)(qbase + (size_t)tbn * 16 * DM + 32);
        __builtin_amdgcn_sched_barrier(0);
        const int tpos = tpos0 + (lane & 15);
        const AttnMask mk{tpos - 128 * (n - 1) + NMETA - 4 * (lane >> 4), tpos < WIN - 1 ? tpos : WIN - 1, tpos - 4 * (lane >> 4)};
        const auto blk = [tb](int jj) { return jj == 0 ? 0 : tb + jj; };
        attn_tblock<288, 10>(lds, q0, q1, slope, sink, mk, blk, AM + row0 * DM + hh * 64, 16, lane);
        q0 = n0; q1 = n1; }
}
__device__ __forceinline__ void attn_sample_unit(LAS unsigned char* lds, const bf16* QB, const bf16* KB, const bf16* VB, const float* ckm, const float* cvm, const float* ckw, const float* cvw,
                                                 const float* sinks, bf16* AM, int b, int g, int tid, int wave, int lane) {
    typedef AttnLds<160> L;
    const int hh = 8 * g + wave; const float slope = exp2f(-0.25f * (float)(hh + 1)), sink = sinks[hh];
    const size_t row0 = (size_t)MPR + DECS * b;
    const bf16* qbase = QB + (row0 + (lane & 15)) * DM + hh * 64 + 8 * (lane >> 4);
    const bf16x8 q0 = *(const bf16x8*)qbase, q1 = *(const bf16x8*)(qbase + 32);
    __syncthreads();
    for (int it = tid; it < 160 * 8; it += 512) { const int kk = it >> 3, ch = it & 7; v4u r = (v4u){0u, 0u, 0u, 0u};
        if (kk < NMETA + WIN) { const float* src = kk < NMETA ? ckm + (((size_t)b * NMETA + kk) * BKV + g) * 64 + 8 * ch : ckw + (((size_t)b * WIN + (kk - NMETA)) * BKV + g) * 64 + 8 * ch;
            const f32x4 f0 = *(const f32x4*)src, f1 = *(const f32x4*)(src + 4); r.x = pk2(f0[0], f0[1]); r.y = pk2(f0[2], f0[3]); r.z = pk2(f1[0], f1[1]); r.w = pk2(f1[2], f1[3]); }
        else if (kk < NMETA + WIN + DECS) r = *(const v4u*)(KB + ((size_t)MPR + DECS * b + (kk - NMETA - WIN)) * 256 + g * 64 + 8 * ch);
        *(LAS v4u*)(lds + L::KN + kk * L::KNS + 16 * ch) = r; }
    for (int it = tid; it < 80 * 8; it += 512) { const int ch = it / 80, p = it - ch * 80; v4u rr[2];
#pragma unroll
        for (int q = 0; q < 2; ++q) { const int kk = 2 * p + q; v4u r = (v4u){0u, 0u, 0u, 0u};
            if (kk < NMETA + WIN) { const float* src = kk < NMETA ? cvm + (((size_t)b * NMETA + kk) * BKV + g) * 64 + 8 * ch : cvw + (((size_t)b * WIN + (kk - NMETA)) * BKV + g) * 64 + 8 * ch;
                const f32x4 f0 = *(const f32x4*)src, f1 = *(const f32x4*)(src + 4); r.x = pk2(f0[0], f0[1]); r.y = pk2(f0[2], f0[3]); r.z = pk2(f1[0], f1[1]); r.w = pk2(f1[2], f1[3]); }
            else if (kk < NMETA + WIN + DECS) r = *(const v4u*)(VB + ((size_t)MPR + DECS * b + (kk - NMETA - WIN)) * 256 + g * 64 + 8 * ch);
            rr[q] = r; }
#pragma unroll
        for (int e = 0; e < 8; ++e) *(LAS unsigned*)(lds + L::VT + (8 * ch + e) * L::VTS + 4 * p) = bfel(rr[0], e) | (bfel(rr[1], e) << 16); }
    __syncthreads();
    const AttnMask mk{WIN + (lane & 15) + NMETA - 4 * (lane >> 4), WIN - 1, 1 << 20};
    const auto blk = [](int jj) { return jj; };
    attn_tblock<160, 10>(lds, q0, q1, slope, sink, mk, blk, AM + row0 * DM + hh * 64, DECS, lane);
}
__device__ __forceinline__ void kv_outputs(const Args& a, const bf16* KB, const bf16* VB, size_t gtid, size_t gthreads) {
    float* out = a.out;
    for (size_t i = gtid; i < (size_t)NBATCH * (NMETA + WIN) * 256; i += gthreads) { const int c = (int)(i & 255); const int rr = (int)(i >> 8); const int b = rr / (NMETA + WIN), q = rr - b * (NMETA + WIN);
        const int t = q < NMETA ? q : TP - WIN + (q - NMETA); const size_t src = ((size_t)b * TP + t) * 256 + c;
        const float kv = __uint_as_float((unsigned)KB[src] << 16), vv = __uint_as_float((unsigned)VB[src] << 16);
        if (q < NMETA) { out[O_KMP + ((size_t)b * NMETA + q) * 256 + c] = kv; out[O_VMP + ((size_t)b * NMETA + q) * 256 + c] = vv; }
        else { out[O_KWP + ((size_t)b * WIN + (q - NMETA)) * 256 + c] = kv; out[O_VWP + ((size_t)b * WIN + (q - NMETA)) * 256 + c] = vv; } }
    for (size_t i = gtid; i < (size_t)DECB * WIN * 64; i += gthreads) { const int c4 = (int)(i & 63) * 4; const int rr = (int)(i >> 6); const int b = rr >> 7, jj = rr & 127;
        f32x4 kv, vv;
        if (jj < WIN - DECS) { kv = *(const f32x4*)(a.in[I_CKW] + ((size_t)b * WIN + jj + DECS) * 256 + c4); vv = *(const f32x4*)(a.in[I_CVW] + ((size_t)b * WIN + jj + DECS) * 256 + c4); }
        else { const size_t src = ((size_t)MPR + DECS * b + (jj - (WIN - DECS))) * 256 + c4; const v2u kw = *(const v2u*)(KB + src), vw = *(const v2u*)(VB + src);
            kv = (f32x4){bflo(kw.x), bfhi(kw.x), bflo(kw.y), bfhi(kw.y)}; vv = (f32x4){bflo(vw.x), bfhi(vw.x), bflo(vw.y), bfhi(vw.y)}; }
        *(f32x4*)(out + O_KWS + ((size_t)b * WIN + jj) * 256 + c4) = kv; *(f32x4*)(out + O_VWS + ((size_t)b * WIN + jj) * 256 + c4) = vv; }
}

#define GEMM_PHASE(EPI_T, E, Aptr, Bptr, N_, K_) do { pg8::Gemm gg{(const pg8::bf16_t*)(Aptr), (const pg8::bf16_t*)(Bptr), MP, (N_), (K_)}; int bx_ = (int)blockIdx.x; asm volatile("" : "+s"(bx_)); pg8::StaticOrder SS; SS.init(MP, (N_), G, bx_); \
    pg8::gemm_phase<EPI_T, pg8::StaticOrder, true, true>(lds, gg, SS, (E)); } while (0)

__global__ void __launch_bounds__(NWAVES * 64, 2) yoco_fwd(Args args) {
    extern __shared__ __attribute__((aligned(16))) unsigned char lds_raw[];
    LAS unsigned char* lds = (LAS unsigned char*)lds_raw;
    volatile LAS unsigned* MISC = (volatile LAS unsigned*)(lds + MISC_OFF);
    const int tid = threadIdx.x, lane = tid & 63, wave = __builtin_amdgcn_readfirstlane(tid >> 6);
    const int G = gridDim.x, gw = blockIdx.x * NWAVES + wave, NGW = G * NWAVES;
    unsigned char* ws = args.ws;
    for (int u = tid; u < (LDS_BYTES - MISC_OFF) / 4; u += NWAVES * 64) ((LAS unsigned*)(lds + MISC_OFF))[u] = 0u;
    __syncthreads();
    XcdBarrier bar = xcd_barrier_post((unsigned*)(ws + WS_CTL) + CW_BAR, MISC + 8);

    float* H = (float*)(ws + WS_H); bf16* AB = (bf16*)(ws + WS_AB); bf16* ACT = (bf16*)(ws + WS_ACT); bf16* QKVO = (bf16*)(ws + WS_ACT);
    float* HM = (float*)(ws + WS_HM); bf16* AM = (bf16*)(ws + WS_AM); bf16* QB = (bf16*)(ws + WS_QB); bf16* KB = (bf16*)(ws + WS_KB); bf16* VB = (bf16*)(ws + WS_VB);
    float* SSQ = (float*)(ws + WS_SSQ); float* HSSQ = (float*)(ws + WS_HSSQ); float* GATES = (float*)(ws + WS_GATES);

    p0_prologue(args, lds, gw, NGW, wave, lane);
    xcd_barrier(bar);

    { EpiSwiglu E{ACT, SSQ}; GEMM_PHASE(EpiSwiglu, E, AB, ws + WS_W1 + 0 * SZ_W1, 2 * DFF, DM); }
    xcd_barrier(bar);
    { EpiResid<false> E{H, AB, SSQ, 0.5f, nullptr}; GEMM_PHASE(EpiResid<false>, E, ACT, ws + WS_W2 + 0 * SZ_W2, DM, DFF); }
    xcd_barrier(bar);

    { EpiQkvo E{QKVO, SSQ, GATES, args.in[I_BAG]}; GEMM_PHASE(EpiQkvo, E, AB, ws + WS_WAIN, NAIN_PAD, DM); }
    xcd_barrier(bar);
    for (int u = blockIdx.x; u < NBATCH * AH * 8; u += G) mlstm_prompt_unit(lds, QKVO, GATES, HM, HSSQ, args.out, u >> 5, (u >> 3) & 3, u & 7, tid, wave, lane);
    for (int u = blockIdx.x; u < DECB * AH; u += G) mlstm_sample_unit(lds, QKVO, GATES, args.in[I_SC], args.in[I_SN], args.in[I_SM], HM, HSSQ, args.out, u >> 2, u & 3, tid, wave, lane);
    xcd_barrier(bar);
    mlstm_gate_rows(HM, HSSQ, QKVO, args.in[I_AHN], AM, gw, NGW, lane);
    xcd_barrier(bar);
    { EpiResid<false> E{H, AB, SSQ, 1.0f, nullptr}; GEMM_PHASE(EpiResid<false>, E, AM, ws + WS_WAOUT, DM, DM); }
    xcd_barrier(bar);

    { EpiSwiglu E{ACT, SSQ}; GEMM_PHASE(EpiSwiglu, E, AB, ws + WS_W1 + 1 * SZ_W1, 2 * DFF, DM); }
    xcd_barrier(bar);
    { EpiResid<false> E{H, AB, SSQ, 0.5f, nullptr}; GEMM_PHASE(EpiResid<false>, E, ACT, ws + WS_W2 + 1 * SZ_W2, DM, DFF); }
    xcd_barrier(bar);

    { EpiHead E{KB, 256, VB, 256, 1, SSQ, args.in[I_KN], 1.0f}; GEMM_PHASE(EpiHead, E, AB, ws + WS_WKV, 512, DM); }
    { EpiSwiglu E{ACT, SSQ}; GEMM_PHASE(EpiSwiglu, E, AB, ws + WS_W1 + 2 * SZ_W1, 2 * DFF, DM); }
    xcd_barrier(bar);
    { EpiResid<false> E{H, AB, SSQ, 0.5f, nullptr}; GEMM_PHASE(EpiResid<false>, E, ACT, ws + WS_W2 + 2 * SZ_W2, DM, DFF); }
    xcd_barrier(bar);

    { EpiHead E{QB, DM, QB, DM, 8, SSQ, args.in[I_QN], 0.125f}; GEMM_PHASE(EpiHead, E, AB, ws + WS_WQ, DM, DM); }
    xcd_barrier(bar);
    kv_outputs(args, KB, VB, (size_t)blockIdx.x * (NWAVES * 64) + tid, (size_t)G * NWAVES * 64);
    for (int u = blockIdx.x; u < NBATCH * BKV * 17; u += G) { const int n = u % 17, bg = u / 17; attn_prompt_unit(lds, QB, KB, VB, args.in[I_SINK], AM, bg >> 2, bg & 3, n, tid, wave, lane); }
    for (int u = blockIdx.x; u < DECB * BKV; u += G) attn_sample_unit(lds, QB, KB, VB, args.in[I_CKM], args.in[I_CVM], args.in[I_CKW], args.in[I_CVW], args.in[I_SINK], AM, u >> 2, u & 3, tid, wave, lane);
    xcd_barrier(bar);
    { EpiResid<false> E{H, AB, SSQ, 1.0f, nullptr}; GEMM_PHASE(EpiResid<false>, E, AM, ws + WS_WBO, DM, DM); }
    xcd_barrier(bar);

    { EpiSwiglu E{ACT, SSQ}; GEMM_PHASE(EpiSwiglu, E, AB, ws + WS_W1 + 3 * SZ_W1, 2 * DFF, DM); }
    xcd_barrier(bar);
    { EpiResid<true> E{H, AB, SSQ, 0.5f, args.out}; GEMM_PHASE(EpiResid<true>, E, ACT, ws + WS_W2 + 3 * SZ_W2, DM, DFF); }
}

extern "C" void kernel_launch(void* const* d_in, const int* in_sizes, int n_in, void* d_out, int out_size, void* d_ws, size_t ws_size, hipStream_t stream) {
    static int grid = 0;
    if (grid == 0) {
        if (n_in != 25 || (size_t)out_size != O_END || ws_size < WS_END) { fprintf(stderr, "kernel_launch: unexpected shapes (n_in %d, out %d vs %zu, ws %zu vs %zu); nothing launched\n", n_in, out_size, (size_t)O_END, ws_size, (size_t)WS_END); grid = -1; return; }
        int dev = 0, cus = 0, per_cu = 0;
        if (hipGetDevice(&dev) != hipSuccess || hipDeviceGetAttribute(&cus, hipDeviceAttributeMultiprocessorCount, dev) != hipSuccess) { grid = -1; return; }
        if (hipFuncSetAttribute((const void*)yoco_fwd, hipFuncAttributeMaxDynamicSharedMemorySize, LDS_BYTES) != hipSuccess) { fprintf(stderr, "kernel_launch: hipFuncSetAttribute failed\n"); grid = -1; return; }
        if (hipOccupancyMaxActiveBlocksPerMultiprocessor(&per_cu, (const void*)yoco_fwd, NWAVES * 64, LDS_BYTES) != hipSuccess || per_cu < 1) fprintf(stderr, "kernel_launch: occupancy query says %d\n", per_cu);
        (void)hipGetLastError();
        grid = cus;
    }
    if (grid < 0) return;
    (void)in_sizes;
    if (hipMemsetAsync((char*)d_ws + WS_CTL, 0, CTL_ZERO_BYTES, stream) != hipSuccess) return;
    Args a{};
    for (int i = 0; i < 25; ++i) a.in[i] = (const float*)d_in[i];
    a.out = (float*)d_out; a.ws = (unsigned char*)d_ws;
    hipLaunchKernelGGL(yoco_fwd, dim3(grid), dim3(NWAVES * 64), LDS_BYTES, stream, a);
}
```

```cpp
#include <hip/hip_runtime.h>
#include <cstdio>
#include <cstdint>
namespace pg8 {
#define PG8_LAS __attribute__((address_space(3)))
typedef unsigned short bf16_t;
typedef short bf16x8 __attribute__((ext_vector_type(8)));
typedef float f32x4 __attribute__((ext_vector_type(4)));
typedef unsigned u32x4 __attribute__((ext_vector_type(4)));
constexpr int BM = 256, BK = 64, HALF = 128, HTB = HALF * BK * 2  , STAGE_BYTES = 8 * HTB, NXCD = 8, WGM = 8;

__host__ __device__ __forceinline__ int lds_byte(int r, int c) { const int st = (r >> 4) * 2 + (c >> 5), rr = r & 15, cc = c & 31, ob = rr * 64 + cc * 2; return st * 1024 + (ob ^ (((ob >> 9) & 1) << 5)); }
__host__ __device__ __forceinline__ void stage_rc(int b, int& R, int& C) { const int st = b / 1024, sb = b % 1024, swz = sb ^ (((sb >> 9) & 1) << 5); R = (st >> 1) * 16 + swz / 64; C = (st & 1) * 32 + (swz % 64) / 2; }
__host__ __device__ __forceinline__ int perm32(int rho) { const int n = rho >> 4, i = rho & 15; return 8 * (i >> 2) + 4 * n + (i & 3); }

struct Unit { int pm, pn, koff, nt; };
struct Gemm { const bf16_t* A; const bf16_t* Bt; int M, N, K; };

struct StaticOrder {
    int nM, nN, nwg, G, c, nt0;
    __host__ __device__ void init(int M, int N, int G_, int c_) { nM = M / BM; nN = N / BM; nwg = nM * nN; G = G_; c = c_; }
    __host__ __device__ bool next(int i, Unit& u) const {
        const long L = (long)i * G + c; if (L >= nwg) return false;
        int wgid = (int)L; { const int q = nwg / NXCD, r = nwg % NXCD, xcd = wgid % NXCD, off = wgid / NXCD; wgid = (xcd < r ? xcd * (q + 1) : r * (q + 1) + (xcd - r) * q) + off; }
        const int nig = WGM * nN, gid = wgid / nig, fm = gid * WGM, gsz = (nM - fm) < WGM ? (nM - fm) : WGM;
        u.pm = fm + ((wgid % nig) % gsz); u.pn = (wgid % nig) / gsz; u.koff = 0; u.nt = nt0; return true;
    }
    __device__ __forceinline__ void a_ready(const Unit&) const {}
    __device__ __forceinline__ void done(const Unit&) const {}
};

__device__ __forceinline__ unsigned cvt_pk_bf16(float lo, float hi) { unsigned r; asm volatile("v_cvt_pk_bf16_f32 %0, %1, %2" : "=v"(r) : "v"(lo), "v"(hi)); return r; }
typedef float f32x2 __attribute__((ext_vector_type(2)));
template <class Epi, class Sched, bool ALIGN_EPI = false, bool SP2 = false>
__device__ __forceinline__ void gemm_phase(PG8_LAS unsigned char* lds, const Gemm g, const Sched& S, const Epi& E) {
    int tid_l = threadIdx.x; asm volatile("" : "+v"(tid_l));
    const int tid = tid_l, wid = __builtin_amdgcn_readfirstlane(tid >> 6), lane = tid & 63, wr = wid >> 2, wc = wid & 3, fr = lane & 15, fq = lane >> 4;
    const int K = g.K, nt = K / BK;
    unsigned voffA[2], voffB[2];
#pragma unroll
    for (int i = 0; i < 2; ++i) { int R, C; stage_rc(tid * 16 + i * 8192, R, C); const int Rb = Epi::PERM ? ((R & ~31) + perm32(R & 31)) : R;
        voffA[i] = (unsigned)(R * K + C) * 2u; voffB[i] = (unsigned)(Rb * K + C) * 2u; }
    const size_t kstep = (size_t)(BK * 2);
    const size_t hstep = (size_t)HALF * K * 2;
    const size_t tstep = 2 * hstep;
    const unsigned ldsw = (unsigned)wid * 1024u;
    const int aoff = lds_byte(wr * 64 + fr, fq * 8), boff = lds_byte(wc * 32 + fr, fq * 8);
#define PG8_SA(b, h) (((b) * 2 + (h)) * HTB)
#define PG8_SB(b, h) ((4 + (b) * 2 + (h)) * HTB)
#define PG8_STAGE(bufoff, gbase, voff) do { _Pragma("unroll") for (int _i = 0; _i < 2; ++_i) \
        __builtin_amdgcn_global_load_lds((const unsigned*)((const char*)(gbase) + (voff)[_i]), (PG8_LAS unsigned*)(lds + (bufoff) + ldsw + _i * 8192), 16, 0, 0); } while (0)
#define PG8_LDA(dst, b, h) do { _Pragma("unroll") for (int m = 0; m < 4; ++m) _Pragma("unroll") for (int k = 0; k < 2; ++k) dst[m][k] = *(const PG8_LAS bf16x8*)(lds + PG8_SA(b, h) + aoff + m * 2048 + k * 1024); } while (0)
#define PG8_LDB(dst, b, h) do { _Pragma("unroll") for (int n = 0; n < 2; ++n) _Pragma("unroll") for (int k = 0; k < 2; ++k) dst[n][k] = *(const PG8_LAS bf16x8*)(lds + PG8_SB(b, h) + boff + n * 2048 + k * 1024); } while (0)
#define PG8_MMA(ai, bj, At, Bt) do { __builtin_amdgcn_s_setprio(1); _Pragma("unroll") for (int m = 0; m < 4; ++m) _Pragma("unroll") for (int n = 0; n < 2; ++n) _Pragma("unroll") for (int k = 0; k < 2; ++k) \
        acc[ai][bj][m][n] = __builtin_amdgcn_mfma_f32_16x16x32_bf16(Bt[n][k], At[m][k], acc[ai][bj][m][n], 0, 0, 0); __builtin_amdgcn_s_setprio(0); } while (0)
#define PG8_WAIT_V(n) asm volatile("s_waitcnt vmcnt(" #n ")" ::: "memory")
#define PG8_WAIT_L(n) asm volatile("s_waitcnt lgkmcnt(" #n ")" ::: "memory")
#define PG8_BAR __builtin_amdgcn_s_barrier()
#define PG8_SCHED __builtin_amdgcn_sched_barrier(0)
    Unit cur, nxt; int ui = 0;
    if (!S.next(0, cur)) return;
    f32x4 acc[2][2][4][2];
#pragma unroll
    for (int a = 0; a < 2; ++a)
#pragma unroll
        for (int b = 0; b < 2; ++b)
#pragma unroll
            for (int m = 0; m < 4; ++m)
#pragma unroll
                for (int n = 0; n < 2; ++n) acc[a][b][m][n] = (f32x4){0.f, 0.f, 0.f, 0.f};
    bf16x8 At[4][2], B0[2][2], B1[2][2];
    const char* cA = (const char*)g.A + (size_t)cur.pm * tstep + cur.koff; const char* cB = (const char*)g.Bt + (size_t)cur.pn * tstep + cur.koff;
    S.a_ready(cur);
    if constexpr (SP2) {
        PG8_STAGE(PG8_SB(0, 0), cB, voffB); PG8_STAGE(PG8_SB(0, 1), cB + hstep, voffB); PG8_STAGE(PG8_SA(0, 0), cA, voffA); PG8_STAGE(PG8_SA(0, 1), cA + hstep, voffA);
        if (wr == 1) PG8_BAR;
        PG8_WAIT_V(2); PG8_BAR;
        PG8_STAGE(PG8_SB(1, 0), cB + kstep, voffB); PG8_STAGE(PG8_SA(1, 0), cA + kstep, voffA); PG8_STAGE(PG8_SB(1, 1), cB + hstep + kstep, voffB);
        PG8_WAIT_V(6); PG8_BAR;
    } else {
        PG8_STAGE(PG8_SB(0, 0), cB, voffB); PG8_STAGE(PG8_SA(0, 0), cA, voffA); PG8_STAGE(PG8_SB(0, 1), cB + hstep, voffB); PG8_STAGE(PG8_SA(0, 1), cA + hstep, voffA);
        if (wr == 1) PG8_BAR;
        PG8_WAIT_V(4); PG8_BAR;
        PG8_STAGE(PG8_SB(1, 0), cB + kstep, voffB); PG8_STAGE(PG8_SA(1, 0), cA + kstep, voffA); PG8_STAGE(PG8_SB(1, 1), cB + hstep + kstep, voffB);
        PG8_WAIT_V(6); PG8_BAR;
    }
    for (;;) {
        const bool has_next = S.next(ui + 1, nxt);
        const char* nA = has_next ? (const char*)g.A + (size_t)nxt.pm * tstep + nxt.koff : cA; const char* nB = has_next ? (const char*)g.Bt + (size_t)nxt.pn * tstep + nxt.koff : cB;
        for (int t = 0; t < cur.nt; t += 2) {
            const bool last = (t == cur.nt - 2);
            const char* a1 = cA + (size_t)(t + 1) * kstep;
            const char* a2 = last ? nA : cA + (size_t)(t + 2) * kstep; const char* b2 = last ? nB : cB + (size_t)(t + 2) * kstep;
            const char* a3 = a2 + kstep; const char* b3 = b2 + kstep;
            if (last && has_next) S.a_ready(nxt);
            if constexpr (SP2) {
            PG8_LDB(B0, 0, 0); PG8_LDB(B1, 0, 1); PG8_SCHED; PG8_LDA(At, 0, 0); PG8_STAGE(PG8_SA(1, 1), a1 + hstep, voffA);
            PG8_WAIT_V(8); PG8_WAIT_L(0); PG8_BAR; PG8_MMA(0, 0, At, B0); PG8_MMA(0, 1, At, B1); PG8_BAR; PG8_SCHED;
            PG8_LDA(At, 0, 1); PG8_STAGE(PG8_SB(0, 0), b2, voffB); PG8_STAGE(PG8_SB(0, 1), b2 + hstep, voffB); PG8_STAGE(PG8_SA(0, 0), a2, voffA);
            PG8_WAIT_V(8); PG8_WAIT_L(0); PG8_BAR; PG8_MMA(1, 0, At, B0); PG8_MMA(1, 1, At, B1); PG8_BAR; PG8_SCHED;
            PG8_LDB(B0, 1, 0); PG8_LDB(B1, 1, 1); PG8_SCHED; PG8_LDA(At, 1, 0); PG8_STAGE(PG8_SA(0, 1), a2 + hstep, voffA);
            PG8_WAIT_V(8); PG8_WAIT_L(0); PG8_BAR; PG8_MMA(0, 0, At, B0); PG8_MMA(0, 1, At, B1); PG8_BAR; PG8_SCHED;
            PG8_LDA(At, 1, 1); PG8_STAGE(PG8_SB(1, 0), b3, voffB); PG8_STAGE(PG8_SB(1, 1), b3 + hstep, voffB); PG8_STAGE(PG8_SA(1, 0), a3, voffA);
            PG8_WAIT_V(8); PG8_WAIT_L(0); PG8_BAR; PG8_MMA(1, 0, At, B0); PG8_MMA(1, 1, At, B1); PG8_BAR; PG8_SCHED;
            } else {
            PG8_LDB(B0, 0, 0); PG8_SCHED; PG8_LDA(At, 0, 0); PG8_STAGE(PG8_SA(1, 1), a1 + hstep, voffA);
            PG8_WAIT_L(8); PG8_BAR; PG8_WAIT_L(0); PG8_MMA(0, 0, At, B0); PG8_BAR; PG8_SCHED;
            PG8_LDB(B1, 0, 1); PG8_STAGE(PG8_SB(0, 0), b2, voffB);
            PG8_BAR; PG8_WAIT_L(0); PG8_MMA(0, 1, At, B1); PG8_BAR;
            PG8_LDA(At, 0, 1); PG8_STAGE(PG8_SA(0, 0), a2, voffA);
            PG8_BAR; PG8_WAIT_L(0); PG8_MMA(1, 0, At, B0); PG8_BAR; PG8_SCHED;
            PG8_STAGE(PG8_SB(0, 1), b2 + hstep, voffB);
            PG8_WAIT_V(6); PG8_BAR; PG8_MMA(1, 1, At, B1); PG8_BAR;
            PG8_LDB(B0, 1, 0); PG8_SCHED; PG8_LDA(At, 1, 0); PG8_STAGE(PG8_SA(0, 1), a2 + hstep, voffA);
            PG8_WAIT_L(8); PG8_BAR; PG8_WAIT_L(0); PG8_MMA(0, 0, At, B0); PG8_BAR; PG8_SCHED;
            PG8_LDB(B1, 1, 1); PG8_STAGE(PG8_SB(1, 0), b3, voffB);
            PG8_BAR; PG8_WAIT_L(0); PG8_MMA(0, 1, At, B1); PG8_BAR;
            PG8_LDA(At, 1, 1); PG8_STAGE(PG8_SA(1, 0), a3, voffA);
            PG8_BAR; PG8_WAIT_L(0); PG8_MMA(1, 0, At, B0); PG8_BAR; PG8_SCHED;
            PG8_STAGE(PG8_SB(1, 1), b3 + hstep, voffB);
            PG8_WAIT_V(6); PG8_BAR; PG8_MMA(1, 1, At, B1); PG8_BAR;
            }
        }
        if constexpr (ALIGN_EPI) { if (wr == 0) PG8_BAR; }
        if constexpr (!Epi::AFTER_DRAIN) { E(acc, cur, wr, wc, fr, fq); S.done(cur); }
        if (!has_next) break;
#pragma unroll
        for (int a = 0; a < 2; ++a)
#pragma unroll
            for (int b = 0; b < 2; ++b)
#pragma unroll
                for (int m = 0; m < 4; ++m)
#pragma unroll
                    for (int n = 0; n < 2; ++n) acc[a][b][m][n] = (f32x4){0.f, 0.f, 0.f, 0.f};
        cur = nxt; cA = nA; cB = nB; ++ui;
        if constexpr (ALIGN_EPI) { if (wr == 1) PG8_BAR; }
    }
    PG8_WAIT_V(0);
    if constexpr (!ALIGN_EPI) { if (wr == 0) PG8_BAR; }
    PG8_BAR;
    if constexpr (Epi::AFTER_DRAIN) { E.fused(acc, cur, wr, wc, fr, fq, lds, wid, lane); S.done(cur); }
#undef PG8_SA
#undef PG8_SB
#undef PG8_STAGE
#undef PG8_LDA
#undef PG8_LDB
#undef PG8_MMA
#undef PG8_WAIT_V
#undef PG8_WAIT_L
#undef PG8_BAR
#undef PG8_SCHED
}
}

constexpr int NWAVES = 8;
constexpr int DM = 2048, DFF = 5632, NBATCH = 8, SEQ = 2048, NMETA = 16, TP = SEQ + NMETA;
constexpr int DECB = 128, DECS = 4, MPR = NBATCH * TP  , MSM = DECB * DECS  , MREAL = MPR + MSM  , MP = 17152  ;
constexpr int AH = 4, ADK = 256, ADV = 512, NAIN = 6144, NAIN_PAD = 6400;
constexpr int BH = 32, BDH = 64, BKV = 4, WIN = 128;
constexpr float EPS = 1e-6f;

constexpr size_t MiB = 1u << 20;
constexpr size_t WS_CTL = 0, CTL_ZERO_BYTES = 1 * MiB;
constexpr size_t SZ_W1 = (size_t)2 * DFF * DM * 2, SZ_W2 = (size_t)DM * DFF * 2;
constexpr size_t WS_W1 = 1 * MiB;
constexpr size_t WS_W2 = WS_W1 + 4 * SZ_W1;
constexpr size_t WS_WAIN = WS_W2 + 4 * SZ_W2;
constexpr size_t WS_WAOUT = WS_WAIN + (size_t)NAIN_PAD * DM * 2;
constexpr size_t WS_WKV = WS_WAOUT + (size_t)DM * DM * 2;
constexpr size_t WS_WQ = WS_WKV + (size_t)512 * DM * 2;
constexpr size_t WS_WBO = WS_WQ + (size_t)DM * DM * 2;
constexpr size_t WS_H = WS_WBO + (size_t)DM * DM * 2;
constexpr size_t WS_AB = WS_H + (size_t)MP * DM * 4;
constexpr size_t WS_ACT = WS_AB + (size_t)MP * DM * 2;
constexpr size_t WS_QKVO = WS_ACT + (size_t)MP * DFF * 2;
constexpr size_t WS_HM = WS_QKVO + (size_t)MP * NAIN * 2;
constexpr size_t WS_AM = WS_HM + (size_t)MP * DM * 4;
constexpr size_t WS_QB = WS_HM;
constexpr size_t WS_KB = WS_AM + (size_t)MP * DM * 2;
constexpr size_t WS_VB = WS_KB + (size_t)MP * 256 * 2;
constexpr size_t WS_SSQ = WS_VB + (size_t)MP * 256 * 2;
constexpr size_t WS_HSSQ = WS_SSQ + (size_t)MP * 32 * 4;
constexpr size_t WS_GATES = WS_HSSQ + (size_t)MP * 32 * 4;
constexpr size_t WS_PF = WS_GATES + (size_t)MP * 8 * 4;
constexpr size_t WS_GA = WS_PF + (size_t)32 * 17 * 8 * 4 * 1024;
constexpr size_t WS_SLAB = WS_GA + (size_t)32 * 17 * 512 * 4;
constexpr size_t WS_AB2 = WS_SLAB + (size_t)24 * 4 * 65536 * 4;
constexpr size_t WS_SSQ2 = WS_AB2 + (size_t)MP * DM * 2;
constexpr size_t WS_RS = WS_SSQ2 + (size_t)MP * 32 * 4;
constexpr size_t WS_RS2 = WS_RS + (size_t)MP * 4;
constexpr size_t WS_END = WS_RS2 + (size_t)MP * 4;
constexpr int CW_BAR = 4096;
constexpr int CW_SQ = 7680;

constexpr size_t O_YP = 0, O_YS = O_YP + (size_t)NBATCH * SEQ * DM, O_CP = O_YS + (size_t)MSM * DM, O_NP = O_CP + (size_t)NBATCH * AH * ADK * ADV,
                 O_MP = O_NP + NBATCH * AH * ADK, O_KMP = O_MP + NBATCH * AH, O_VMP = O_KMP + NBATCH * NMETA * 256, O_KWP = O_VMP + NBATCH * NMETA * 256,
                 O_VWP = O_KWP + NBATCH * WIN * 256, O_CS = O_VWP + NBATCH * WIN * 256, O_NS = O_CS + (size_t)DECB * AH * ADK * ADV, O_MS = O_NS + DECB * AH * ADK,
                 O_KWS = O_MS + DECB * AH, O_VWS = O_KWS + (size_t)DECB * WIN * 256, O_END = O_VWS + (size_t)DECB * WIN * 256;

constexpr int SCR_BYTES = 143360;
constexpr int MISC_OFF = SCR_BYTES;
constexpr int LDS_BYTES = 147456;

#define GAS __attribute__((address_space(1)))
#define LAS __attribute__((address_space(3)))
typedef unsigned short bf16;
typedef unsigned v4u __attribute__((ext_vector_type(4)));
typedef unsigned v2u __attribute__((ext_vector_type(2)));
typedef float f32x4 __attribute__((ext_vector_type(4)));
typedef short bf16x8 __attribute__((ext_vector_type(8)));
#define LDS_WAIT() asm volatile("s_waitcnt lgkmcnt(0)" ::: "memory")
#define MFMA16(a, b, c) __builtin_amdgcn_mfma_f32_16x16x32_bf16((a), (b), (c), 0, 0, 0)
typedef __bf16 bf16n2 __attribute__((ext_vector_type(2)));
typedef float f32n2 __attribute__((ext_vector_type(2)));
__device__ __forceinline__ unsigned pk2(float lo, float hi) { const f32n2 v = {lo, hi}; return __builtin_bit_cast(unsigned, __builtin_convertvector(v, bf16n2)); }
__device__ __forceinline__ unsigned pk2m(float lo, float hi) { return pk2(lo, hi); }
__device__ __forceinline__ bf16 bf16_rne(float x) { return (bf16)(pk2(x, 0.f) & 0xffffu); }
__device__ __forceinline__ float bflo(unsigned w) { return __uint_as_float(w << 16); }
__device__ __forceinline__ float bfhi(unsigned w) { return __uint_as_float(w & 0xffff0000u); }
__device__ __forceinline__ unsigned bfel(const v4u& r, int e) { return (r[e >> 1] >> (16 * (e & 1))) & 0xffffu; }
__device__ __forceinline__ float wave_sum(float v) {
#pragma unroll
    for (int o = 1; o < 64; o <<= 1) v += __shfl_xor(v, o);
    return v;
}
#define XB_TMO      128
#define XB_XCNT(j)  (256  + 64 * (j))
#define XB_XSUB(j)  (1280 + 64 * (j))
#define XB_XGEN(j)  (2304 + 64 * (j))
#define XB_TOP      3328
#define XB_TOPGEN   3392
#define XCD_BAR_WORDS 3456
#define XB_SPIN_CAP (1u << 18)

__device__ __forceinline__ unsigned xb_ld(unsigned* p)              { return __hip_atomic_load(p, __ATOMIC_RELAXED, __HIP_MEMORY_SCOPE_AGENT); }
__device__ __forceinline__ unsigned xb_add(unsigned* p, unsigned v) { return __hip_atomic_fetch_add(p, v, __ATOMIC_RELAXED, __HIP_MEMORY_SCOPE_AGENT); }
__device__ __forceinline__ unsigned xb_xcc_id() { return (unsigned)__builtin_amdgcn_s_getreg((3 << 11) | 20) & 0xFu; }
#define XB_SPIN(cond, bar) do { unsigned _sp = 0; while (cond) { __builtin_amdgcn_s_sleep(1); \
    if ((++_sp & 255u) == 0u) { if (xb_ld(&(bar)[XB_TMO])) break; if (_sp > XB_SPIN_CAP) { atomicAdd(&(bar)[XB_TMO], 1u); break; } } } } while (0)

struct XcdBarrier {
    unsigned* bar; unsigned x;
    volatile LAS unsigned* st;
};

__device__ __forceinline__ XcdBarrier xcd_barrier_post(unsigned* bar, volatile LAS unsigned* st) {
    XcdBarrier b; b.bar = bar; b.x = xb_xcc_id(); b.st = st;
    if (threadIdx.x == 0) (void)xb_add(&bar[XB_XCNT(b.x)], 1u);
    return b;
}
__device__ __forceinline__ void xcd_barrier_complete(unsigned* bar, unsigned x, unsigned& nloc, unsigned& nx) {
    const unsigned G = gridDim.x * gridDim.y * gridDim.z;
    unsigned sum, cnt, mine, sp = 0u;
    for (;;) {
        sum = 0u; cnt = 0u; mine = 0u;
#pragma unroll
        for (unsigned j = 0; j < 16; ++j) { const unsigned c = xb_ld(&bar[XB_XCNT(j)]); sum += c; cnt += (c > 0u) ? 1u : 0u; mine = (j == x) ? c : mine; }
        if (sum == G) break;
        __builtin_amdgcn_s_sleep(1);
        if ((++sp & 255u) == 0u) { if (xb_ld(&bar[XB_TMO])) break; if (sp > XB_SPIN_CAP) { atomicAdd(&bar[XB_TMO], 1u); break; } }
    }
    nloc = mine > 0u ? mine : 1u; nx = cnt > 0u ? cnt : 1u;
}

__device__ __forceinline__ void xcd_barrier(const XcdBarrier& b) {
    asm volatile("s_waitcnt vmcnt(0)" ::: "memory");
    __syncthreads();
    if (threadIdx.x == 0) {
        unsigned* bar = b.bar;
        __builtin_amdgcn_s_waitcnt(0);
        unsigned nloc = b.st[0], nx = b.st[1];
        if (nloc == 0u) { xcd_barrier_complete(bar, b.x, nloc, nx); b.st[0] = nloc; b.st[1] = nx; }
        const unsigned old = xb_add(&bar[XB_XSUB(b.x)], 1u);
        const unsigned gen = old / nloc;
        if (old + 1u == (gen + 1u) * nloc) {
            __builtin_amdgcn_fence(__ATOMIC_RELEASE, "agent");
            asm volatile("s_waitcnt vmcnt(0)" ::: "memory");
            const unsigned og = xb_add(&bar[XB_TOP], 1u);
            const unsigned tg = og / nx;
            if (og + 1u == (tg + 1u) * nx) xb_add(&bar[XB_TOPGEN], 1u);
            else XB_SPIN(xb_ld(&bar[XB_TOPGEN]) == tg, bar);
            __builtin_amdgcn_fence(__ATOMIC_ACQUIRE, "agent");
            xb_add(&bar[XB_XGEN(b.x)], 1u);
            asm volatile("s_waitcnt vmcnt(0)" ::: "memory");
        } else {
            XB_SPIN(xb_ld(&bar[XB_XGEN(b.x)]) == gen, bar);
            __builtin_amdgcn_fence(__ATOMIC_ACQUIRE, "agent");
            asm volatile("s_waitcnt vmcnt(0)" ::: "memory");
        }
    }
    __syncthreads();
}

constexpr int CW_TMO = 0;
constexpr int CW_Q = 8192;
constexpr int CW_CNT = 16384, CNT_STRIDE = 80;
static_assert((CW_CNT + 13 * CNT_STRIDE * 64) * 4 <= (int)CTL_ZERO_BYTES && CW_Q + 13 * 8 * 64 <= CW_CNT, "CTL map");
#define FLOW_NONE 0xffffffffu
struct FlowOrder {
    int nM, nN, nwg, x; unsigned* q; const unsigned* dep; unsigned need; unsigned* pub; unsigned* tmo; volatile LAS unsigned* slot;
    static constexpr int MID_T = 4;
    int pend_pm; unsigned pend_t; int pend_kind;
    __device__ __forceinline__ void init(int N, unsigned xcc, unsigned* ctl, int phase, int dep_bank, unsigned need_, int pub_bank, volatile LAS unsigned* slot_) {
        nM = MP / 256; nN = N / 256; nwg = nM * nN; x = (int)(xcc & 7u); q = ctl + CW_Q + phase * 8 * 64;
        dep = dep_bank >= 0 ? ctl + CW_CNT + dep_bank * CNT_STRIDE * 64 : nullptr; need = need_;
        pub = pub_bank >= 0 ? ctl + CW_CNT + pub_bank * CNT_STRIDE * 64 : nullptr; tmo = ctl + CW_TMO; slot = slot_; pend_pm = -1; pend_t = 0u; pend_kind = 0; }
    __device__ __forceinline__ int lstart(int xx) const { const int q_ = nwg / 8, r = nwg % 8; return xx < r ? xx * (q_ + 1) : r * (q_ + 1) + (xx - r) * q_; }
    __device__ __forceinline__ unsigned lcount(int xx) const { return (unsigned)(nwg / 8 + (xx < nwg % 8 ? 1 : 0)); }
    static constexpr int WG = 2;
    __device__ __forceinline__ void decode(unsigned wgid, pg8::Unit& u) const { const int w = (int)wgid, nig = WG * nN, gid = w / nig, fm = gid * WG, gsz = (nM - fm) < WG ? (nM - fm) : WG;
        u.pm = fm + ((w % nig) % gsz); u.pn = (w % nig) / gsz; }
    __device__ __forceinline__ unsigned take(int xx) const { unsigned t = 0; if ((threadIdx.x & 63) == 0) t = __hip_atomic_fetch_add(q + 64 * xx, 1u, __ATOMIC_RELAXED, __HIP_MEMORY_SCOPE_AGENT);
        t = (unsigned)__builtin_amdgcn_readfirstlane((int)t); return t < lcount(xx) ? (unsigned)lstart(xx) + t : FLOW_NONE; }
    __device__ __forceinline__ unsigned steal() const {
        for (int k = 1; k < 8; ++k) { const int xx = (x + k) & 7;
            const unsigned h = (unsigned)__builtin_amdgcn_readfirstlane((int)__hip_atomic_load(q + 64 * xx, __ATOMIC_RELAXED, __HIP_MEMORY_SCOPE_AGENT)); if (h >= lcount(xx)) continue;
            const unsigned id = take(xx); if (id != FLOW_NONE) return id; }
        return FLOW_NONE; }
    __device__ __forceinline__ unsigned claim_blocking() const {
        if (__builtin_amdgcn_readfirstlane((int)slot[3]) == 0) { const unsigned id = take(x); if (id != FLOW_NONE) return id; if ((threadIdx.x & 63) == 0) slot[3] = 1u; }
        return steal(); }
    __device__ __forceinline__ void begin() const {
        if (threadIdx.x < 64) {
            if (threadIdx.x == 0) { slot[3] = 0u; slot[5] = 0u; }
            const unsigned u0 = claim_blocking(); const unsigned u1 = u0 != FLOW_NONE ? claim_blocking() : FLOW_NONE;
            if (threadIdx.x == 0) { slot[0] = u0; slot[1] = u1; slot[4] = 2u; if (u1 == FLOW_NONE) slot[5] = 1u; } }
        asm volatile("s_waitcnt lgkmcnt(0)" ::: "memory"); __builtin_amdgcn_s_barrier(); asm volatile("" ::: "memory"); }
    __device__ __forceinline__ bool peek(int i, pg8::Unit& u) const { const unsigned id = (unsigned)__builtin_amdgcn_readfirstlane((int)slot[i % 3]); if (id == FLOW_NONE) return false; decode(id, u); return true; }
    __device__ __forceinline__ void a_ready(const pg8::Unit& u, int prev_pm) const {
        if (dep == nullptr || u.pm == prev_pm) return;
        if (threadIdx.x < 64) {
            const unsigned long long t0 = __builtin_amdgcn_s_memrealtime(); unsigned polls = 0;
            while ((unsigned)__builtin_amdgcn_readfirstlane((int)__hip_atomic_load(dep + 64 * u.pm, __ATOMIC_RELAXED, __HIP_MEMORY_SCOPE_AGENT)) < need) {
                if ((++polls & 255u) == 0u && __builtin_amdgcn_readfirstlane((int)__hip_atomic_load(tmo, __ATOMIC_RELAXED, __HIP_MEMORY_SCOPE_AGENT)) != 0) break;
                if (__builtin_amdgcn_s_memrealtime() - t0 > 2000000ull) {
                    if (threadIdx.x == 0) { unsigned expect = 0u; __hip_atomic_compare_exchange_strong(tmo + 1, &expect, 0x600u | (unsigned)(u.pm & 0xff), __ATOMIC_RELAXED, __ATOMIC_RELAXED, __HIP_MEMORY_SCOPE_AGENT); __hip_atomic_store(tmo, 1u, __ATOMIC_RELAXED, __HIP_MEMORY_SCOPE_AGENT); }
                    break; }
                __builtin_amdgcn_s_sleep(2); }
            __builtin_amdgcn_fence(__ATOMIC_ACQUIRE, "agent");
            asm volatile("s_waitcnt vmcnt(0)" ::: "memory");
        }
        asm volatile("" ::: "memory"); __builtin_amdgcn_s_barrier(); asm volatile("" ::: "memory"); }
    __device__ __forceinline__ void done(const pg8::Unit& u) {
        if (pub) pend_pm = u.pm;
        if (threadIdx.x < 64) {
            const bool all_empty = __builtin_amdgcn_readfirstlane((int)slot[5]) != 0, own_empty = __builtin_amdgcn_readfirstlane((int)slot[3]) != 0;
            pend_kind = all_empty ? 0 : (own_empty ? 2 : 1);
            if (pend_kind == 1 && threadIdx.x == 0) pend_t = __hip_atomic_fetch_add(q + 64 * x, 1u, __ATOMIC_RELAXED, __HIP_MEMORY_SCOPE_AGENT); } }
    __device__ __forceinline__ void mid() {
        if (pend_pm < 0 && pend_kind == 0) return;
        asm volatile("s_waitcnt vmcnt(0)" ::: "memory");
        if (pend_pm >= 0) { if ((threadIdx.x & 63) == 0) __hip_atomic_fetch_add(pub + 64 * pend_pm, 1u, __ATOMIC_RELAXED, __HIP_MEMORY_SCOPE_AGENT); pend_pm = -1; }
        if (threadIdx.x < 64 && pend_kind != 0) {
            unsigned id = FLOW_NONE;
            if (pend_kind == 1) { const unsigned t = (unsigned)__builtin_amdgcn_readfirstlane((int)pend_t); if (t < lcount(x)) id = (unsigned)lstart(x) + t; else { if (threadIdx.x == 0) slot[3] = 1u; id = steal(); } }
            else id = steal();
            if (id == FLOW_NONE && threadIdx.x == 0) slot[5] = 1u;
            const unsigned ci = (unsigned)__builtin_amdgcn_readfirstlane((int)slot[4]);
            if (threadIdx.x == 0) { slot[ci % 3u] = id; slot[4] = ci + 1u; }
            pend_kind = 0; } }
    __device__ __forceinline__ void flush() {
        if (pend_pm >= 0) { if ((threadIdx.x & 63) == 0) __hip_atomic_fetch_add(pub + 64 * pend_pm, 1u, __ATOMIC_RELAXED, __HIP_MEMORY_SCOPE_AGENT); pend_pm = -1; } }
};
template <bool WT> __device__ __forceinline__ void st_b128(void* p, const v4u& v) { if constexpr (WT) asm volatile("global_store_dwordx4 %0, %1, off sc1" :: "v"(p), "v"(v) : "memory"); else *(v4u*)p = v; }
template <bool WT> __device__ __forceinline__ void st_b32(void* p, float v) { if constexpr (WT) asm volatile("global_store_dword %0, %1, off sc1" :: "v"(p), "v"(v) : "memory"); else *(float*)p = v; }

__device__ __forceinline__ void row_rscale8(const float* rs, int row0, float (&r8)[8]) {
#pragma unroll
    for (int ai = 0; ai < 2; ++ai)
#pragma unroll
        for (int m = 0; m < 4; ++m) r8[ai * 4 + m] = rs[row0 + ai * 128 + m * 16];
}
__device__ __forceinline__ float silu_f(float g) { return g * __builtin_amdgcn_rcpf(1.0f + __expf(-g)); }

typedef float f32x2 __attribute__((ext_vector_type(2)));
template <bool WT> struct EpiSwiglu {
    static constexpr bool PERM = true, AFTER_DRAIN = false;
    bf16* O; const float* rs;
    __device__ __forceinline__ void operator()(const f32x4 (&acc)[2][2][4][2], const pg8::Unit& u, int wr, int wc, int fr, int fq) const {
        const int row0 = u.pm * 256 + wr * 64 + fr, col0 = u.pn * 128 + wc * 32 + 8 * fq;
        float r8[8]; row_rscale8(rs, row0, r8);
#pragma unroll
        for (int ai = 0; ai < 2; ++ai)
#pragma unroll
            for (int m = 0; m < 4; ++m) {
                const int row = row0 + ai * 128 + m * 16;
                const float r1 = r8[ai * 4 + m] * 1.4426950408889634f, r2 = r8[ai * 4 + m] * 0.6931471805599453f;
                f32x2 o[4];
#pragma unroll
                for (int n = 0; n < 2; ++n)
#pragma unroll
                    for (int jp = 0; jp < 2; ++jp) {
                        const f32x2 g2 = (f32x2){acc[ai][0][m][n][2 * jp], acc[ai][0][m][n][2 * jp + 1]}, u2 = (f32x2){acc[ai][1][m][n][2 * jp], acc[ai][1][m][n][2 * jp + 1]};
                        const f32x2 t2 = g2 * r1;
                        f32x2 d2 = (f32x2){__builtin_amdgcn_exp2f(-t2.x), __builtin_amdgcn_exp2f(-t2.y)} + 1.0f;
                        const f32x2 s2 = (f32x2){__builtin_amdgcn_rcpf(d2.x), __builtin_amdgcn_rcpf(d2.y)};
                        o[2 * n + jp] = (t2 * s2) * (u2 * r2);
                    }
                v4u w; w.x = pk2(o[0].x, o[0].y); w.y = pk2(o[1].x, o[1].y); w.z = pk2(o[2].x, o[2].y); w.w = pk2(o[3].x, o[3].y);
                st_b128<WT>(O + (size_t)row * DFF + col0, w);
            }
    }
};
constexpr int TS_PM0 = 64, TS_PARTS = 4, TS_TILES = 24;
static_assert((DFF / TS_PARTS) % 128 == 0 && (DM / TS_PARTS) % 128 == 0, "split-K part depth");
typedef float f32x8 __attribute__((ext_vector_type(8)));
template <bool FINAL, bool WT> struct EpiResid {
    static constexpr bool PERM = true, AFTER_DRAIN = false;
    const bf16* HI; bf16* AB; float* ssq; float* out; float* slab; float sc; int nt_full;
    __device__ __forceinline__ void operator()(const f32x4 (&acc)[2][2][4][2], const pg8::Unit& u, int wr, int wc, int fr, int fq) const {
        const int row0 = u.pm * 256 + wr * 64 + fr, col0 = u.pn * 256 + wc * 32 + 8 * fq;
        if (u.nt != nt_full) {
            float* sp = slab + (size_t)((((u.pm - TS_PM0) * 8 + u.pn) * TS_PARTS) + u.koff / (u.nt * 128)) * 65536 + (size_t)(wr * 64 + fr) * 256 + wc * 32 + 8 * fq;
#pragma unroll
            for (int ai = 0; ai < 2; ++ai)
#pragma unroll
                for (int m = 0; m < 4; ++m)
#pragma unroll
                    for (int bj = 0; bj < 2; ++bj) { float* q = sp + (ai * 128 + m * 16) * 256 + bj * 128; *(f32x4*)q = acc[ai][bj][m][0]; *(f32x4*)(q + 4) = acc[ai][bj][m][1]; }
            return; }
        f32x8 ssv = (f32x8){0.f, 0.f, 0.f, 0.f, 0.f, 0.f, 0.f, 0.f};
#pragma unroll
        for (int ai = 0; ai < 2; ++ai) {
            v4u hbv[4][2];
#pragma unroll
            for (int m = 0; m < 4; ++m)
#pragma unroll
                for (int bj = 0; bj < 2; ++bj) hbv[m][bj] = *(const v4u*)(HI + (size_t)(row0 + ai * 128 + m * 16) * DM + col0 + bj * 128);
#pragma unroll
            for (int m = 0; m < 4; ++m) {
                const int row = row0 + ai * 128 + m * 16;
                float ss = 0.f;
                float* op = nullptr;
                if (FINAL) {
                    if (row < MPR) { const int b = row / TP, t = row - b * TP; if (t >= NMETA) op = out + O_YP + ((size_t)b * SEQ + (t - NMETA)) * DM + col0; }
                    else if (row < MREAL) op = out + O_YS + (size_t)(row - MPR) * DM + col0;
                }
#pragma unroll
                for (int bj = 0; bj < 2; ++bj) {
                    const v4u hb = hbv[m][bj];
                    const f32x4 h0 = (f32x4){bflo(hb.x), bfhi(hb.x), bflo(hb.y), bfhi(hb.y)}, h1 = (f32x4){bflo(hb.z), bfhi(hb.z), bflo(hb.w), bfhi(hb.w)};
                    const f32x4 n0 = h0 + acc[ai][bj][m][0] * sc, n1 = h1 + acc[ai][bj][m][1] * sc;
                    if (FINAL) { if (op) { *(f32x4*)(op + bj * 128) = n0; *(f32x4*)(op + bj * 128 + 4) = n1; } }
                    else {
                        v4u w; w.x = pk2(n0[0], n0[1]); w.y = pk2(n0[2], n0[3]); w.z = pk2(n1[0], n1[1]); w.w = pk2(n1[2], n1[3]);
                        st_b128<WT>(AB + (size_t)row * DM + col0 + bj * 128, w);
                        ss += (n0[0] * n0[0] + n0[1] * n0[1]) + (n0[2] * n0[2] + n0[3] * n0[3]) + (n1[0] * n1[0] + n1[1] * n1[1]) + (n1[2] * n1[2] + n1[3] * n1[3]);
                    }
                }
                ssv[ai * 4 + m] = ss;
            }
        }
        if (!FINAL) {
#pragma unroll
            for (int i = 0; i < 8; ++i) ssv[i] += __shfl_xor(ssv[i], 16);
#pragma unroll
            for (int i = 0; i < 8; ++i) ssv[i] += __shfl_xor(ssv[i], 32);
            if (fq == 0) {
#pragma unroll
                for (int i = 0; i < 8; ++i) st_b32<WT>(ssq + (size_t)(row0 + (i >> 2) * 128 + (i & 3) * 16) * 32 + u.pn * 4 + wc, ssv[i]); }
        }
    }
};
struct EpiQkvo {
    static constexpr bool PERM = true, AFTER_DRAIN = false;
    bf16* O; const float* rs; float* gates; const float* bias;
    __device__ __forceinline__ void operator()(const f32x4 (&acc)[2][2][4][2], const pg8::Unit& u, int wr, int wc, int fr, int fq) const {
        const int row0 = u.pm * 256 + wr * 64 + fr, col0 = u.pn * 256 + wc * 32 + 8 * fq;
        const bool gate_tile = (u.pn == NAIN / 256);
        float r8[8]; row_rscale8(rs, row0, r8);
#pragma unroll
        for (int i = 0; i < 8; ++i) asm volatile("" : "+v"(r8[i]));
#pragma unroll
        for (int ai = 0; ai < 2; ++ai)
#pragma unroll
            for (int m = 0; m < 4; ++m) {
                const int row = row0 + ai * 128 + m * 16;
                const float r = r8[ai * 4 + m];
                if (!gate_tile) {
#pragma unroll
                    for (int bj = 0; bj < 2; ++bj) { const f32x4 v0 = acc[ai][bj][m][0] * r, v1 = acc[ai][bj][m][1] * r;
                        v4u w; w.x = pk2(v0[0], v0[1]); w.y = pk2(v0[2], v0[3]); w.z = pk2(v1[0], v1[1]); w.w = pk2(v1[2], v1[3]);
                        *(v4u*)(O + (size_t)row * NAIN + col0 + bj * 128) = w; }
                } else if (wc == 0 && fq == 0) {
                    const f32x4 bi = *(const f32x4*)bias, bf = *(const f32x4*)(bias + 4);
                    const f32x4 xi = acc[ai][0][m][0] * r + bi, xf = acc[ai][0][m][1] * r + bf;
                    f32x4 gi, gf;
#pragma unroll
                    for (int j = 0; j < 4; ++j) { gi[j] = 15.0f * tanhf(xi[j] * (1.0f / 15.0f)); const float c = 15.0f * tanhf(xf[j] * (1.0f / 15.0f));
                        gf[j] = fminf(c, 0.f) - log1pf(expf(-fabsf(c))); }
                    *(f32x4*)(gates + (size_t)row * 8) = gi; *(f32x4*)(gates + (size_t)row * 8 + 4) = gf;
                }
            }
    }
};
struct EpiHead {
    static constexpr bool PERM = true, AFTER_DRAIN = false;
    bf16* O0; int ld0; bf16* O1; int ld1; int norm_tiles; const float* rs; const float* gain; float post; float* slab; int nt_full;
    __device__ __forceinline__ void operator()(const f32x4 (&acc)[2][2][4][2], const pg8::Unit& u, int wr, int wc, int fr, int fq) const {
        const int row0 = u.pm * 256 + wr * 64 + fr;
        if (u.nt != nt_full) {
            float* sp = slab + (size_t)((((u.pm - TS_PM0) * 8 + u.pn) * TS_PARTS) + u.koff / (u.nt * 128)) * 65536 + (size_t)(wr * 64 + fr) * 256 + wc * 32 + 8 * fq;
#pragma unroll
            for (int ai = 0; ai < 2; ++ai)
#pragma unroll
                for (int m = 0; m < 4; ++m)
#pragma unroll
                    for (int bj = 0; bj < 2; ++bj) { float* q = sp + (ai * 128 + m * 16) * 256 + bj * 128; *(f32x4*)q = acc[ai][bj][m][0]; *(f32x4*)(q + 4) = acc[ai][bj][m][1]; }
            return; }
        const bool normed = u.pn < norm_tiles;
        bf16* base = normed ? O0 + (size_t)u.pn * 256 : O1 + (size_t)(u.pn - norm_tiles) * 256;
        const int ld = normed ? ld0 : ld1;
        float r8[8]; row_rscale8(rs, row0, r8);
        f32x4 gn[2][2];
#pragma unroll
        for (int bj = 0; bj < 2; ++bj)
#pragma unroll
            for (int n = 0; n < 2; ++n) gn[bj][n] = normed ? *(const f32x4*)(gain + 32 * bj + 8 * fq + 4 * n) * post : (f32x4){1.f, 1.f, 1.f, 1.f};
#pragma unroll
        for (int ai = 0; ai < 2; ++ai)
#pragma unroll
            for (int m = 0; m < 4; ++m) {
                const int row = row0 + ai * 128 + m * 16;
                const float r = r8[ai * 4 + m];
                f32x4 x[2][2]; float ms = 0.f;
#pragma unroll
                for (int bj = 0; bj < 2; ++bj)
#pragma unroll
                    for (int n = 0; n < 2; ++n) { x[bj][n] = acc[ai][bj][m][n] * r; const f32x4 q = x[bj][n] * x[bj][n]; ms += (q[0] + q[1]) + (q[2] + q[3]); }
                ms += __shfl_xor(ms, 16); ms += __shfl_xor(ms, 32);
                const float inv = normed ? rsqrtf(ms * (1.0f / 64.0f) + EPS) : 1.0f;
#pragma unroll
                for (int bj = 0; bj < 2; ++bj) { const f32x4 v0 = x[bj][0] * inv * gn[bj][0], v1 = x[bj][1] * inv * gn[bj][1];
                    v4u w; w.x = pk2(v0[0], v0[1]); w.y = pk2(v0[2], v0[3]); w.z = pk2(v1[0], v1[1]); w.w = pk2(v1[2], v1[3]);
                    *(v4u*)(base + (size_t)row * ld + wc * 64 + 32 * bj + 8 * fq) = w; }
            }
    }
};

struct Args { const float* in[25]; float* out; unsigned char* ws; };
enum { I_XP = 0, I_XS, I_SC, I_SN, I_SM, I_CKM, I_CVM, I_CKW, I_CVW, I_META, I_FFNN, I_WFI, I_WFO, I_MIXN, I_WAI, I_BAG, I_AHN, I_WAO, I_KVN, I_WKV, I_KN, I_WQ, I_QN, I_SINK, I_WBO };
struct CvtItem { const float* lp; const float* gain; bf16* dp; int ldw; int valid; float scale; int K; };
constexpr int IT_W1 = (DM / 64) * (2 * DFF / 64), IT_W2 = (DFF / 64) * (DM / 64), IT_AIN = (DM / 64) * (NAIN_PAD / 64), IT_SQ = (DM / 64) * (DM / 64), IT_KV = (DM / 64) * (512 / 64);
constexpr int CVT_NITEMS = 4 * IT_W1 + 4 * IT_W2 + IT_AIN + IT_SQ + IT_KV + IT_SQ + IT_SQ;
__device__ __forceinline__ CvtItem cvt_decode(const Args& a, int it, int lane) {
    unsigned char* ws = a.ws; const int l16 = lane & 15, q = lane >> 4, nl = 4 * l16;
    CvtItem c; c.valid = 1; c.scale = 1.0f; c.gain = nullptr;
    int r = it, kb, n0, col; const float* W; bf16* dst;
    if (r < 4 * IT_W1) { const int f = r / IT_W1; r -= f * IT_W1; const int nblk = 2 * DFF / 64; kb = r / nblk; n0 = 64 * (r % nblk); const int tile = n0 >> 8, within = (n0 & 255) + nl;
        col = within < 128 ? 128 * tile + within : DFF + 128 * tile + (within - 128);
        W = a.in[I_WFI] + (size_t)f * DM * 2 * DFF; c.ldw = 2 * DFF; c.K = DM; c.gain = a.in[I_FFNN] + f * DM; dst = (bf16*)(ws + WS_W1 + f * SZ_W1); }
    else if ((r -= 4 * IT_W1) < 4 * IT_W2) { const int f = r / IT_W2; r -= f * IT_W2; const int nblk = DM / 64; kb = r / nblk; n0 = 64 * (r % nblk); col = n0 + nl;
        W = a.in[I_WFO] + (size_t)f * DFF * DM; c.ldw = DM; c.K = DFF; dst = (bf16*)(ws + WS_W2 + f * SZ_W2); }
    else if ((r -= 4 * IT_W2) < IT_AIN) { const int nblk = NAIN_PAD / 64; kb = r / nblk; n0 = 64 * (r % nblk); col = n0 + nl;
        c.valid = col < NAIN + 8 ? 1 : 0; if (!c.valid) col = 0; c.scale = (n0 >= 1024 && n0 < 2048) ? 0.0625f : 1.0f;
        W = a.in[I_WAI]; c.ldw = NAIN + 8; c.K = DM; c.gain = a.in[I_MIXN]; dst = (bf16*)(ws + WS_WAIN); }
    else if ((r -= IT_AIN) < IT_SQ) { const int nblk = DM / 64; kb = r / nblk; n0 = 64 * (r % nblk); col = n0 + nl; W = a.in[I_WAO]; c.ldw = DM; c.K = DM; dst = (bf16*)(ws + WS_WAOUT); }
    else if ((r -= IT_SQ) < IT_KV) { const int nblk = 512 / 64; kb = r / nblk; n0 = 64 * (r % nblk); const int d = n0 + nl, tile = d >> 8, within = d & 255, bj = within >> 7, wc = (within >> 5) & 3;
        col = 256 * tile + 64 * wc + 32 * bj + (within & 31); W = a.in[I_WKV]; c.ldw = 512; c.K = DM; c.gain = a.in[I_KVN]; dst = (bf16*)(ws + WS_WKV); }
    else if ((r -= IT_KV) < IT_SQ) { const int nblk = DM / 64; kb = r / nblk; n0 = 64 * (r % nblk); const int d = n0 + nl, tile = d >> 8, within = d & 255, bj = within >> 7, wc = (within >> 5) & 3;
        col = 256 * tile + 64 * wc + 32 * bj + (within & 31); W = a.in[I_WQ]; c.ldw = DM; c.K = DM; c.gain = a.in[I_MIXN] + DM; dst = (bf16*)(ws + WS_WQ); }
    else { r -= IT_SQ; const int nblk = DM / 64; kb = r / nblk; n0 = 64 * (r % nblk); col = n0 + nl; W = a.in[I_WBO]; c.ldw = DM; c.K = DM; dst = (bf16*)(ws + WS_WBO); }
    c.lp = W + (size_t)(64 * kb + q) * c.ldw + col;
    if (c.gain) c.gain += 64 * kb;
    c.dp = dst + (size_t)n0 * c.K + 64 * kb;
    return c;
}
__device__ __forceinline__ void cvt_load(const CvtItem& c, f32x4 (&r)[16]) {
#pragma unroll
    for (int i = 0; i < 16; ++i) r[i] = c.valid ? *(const f32x4*)(c.lp + (size_t)(4 * i) * c.ldw) : (f32x4){0.f, 0.f, 0.f, 0.f};
}
__device__ __forceinline__ void cvt_store(const CvtItem& c, const f32x4 (&r)[16], LAS float* scr, int lane) {
    const int l16 = lane & 15, q = lane >> 4;
#pragma unroll
    for (int i = 0; i < 16; ++i) { LAS float* s = scr + (4 * i + q) * 65 + 4 * l16; s[0] = r[i][0]; s[1] = r[i][1]; s[2] = r[i][2]; s[3] = r[i][3]; }
    LDS_WAIT(); asm volatile("" ::: "memory");
    const int ch = lane & 7;
    f32x4 g0 = (f32x4){c.scale, c.scale, c.scale, c.scale}, g1 = g0;
    if (c.gain) { g0 = *(const f32x4*)(c.gain + 8 * ch) * c.scale; g1 = *(const f32x4*)(c.gain + 8 * ch + 4) * c.scale; }
#pragma unroll
    for (int j = 0; j < 8; ++j) { const int n = (lane >> 3) + 8 * j; const LAS float* s = scr + (8 * ch) * 65 + n;
        v4u o; o.x = pk2(s[0 * 65] * g0[0], s[1 * 65] * g0[1]); o.y = pk2(s[2 * 65] * g0[2], s[3 * 65] * g0[3]); o.z = pk2(s[4 * 65] * g1[0], s[5 * 65] * g1[1]); o.w = pk2(s[6 * 65] * g1[2], s[7 * 65] * g1[3]);
        *(v4u*)(c.dp + (size_t)n * c.K + 8 * ch) = o; }
    LDS_WAIT(); asm volatile("" ::: "memory");
}

__device__ __forceinline__ void p0_prologue(const Args& a, LAS unsigned char* lds, int gw, int NGW, int wave, int lane) {
    LAS float* scr = (LAS float*)(lds + wave * 16640);
    unsigned char* ws = a.ws;
    {
        f32x4 r0[16], r1[16]; int it = gw;
        if (it < CVT_NITEMS) {
            CvtItem c0 = cvt_decode(a, it, lane); CvtItem c1 = cvt_decode(a, it, lane); cvt_load(c0, r0);
            for (;;) {
                it += NGW; const bool h1 = it < CVT_NITEMS; if (h1) { c1 = cvt_decode(a, it, lane); cvt_load(c1, r1); }
                cvt_store(c0, r0, scr, lane);
                if (!h1) break;
                it += NGW; const bool h0 = it < CVT_NITEMS; if (h0) { c0 = cvt_decode(a, it, lane); cvt_load(c0, r0); }
                cvt_store(c1, r1, scr, lane);
                if (!h0) break;
            }
        }
    }
    bf16* AB = (bf16*)(ws + WS_AB); float* RS = (float*)(ws + WS_RS);
    for (int rw0 = gw; rw0 < MP; rw0 += 2 * NGW) {
        f32x4 v0[2][4], v1[2][4];
#pragma unroll
        for (int q = 0; q < 2; ++q) { const int row = rw0 + q * NGW; const float* src = nullptr;
            if (row < MPR) { const int b = row / TP, t = row - b * TP; src = t < NMETA ? a.in[I_META] + (size_t)t * DM : a.in[I_XP] + ((size_t)b * SEQ + (t - NMETA)) * DM; }
            else if (row < MREAL) src = a.in[I_XS] + (size_t)(row - MPR) * DM;
#pragma unroll
            for (int j = 0; j < 4; ++j) { v0[q][j] = (f32x4){0.f, 0.f, 0.f, 0.f}; v1[q][j] = v0[q][j];
                if (src) { v0[q][j] = *(const f32x4*)(src + 512 * j + 8 * lane); v1[q][j] = *(const f32x4*)(src + 512 * j + 8 * lane + 4); } } }
#pragma unroll
        for (int q = 0; q < 2; ++q) { const int row = rw0 + q * NGW; if (row < MP) { float ss = 0.f;
#pragma unroll
            for (int j = 0; j < 4; ++j) {
                v4u w; w.x = pk2(v0[q][j][0], v0[q][j][1]); w.y = pk2(v0[q][j][2], v0[q][j][3]); w.z = pk2(v1[q][j][0], v1[q][j][1]); w.w = pk2(v1[q][j][2], v1[q][j][3]);
                *(v4u*)(AB + (size_t)row * DM + 512 * j + 8 * lane) = w;
                ss += (v0[q][j][0] * v0[q][j][0] + v0[q][j][1] * v0[q][j][1]) + (v0[q][j][2] * v0[q][j][2] + v0[q][j][3] * v0[q][j][3]) + (v1[q][j][0] * v1[q][j][0] + v1[q][j][1] * v1[q][j][1]) + (v1[q][j][2] * v1[q][j][2] + v1[q][j][3] * v1[q][j][3]);
            }
            ss = wave_sum(ss);
            if (lane == 0) RS[row] = rsqrtf(ss * (1.0f / DM) + EPS); } }
    }
}

constexpr int ML_KN = 0, ML_KNS = 272, ML_KT = 34816, ML_KTS = 272, ML_VT = 69632, ML_VTS = 272, ML_CTB = ML_VT + 80 * 272  , ML_CTBS = 528, ML_GA = ML_CTB + 80 * 528  ;
static_assert(ML_GA + 2816 <= SCR_BYTES, "mLSTM LDS map");

#define ML_HALF(DH) do { \
    _Pragma("unroll") for (int ks = 0; ks < 4; ++ks) { bf16x8 fa_[8]; \
        _Pragma("unroll") for (int jb = 0; jb < 8; ++jb) fa_[jb] = *(const LAS bf16x8*)(lds + ML_KN + (16 * jb + i16) * ML_KNS + (32 * ks + 8 * g) * 2); \
        _Pragma("unroll") for (int jb = 0; jb < 8; ++jb) as_[jb] = MFMA16(fa_[jb], qf[4 * (DH) + ks], as_[jb]); } \
    _Pragma("unroll") for (int vb = 0; vb < 5; ++vb) accC[DH][vb] = accC[DH][vb] * decay; \
    _Pragma("unroll") for (int ks = 0; ks < 4; ++ks) { bf16x8 fv_[5]; \
        const bf16x8 bfr = *(const LAS bf16x8*)(lds + ML_KT + (16 * wave + i16) * ML_KTS + (32 * ks + 8 * g) * 2); \
        _Pragma("unroll") for (int vb = 0; vb < 5; ++vb) fv_[vb] = *(const LAS bf16x8*)(lds + ML_VT + (16 * vb + i16) * ML_VTS + (32 * ks + 8 * g) * 2); \
        _Pragma("unroll") for (int vb = 0; vb < 5; ++vb) accC[DH][vb] = MFMA16(fv_[vb], bfr, accC[DH][vb]); } \
} while (0)
#define ML_PUT_CTB(DH) do { _Pragma("unroll") for (int vb = 0; vb < 5; ++vb) _Pragma("unroll") for (int r = 0; r < 4; ++r) \
    *(LAS bf16*)(lds + ML_CTB + (16 * vb + 4 * g + r) * ML_CTBS + (128 * (DH) + 16 * wave + i16) * 2) = bf16_rne(accC[DH][vb][r]); } while (0)
#define ML_LOAD_K_ISSUE(DH, R0, R1) do { _Pragma("unroll") for (int it = 0; it < 2; ++it) { const int dc = wave + 8 * it; \
    const bf16* kp = QKVO + (rowbase + 2 * lane) * NAIN + 1024 + h * ADK + 128 * (DH) + 8 * dc; R0[it] = *(const v4u*)kp; R1[it] = *(const v4u*)(kp + NAIN); } } while (0)
#define ML_LOAD_K_PUT(R0, R1) do { const float w0 = ga[512 + 2 * lane], w1 = ga[512 + 2 * lane + 1]; \
    _Pragma("unroll") for (int it = 0; it < 2; ++it) { const int dc = wave + 8 * it; \
    *(LAS v4u*)(lds + ML_KN + (2 * lane) * ML_KNS + 16 * dc) = R0[it]; *(LAS v4u*)(lds + ML_KN + (2 * lane + 1) * ML_KNS + 16 * dc) = R1[it]; \
    _Pragma("unroll") for (int e = 0; e < 8; ++e) *(LAS unsigned*)(lds + ML_KT + (8 * dc + e) * ML_KTS + 4 * lane) = pk2(__uint_as_float(bfel(R0[it], e) << 16) * w0, __uint_as_float(bfel(R1[it], e) << 16) * w1); } } while (0)

__device__ __forceinline__ void mlstm_prompt_unit(LAS unsigned char* lds, const bf16* QKVO, const float* GATES, float* HM, float* HSSQ, float* out, int b, int h, int j, int tid, int wave, int lane) {
    const int i16 = lane & 15, g = lane >> 4;
    LAS float* ga = (LAS float*)(lds + ML_GA);
    f32x4 accC[2][5];
#pragma unroll
    for (int dh = 0; dh < 2; ++dh)
#pragma unroll
        for (int vb = 0; vb < 5; ++vb) accC[dh][vb] = (f32x4){0.f, 0.f, 0.f, 0.f};
    __syncthreads();
    for (int o = tid * 16; o < 80 * ML_CTBS; o += 512 * 16) *(LAS v4u*)(lds + ML_CTB + o) = (v4u){0u, 0u, 0u, 0u};
    for (int o = tid; o < 16 * 64; o += 512) { const int rr = o >> 6, cc = o & 63; *(LAS unsigned*)(lds + ML_VT + (64 + rr) * ML_VTS + cc * 4) = rr == 0 ? 0x3F803F80u : 0u; }
    float m_prev = 0.f;
    for (int c = 0; c < 17; ++c) {
        const int tok0 = c == 0 ? 0 : NMETA + 128 * (c - 1), nvalid = c == 0 ? NMETA : 128;
        const size_t rowbase = (size_t)b * TP + tok0;
        __syncthreads();
        bf16x8 qf[8];
        { const bf16* qp = QKVO + (rowbase + 16 * wave + i16) * NAIN + h * ADK + 8 * g;
#pragma unroll
          for (int ks = 0; ks < 8; ++ks) qf[ks] = *(const bf16x8*)(qp + 32 * ks); }
        if (wave == 0) {
            const int t0 = 2 * lane, t1 = t0 + 1;
            float ig0 = -1e30f, ig1 = -1e30f, lf0 = 0.f, lf1 = 0.f;
            if (t0 < nvalid) { const float* gp = GATES + (rowbase + t0) * 8; ig0 = gp[h]; lf0 = gp[4 + h]; }
            if (t1 < nvalid) { const float* gp = GATES + (rowbase + t1) * 8; ig1 = gp[h]; lf1 = gp[4 + h]; }
            const float c1 = lf0 + lf1; float sc = c1;
#pragma unroll
            for (int o = 1; o < 64; o <<= 1) { const float t = __shfl_up(sc, o); if (lane >= o) sc += t; }
            const float excl = sc - c1, b0 = excl + lf0, b1 = excl + c1;
            const float a0 = ig0 - b0, a1 = ig1 - b1;
            float smx = fmaxf(a0, a1);
#pragma unroll
            for (int o = 1; o < 64; o <<= 1) { const float t = __shfl_up(smx, o); if (lane >= o) smx = fmaxf(smx, t); }
            float exm = __shfl_up(smx, 1); if (lane == 0) exm = -INFINITY;
            const float p0 = fmaxf(exm, a0), p1 = fmaxf(p0, a1);
            const float pm0 = fmaxf(m_prev, p0), pm1 = fmaxf(m_prev, p1);
            const float Mx = fmaxf(m_prev, __shfl(smx, 63)), blast = __shfl(b1, 63);
            ga[t0] = a0; ga[t1] = a1; ga[128 + t0] = pm0; ga[128 + t1] = pm1;
            ga[256 + t0] = __expf(m_prev - pm0); ga[256 + t1] = __expf(m_prev - pm1);
            ga[384 + t0] = __expf(-(b0 + pm0)); ga[384 + t1] = __expf(-(b1 + pm1));
            ga[512 + t0] = __expf(a0 - Mx); ga[512 + t1] = __expf(a1 - Mx);
            if (lane == 0) ga[640] = __expf(m_prev - Mx);
            m_prev = blast + Mx;
        }
        __syncthreads();
        {
            const bf16* vp = QKVO + (rowbase + 2 * lane) * NAIN + 2048 + h * ADV + 64 * j + 8 * wave;
            const v4u r0 = *(const v4u*)vp, r1 = *(const v4u*)(vp + NAIN);
            v4u ka[2], kb[2]; ML_LOAD_K_ISSUE(0, ka, kb);
#pragma unroll
            for (int e = 0; e < 8; ++e) *(LAS unsigned*)(lds + ML_VT + (8 * wave + e) * ML_VTS + 4 * lane) = bfel(r0, e) | (bfel(r1, e) << 16);
            ML_LOAD_K_PUT(ka, kb);
        }
        __syncthreads();
        const float decay = ga[640];
        f32x4 aqc[5], as_[8];
#pragma unroll
        for (int vb = 0; vb < 5; ++vb) aqc[vb] = (f32x4){0.f, 0.f, 0.f, 0.f};
#pragma unroll
        for (int ks = 0; ks < 8; ++ks) { bf16x8 fb_[5];
#pragma unroll
            for (int vb = 0; vb < 5; ++vb) fb_[vb] = *(const LAS bf16x8*)(lds + ML_CTB + (16 * vb + i16) * ML_CTBS + (32 * ks + 8 * g) * 2);
#pragma unroll
            for (int vb = 0; vb < 5; ++vb) aqc[vb] = MFMA16(qf[ks], fb_[vb], aqc[vb]); }
#pragma unroll
        for (int jb = 0; jb < 8; ++jb) as_[jb] = (f32x4){0.f, 0.f, 0.f, 0.f};
        ML_HALF(0);
        __syncthreads();
        { v4u ka[2], kb[2]; ML_LOAD_K_ISSUE(1, ka, kb);
          ML_PUT_CTB(0);
          ML_LOAD_K_PUT(ka, kb); }
        __syncthreads();
        ML_HALF(1);
        ML_PUT_CTB(1);
        const int tl = 16 * wave + i16; const float pmt = ga[128 + tl];
        bf16x8 pf[4];
#pragma unroll
        for (int kk = 0; kk < 4; ++kk) { float pv[8];
#pragma unroll
            for (int hb = 0; hb < 2; ++hb) { const int jb = 2 * kk + hb; const f32x4 av = *(const LAS f32x4*)(ga + 16 * jb + 4 * g);
#pragma unroll
                for (int r = 0; r < 4; ++r) { const int s = 16 * jb + 4 * g + r; const float wgt = (s <= tl) ? __expf(av[r] - pmt) : 0.f; pv[4 * hb + r] = as_[jb][r] * wgt; } }
            v4u w; w.x = pk2m(pv[0], pv[1]); w.y = pk2m(pv[2], pv[3]); w.z = pk2m(pv[4], pv[5]); w.w = pk2m(pv[6], pv[7]); pf[kk] = __builtin_bit_cast(bf16x8, w); }
        f32x4 apv[5];
#pragma unroll
        for (int vb = 0; vb < 5; ++vb) apv[vb] = (f32x4){0.f, 0.f, 0.f, 0.f};
#pragma unroll
        for (int kk = 0; kk < 4; ++kk) { v4u wv_[5];
#pragma unroll
            for (int vb = 0; vb < 5; ++vb) { const LAS unsigned char* vp = lds + ML_VT + (16 * vb + i16) * ML_VTS + (32 * kk + 4 * g) * 2;
                const v2u lo = *(const LAS v2u*)vp, hi = *(const LAS v2u*)(vp + 32); wv_[vb] = (v4u){lo.x, lo.y, hi.x, hi.y}; }
#pragma unroll
            for (int vb = 0; vb < 5; ++vb) apv[vb] = MFMA16(pf[kk], __builtin_bit_cast(bf16x8, wv_[vb]), apv[vb]); }
        const f32x4 wi4 = *(const LAS f32x4*)(ga + 256 + 16 * wave + 4 * g), ef4 = *(const LAS f32x4*)(ga + 384 + 16 * wave + 4 * g);
#pragma unroll
        for (int r = 0; r < 4; ++r) { const int tr = 16 * wave + 4 * g + r; const float wi = wi4[r];
            float den = apv[4][r] + wi * aqc[4][r]; den = __shfl(den, lane & 48); den = fmaxf(fabsf(den), ef4[r]);
            const float inv = 1.0f / den; float ss = 0.f; const bool ok = tr < nvalid;
#pragma unroll
            for (int vb = 0; vb < 4; ++vb) { const float hv = (apv[vb][r] + wi * aqc[vb][r]) * inv; ss += hv * hv;
                if (ok) HM[(rowbase + tr) * DM + h * ADV + 64 * j + 16 * vb + i16] = hv; }
            ss += __shfl_xor(ss, 1); ss += __shfl_xor(ss, 2); ss += __shfl_xor(ss, 4); ss += __shfl_xor(ss, 8);
            if (ok && i16 == 0) HSSQ[(rowbase + tr) * 32 + h * 8 + j] = ss; }
    }
    const size_t bh = (size_t)b * AH + h;
#pragma unroll
    for (int dh = 0; dh < 2; ++dh) { const int d = 128 * dh + 16 * wave + i16;
#pragma unroll
        for (int vb = 0; vb < 4; ++vb) *(f32x4*)(out + O_CP + (bh * ADK + d) * ADV + 64 * j + 16 * vb + 4 * g) = accC[dh][vb];
        if (j == 0 && g == 0) out[O_NP + bh * ADK + d] = accC[dh][4][0]; }
    if (j == 0 && tid == 0) out[O_MP + bh] = m_prev;
}

__device__ __forceinline__ void mlstm_sample_unit(LAS unsigned char* lds, const bf16* QKVO, const float* GATES, const float* stC, const float* stN, const float* stM,
                                                  float* HM, float* HSSQ, float* out, int b, int h, int tid, int wave, int lane) {
    LAS float* qT = (LAS float*)lds;
    LAS float* wkT = (LAS float*)(lds + 4096);
    LAS float* qN = (LAS float*)(lds + 8192);
    LAS float* kN = (LAS float*)(lds + 12288);
    LAS float* dots = (LAS float*)(lds + 16384);
    LAS float* red = (LAS float*)(lds + 16640);
    const int row0 = MPR + DECS * b; const size_t bh = (size_t)b * AH + h;
    float ig[4], bb[4], a_[4], pm[4], wint[4], efl[4], wst[4];
    const unsigned qq = *(const unsigned*)(QKVO + (size_t)(row0 + (tid >> 7)) * NAIN + h * ADK + (tid & 127) * 2), kk = *(const unsigned*)(QKVO + (size_t)(row0 + (tid >> 7)) * NAIN + h * ADK + (tid & 127) * 2 + 1024);
    v2u vw[4];
#pragma unroll
    for (int s = 0; s < 4; ++s) vw[s] = *(const v2u*)(QKVO + (size_t)(row0 + s) * NAIN + 2048 + h * ADV + 4 * (tid & 127));
    const float mprev = stM[bh];
    { float run = 0.f, pmax = -INFINITY;
#pragma unroll
      for (int s = 0; s < 4; ++s) { ig[s] = GATES[(size_t)(row0 + s) * 8 + h]; run += GATES[(size_t)(row0 + s) * 8 + 4 + h]; bb[s] = run; a_[s] = ig[s] - bb[s]; pmax = fmaxf(pmax, a_[s]);
          pm[s] = fmaxf(mprev, pmax); wint[s] = __expf(mprev - pm[s]); efl[s] = __expf(-(bb[s] + pm[s])); } }
    const float Mx = pm[3], decay = __expf(mprev - Mx), mnew = bb[3] + Mx;
#pragma unroll
    for (int s = 0; s < 4; ++s) wst[s] = __expf(a_[s] - Mx);
    __syncthreads();
    { const int s = tid >> 7, d2 = (tid & 127) * 2;
      const float q0 = bflo(qq), q1 = bfhi(qq), k0 = bflo(kk), k1 = bfhi(kk);
      const float w = s == 0 ? wst[0] : s == 1 ? wst[1] : s == 2 ? wst[2] : wst[3];
      qT[d2 * 4 + s] = q0; qT[(d2 + 1) * 4 + s] = q1; wkT[d2 * 4 + s] = w * k0; wkT[(d2 + 1) * 4 + s] = w * k1;
      qN[s * 256 + d2] = q0; qN[s * 256 + d2 + 1] = q1; kN[s * 256 + d2] = k0; kN[s * 256 + d2 + 1] = k1; }
    __syncthreads();
    for (int x = wave; x < 20; x += 8) { float p = 0.f;
        if (x < 16) { const int t = x >> 2, s = x & 3;
#pragma unroll
            for (int i = 0; i < 4; ++i) p += qN[t * 256 + lane + 64 * i] * kN[s * 256 + lane + 64 * i]; }
        else { const int t = x - 16;
#pragma unroll
            for (int i = 0; i < 4; ++i) p += qN[t * 256 + lane + 64 * i] * stN[bh * ADK + lane + 64 * i]; }
        p = wave_sum(p); if (lane == 0) dots[x] = p; }
    __syncthreads();
    float P[4][4], deninv[4];
#pragma unroll
    for (int t = 0; t < 4; ++t) { float den = 0.f;
#pragma unroll
        for (int s = 0; s < 4; ++s) { P[t][s] = s <= t ? dots[4 * t + s] * __expf(a_[s] - pm[t]) : 0.f; den += P[t][s]; }
        den += wint[t] * dots[16 + t]; deninv[t] = 1.0f / fmaxf(fabsf(den), efl[t]); }
    const int eq = tid & 127, dq = tid >> 7;
    f32x4 vv[4];
#pragma unroll
    for (int s = 0; s < 4; ++s) { const v2u w = vw[s]; vv[s] = (f32x4){bflo(w.x), bfhi(w.x), bflo(w.y), bfhi(w.y)}; }
    f32x4 qc[4];
#pragma unroll
    for (int t = 0; t < 4; ++t) qc[t] = (f32x4){0.f, 0.f, 0.f, 0.f};
    const float* Cin = stC + bh * ADK * ADV + 4 * eq; float* Cout = out + O_CS + bh * ADK * ADV + 4 * eq;
#pragma unroll 8
    for (int dd = 0; dd < 64; ++dd) { const int d = 64 * dq + dd;
        const f32x4 c = *(const f32x4*)(Cin + (size_t)d * ADV); const f32x4 q4 = *(const LAS f32x4*)(qT + 4 * d), k4 = *(const LAS f32x4*)(wkT + 4 * d);
#pragma unroll
        for (int t = 0; t < 4; ++t) qc[t] += c * q4[t];
        *(f32x4*)(Cout + (size_t)d * ADV) = c * decay + vv[0] * k4[0] + vv[1] * k4[1] + vv[2] * k4[2] + vv[3] * k4[3]; }
#pragma unroll
    for (int t = 0; t < 4; ++t) *(LAS f32x4*)(red + (dq * 4 + t) * 512 + 4 * eq) = qc[t];
    __syncthreads();
    { const int e = tid; float ve[4];
#pragma unroll
      for (int s = 0; s < 4; ++s) ve[s] = __uint_as_float((unsigned)QKVO[(size_t)(row0 + s) * NAIN + 2048 + h * ADV + e] << 16);
#pragma unroll
      for (int t = 0; t < 4; ++t) { const float qcs = (red[(0 * 4 + t) * 512 + e] + red[(1 * 4 + t) * 512 + e]) + (red[(2 * 4 + t) * 512 + e] + red[(3 * 4 + t) * 512 + e]);
          float pvv = 0.f;
#pragma unroll
          for (int s = 0; s < 4; ++s) pvv += P[t][s] * ve[s];
          const float hv = (pvv + wint[t] * qcs) * deninv[t];
          HM[(size_t)(row0 + t) * DM + h * ADV + e] = hv;
          const float ss = wave_sum(hv * hv); if (lane == 0) HSSQ[(size_t)(row0 + t) * 32 + h * 8 + wave] = ss; } }
    if (tid < ADK) { const f32x4 k4 = *(const LAS f32x4*)(wkT + 4 * tid); out[O_NS + bh * ADK + tid] = decay * stN[bh * ADK + tid] + ((k4[0] + k4[1]) + (k4[2] + k4[3])); }
    if (tid == 0) out[O_MS + bh] = mnew;
}

__device__ __forceinline__ void mlstm_gate_rows(const float* HM, const float* HSSQ, const bf16* QKVO, const float* gain, bf16* AM, int gw, int NGW, int lane) {
    f32x4 g0[4], g1[4];
#pragma unroll
    for (int i = 0; i < 4; ++i) { g0[i] = *(const f32x4*)(gain + 512 * i + 8 * lane); g1[i] = *(const f32x4*)(gain + 512 * i + 8 * lane + 4); }
    for (int row0 = 2 * gw; row0 < MREAL; row0 += 2 * NGW) {
        f32x4 s0[2][4], s1[2][4], h0[2][4], h1[2][4]; v4u ow[2][4];
#pragma unroll
        for (int q = 0; q < 2; ++q) { const int row = row0 + q < MREAL ? row0 + q : row0;
#pragma unroll
            for (int i = 0; i < 4; ++i) { const int c = 512 * i + 8 * lane;
                s0[q][i] = *(const f32x4*)(HSSQ + (size_t)row * 32 + 8 * i); s1[q][i] = *(const f32x4*)(HSSQ + (size_t)row * 32 + 8 * i + 4);
                h0[q][i] = *(const f32x4*)(HM + (size_t)row * DM + c); h1[q][i] = *(const f32x4*)(HM + (size_t)row * DM + c + 4);
                ow[q][i] = *(const v4u*)(QKVO + (size_t)row * NAIN + 4096 + c); } }
#pragma unroll
        for (int q = 0; q < 2; ++q) { const int row = row0 + q; if (row < MREAL) {
#pragma unroll
            for (int i = 0; i < 4; ++i) {
                const float rs = rsqrtf((((s0[q][i][0] + s0[q][i][1]) + (s0[q][i][2] + s0[q][i][3])) + ((s1[q][i][0] + s1[q][i][1]) + (s1[q][i][2] + s1[q][i][3]))) * (1.0f / ADV) + EPS);
                float o[8];
#pragma unroll
                for (int e = 0; e < 8; ++e) { const float ov = __uint_as_float(bfel(ow[q][i], e) << 16); const float sg = __builtin_amdgcn_rcpf(1.0f + __expf(-ov));
                    const float hv = e < 4 ? h0[q][i][e & 3] * g0[i][e & 3] : h1[q][i][e & 3] * g1[i][e & 3]; o[e] = hv * rs * sg; }
                v4u w; w.x = pk2(o[0], o[1]); w.y = pk2(o[2], o[3]); w.z = pk2(o[4], o[5]); w.w = pk2(o[6], o[7]);
                *(v4u*)(AM + (size_t)row * DM + 512 * i + 8 * lane) = w; } } }
    }
}

template <int NKEY> struct AttnLds { static constexpr int KNS = 144, KN = 0, VT = NKEY * 144, VTS = NKEY * 2 + 16, END = VT + 64 * VTS; };

struct AttnMask { int rel0, lim, mrel;
    __device__ __forceinline__ bool operator()(int jj, int blk, int r, float& dist) const {
        if (jj == 0) { dist = (float)WIN; return mrel - r >= WIN; }
        const int rel = rel0 - 16 * blk - r; dist = (float)rel; return (unsigned)rel <= (unsigned)lim; } };
struct MaskGen { AttnMask m; float slope;
    __device__ __forceinline__ float apply(int jj, int blk, int r, float s) const { float dist; const bool ok = m(jj, blk, r, dist); return ok ? s - slope * dist : -INFINITY; }
    __device__ __forceinline__ float shift() const { return 0.f; } };
struct MaskFast { float u[4], s16, m0, sh; int relT;
    __device__ __forceinline__ void init(float slope, int lane) { const int i16 = lane & 15, g = lane >> 4;
#pragma unroll
        for (int r = 0; r < 4; ++r) u[r] = slope * (float)(4 * g + r);
        s16 = 16.0f * slope; m0 = slope * (float)(16 + i16); sh = slope * (float)(144 + i16); relT = 144 + i16 - 4 * g; }
    __device__ __forceinline__ float apply(int jj, int, int r, float s) const {
        if (jj == 0) return s + m0;
        const float v = (s + u[r]) + s16 * (float)jj;
        if (jj == 1) return relT - 16 - r <= WIN - 1 ? v : -INFINITY;
        if (jj == 9) return relT - 144 - r >= 0 ? v : -INFINITY;
        return v; }
    __device__ __forceinline__ float shift() const { return sh; } };
template <int NKEY, int NJB, class MaskF, class BlkF>
__device__ __forceinline__ void attn_tblock(LAS unsigned char* lds, const bf16x8 qf0, const bf16x8 qf1, float sink_in, const MaskF& mask, const BlkF& blk,
                                            bf16* orow  , int nq_valid, int lane) {
    typedef AttnLds<NKEY> L;
    const int i16 = lane & 15, g = lane >> 4;
    f32x4 sacc[NJB];
#pragma unroll
    for (int jb = 0; jb < NJB; ++jb) { sacc[jb] = (f32x4){0.f, 0.f, 0.f, 0.f};
        const LAS unsigned char* kp = lds + L::KN + (16 * blk(jb) + i16) * L::KNS + 16 * g;
        sacc[jb] = MFMA16(*(const LAS bf16x8*)kp, qf0, sacc[jb]); sacc[jb] = MFMA16(*(const LAS bf16x8*)(kp + 64), qf1, sacc[jb]); }
    const float sink = sink_in + mask.shift();
    float mx = sink;
#pragma unroll
    for (int jb = 0; jb < NJB; ++jb)
#pragma unroll
        for (int r = 0; r < 4; ++r) { const float sv = mask.apply(jb, blk(jb), r, sacc[jb][r]); sacc[jb][r] = sv; mx = fmaxf(mx, sv); }
    mx = fmaxf(mx, __shfl_xor(mx, 16)); mx = fmaxf(mx, __shfl_xor(mx, 32));
    float sum = 0.f;
#pragma unroll
    for (int jb = 0; jb < NJB; ++jb)
#pragma unroll
        for (int r = 0; r < 4; ++r) { const float p = __expf(sacc[jb][r] - mx); sacc[jb][r] = p; sum += p; }
    sum += __shfl_xor(sum, 16); sum += __shfl_xor(sum, 32);
    sum += __expf(sink - mx);
    const float inv = 1.0f / sum;
    f32x4 oacc[4];
#pragma unroll
    for (int db = 0; db < 4; ++db) oacc[db] = (f32x4){0.f, 0.f, 0.f, 0.f};
#pragma unroll
    for (int kk = 0; kk < NJB / 2; ++kk) {
        v4u w; w.x = pk2m(sacc[2 * kk][0], sacc[2 * kk][1]); w.y = pk2m(sacc[2 * kk][2], sacc[2 * kk][3]); w.z = pk2m(sacc[2 * kk + 1][0], sacc[2 * kk + 1][1]); w.w = pk2m(sacc[2 * kk + 1][2], sacc[2 * kk + 1][3]);
        const bf16x8 pf = __builtin_bit_cast(bf16x8, w);
#pragma unroll
        for (int db = 0; db < 4; ++db) { const LAS unsigned char* vp = lds + L::VT + (16 * db + i16) * L::VTS + 8 * g;
            const v2u lo = *(const LAS v2u*)(vp + 32 * blk(2 * kk)), hi = *(const LAS v2u*)(vp + 32 * blk(2 * kk + 1)); const v4u bw = (v4u){lo.x, lo.y, hi.x, hi.y};
            oacc[db] = MFMA16(__builtin_bit_cast(bf16x8, bw), pf, oacc[db]); } }
    if (i16 < nq_valid) {
#pragma unroll
        for (int db = 0; db < 4; ++db) { const f32x4 o = oacc[db] * inv; v2u w; w.x = pk2(o[0], o[1]); w.y = pk2(o[2], o[3]); *(v2u*)(orow + (size_t)i16 * DM + 16 * db + 4 * g) = w; } }
}

__device__ __forceinline__ void attn_prompt_unit(LAS unsigned char* lds, const bf16* QB, const bf16* KB, const bf16* VB, const float* sinks, bf16* AM, int b, int g, int n, int tid, int wave, int lane) {
    typedef AttnLds<288> L;
    const int hh = 8 * g + wave; const float slope = exp2f(-0.25f * (float)(hh + 1)), sink = sinks[hh];
    const bf16* qbase = QB + ((size_t)b * TP + 128 * n + (lane & 15)) * DM + hh * 64 + 8 * (lane >> 4);
    bf16x8 q0 = *(const bf16x8*)qbase, q1 = *(const bf16x8*)(qbase + 32);
    __syncthreads();
    { v4u kr[5], vr0[3], vr1[3];
#pragma unroll
      for (int i = 0; i < 5; ++i) { const int it = tid + 512 * i, kk = it >> 3, ch = it & 7; const int pos = kk < NMETA ? kk : 128 * (n - 1) + kk - NMETA; kr[i] = (v4u){0u, 0u, 0u, 0u};
          if (it < 288 * 8 && kk < NMETA + 256 && pos >= 0 && pos < TP) kr[i] = *(const v4u*)(KB + ((size_t)b * TP + pos) * 256 + g * 64 + 8 * ch); }
#pragma unroll
      for (int i = 0; i < 3; ++i) { const int it = tid + 512 * i, ch = it / 144, p = it - ch * 144; vr0[i] = (v4u){0u, 0u, 0u, 0u}; vr1[i] = vr0[i];
          if (it < 144 * 8) {
              { const int kk = 2 * p, pos = kk < NMETA ? kk : 128 * (n - 1) + kk - NMETA; if (kk < NMETA + 256 && pos >= 0 && pos < TP) vr0[i] = *(const v4u*)(VB + ((size_t)b * TP + pos) * 256 + g * 64 + 8 * ch); }
              { const int kk = 2 * p + 1, pos = kk < NMETA ? kk : 128 * (n - 1) + kk - NMETA; if (kk < NMETA + 256 && pos >= 0 && pos < TP) vr1[i] = *(const v4u*)(VB + ((size_t)b * TP + pos) * 256 + g * 64 + 8 * ch); } } }
#pragma unroll
      for (int i = 0; i < 5; ++i) { const int it = tid + 512 * i, kk = it >> 3, ch = it & 7; if (it < 288 * 8) *(LAS v4u*)(lds + L::KN + kk * L::KNS + 16 * ch) = kr[i]; }
#pragma unroll
      for (int i = 0; i < 3; ++i) { const int it = tid + 512 * i, ch = it / 144, p = it - ch * 144;
          if (it < 144 * 8) {
#pragma unroll
              for (int e = 0; e < 8; ++e) *(LAS unsigned*)(lds + L::VT + (8 * ch + e) * L::VTS + 4 * p) = bfel(vr0[i], e) | (bfel(vr1[i], e) << 16); } } }
    __syncthreads();
    MaskFast mf; mf.init(slope, lane);
    for (int tb = 0; tb < 8; ++tb) { const int tpos0 = 128 * n + 16 * tb; if (tpos0 >= TP) break;
        const size_t row0 = (size_t)b * TP + tpos0;
        const int tbn = (tb < 7 && tpos0 + 16 < TP) ? tb + 1 : tb;
        const bf16x8 n0 = *(const bf16x8*)(qbase + (size_t)tbn * 16 * DM), n1 = *(const bf16x8*)(qbase + (size_t)tbn * 16 * DM + 32);
        __builtin_amdgcn_sched_barrier(0);
        const auto blk = [tb](int jj) { return jj == 0 ? 0 : tb + jj; };
        if (n >= 2) attn_tblock<288, 10>(lds, q0, q1, sink, mf, blk, AM + row0 * DM + hh * 64, 16, lane);
        else { const int tpos = tpos0 + (lane & 15);
            const MaskGen mk{AttnMask{tpos - 128 * (n - 1) + NMETA - 4 * (lane >> 4), tpos < WIN - 1 ? tpos : WIN - 1, tpos - 4 * (lane >> 4)}, slope};
            attn_tblock<288, 10>(lds, q0, q1, sink, mk, blk, AM + row0 * DM + hh * 64, 16, lane); }
        q0 = n0; q1 = n1; }
}
__device__ __forceinline__ void attn_sample_unit(LAS unsigned char* lds, const bf16* QB, const bf16* KB, const bf16* VB, const float* ckm, const float* cvm, const float* ckw, const float* cvw,
                                                 const float* sinks, bf16* AM, int b, int g, int tid, int wave, int lane) {
    typedef AttnLds<160> L;
    const int hh = 8 * g + wave; const float slope = exp2f(-0.25f * (float)(hh + 1)), sink = sinks[hh];
    const size_t row0 = (size_t)MPR + DECS * b;
    const bf16* qbase = QB + (row0 + (lane & 15)) * DM + hh * 64 + 8 * (lane >> 4);
    const bf16x8 q0 = *(const bf16x8*)qbase, q1 = *(const bf16x8*)(qbase + 32);
    __syncthreads();
    { f32x4 kf0[3], kf1[3]; v4u kn[3];
#pragma unroll
      for (int i = 0; i < 3; ++i) { const int it = tid + 512 * i, kk = it >> 3, ch = it & 7; kf0[i] = (f32x4){0.f, 0.f, 0.f, 0.f}; kf1[i] = kf0[i]; kn[i] = (v4u){0u, 0u, 0u, 0u};
          if (it < 160 * 8) {
              if (kk < NMETA + WIN) { const float* src = kk < NMETA ? ckm + (((size_t)b * NMETA + kk) * BKV + g) * 64 + 8 * ch : ckw + (((size_t)b * WIN + (kk - NMETA)) * BKV + g) * 64 + 8 * ch;
                  kf0[i] = *(const f32x4*)src; kf1[i] = *(const f32x4*)(src + 4); }
              else if (kk < NMETA + WIN + DECS) kn[i] = *(const v4u*)(KB + ((size_t)MPR + DECS * b + (kk - NMETA - WIN)) * 256 + g * 64 + 8 * ch); } }
      f32x4 vf0[2][2], vf1[2][2]; v4u vn[2][2];
#pragma unroll
      for (int i = 0; i < 2; ++i) { const int it = tid + 512 * i, ch = it / 80, p = it - ch * 80;
#pragma unroll
          for (int q = 0; q < 2; ++q) { const int kk = 2 * p + q; vf0[i][q] = (f32x4){0.f, 0.f, 0.f, 0.f}; vf1[i][q] = vf0[i][q]; vn[i][q] = (v4u){0u, 0u, 0u, 0u};
              if (it < 80 * 8) {
                  if (kk < NMETA + WIN) { const float* src = kk < NMETA ? cvm + (((size_t)b * NMETA + kk) * BKV + g) * 64 + 8 * ch : cvw + (((size_t)b * WIN + (kk - NMETA)) * BKV + g) * 64 + 8 * ch;
                      vf0[i][q] = *(const f32x4*)src; vf1[i][q] = *(const f32x4*)(src + 4); }
                  else if (kk < NMETA + WIN + DECS) vn[i][q] = *(const v4u*)(VB + ((size_t)MPR + DECS * b + (kk - NMETA - WIN)) * 256 + g * 64 + 8 * ch); } } }
#pragma unroll
      for (int i = 0; i < 3; ++i) { const int it = tid + 512 * i, kk = it >> 3, ch = it & 7;
          if (it < 160 * 8) { v4u r = kn[i];
              if (kk < NMETA + WIN) { r.x = pk2(kf0[i][0], kf0[i][1]); r.y = pk2(kf0[i][2], kf0[i][3]); r.z = pk2(kf1[i][0], kf1[i][1]); r.w = pk2(kf1[i][2], kf1[i][3]); }
              *(LAS v4u*)(lds + L::KN + kk * L::KNS + 16 * ch) = r; } }
#pragma unroll
      for (int i = 0; i < 2; ++i) { const int it = tid + 512 * i, ch = it / 80, p = it - ch * 80;
          if (it < 80 * 8) { v4u rr[2];
#pragma unroll
              for (int q = 0; q < 2; ++q) { const int kk = 2 * p + q; v4u r = vn[i][q];
                  if (kk < NMETA + WIN) { r.x = pk2(vf0[i][q][0], vf0[i][q][1]); r.y = pk2(vf0[i][q][2], vf0[i][q][3]); r.z = pk2(vf1[i][q][0], vf1[i][q][1]); r.w = pk2(vf1[i][q][2], vf1[i][q][3]); }
                  rr[q] = r; }
#pragma unroll
              for (int e = 0; e < 8; ++e) *(LAS unsigned*)(lds + L::VT + (8 * ch + e) * L::VTS + 4 * p) = bfel(rr[0], e) | (bfel(rr[1], e) << 16); } } }
    __syncthreads();
    const MaskGen mk{AttnMask{WIN + (lane & 15) + NMETA - 4 * (lane >> 4), WIN - 1, 1 << 20}, slope};
    const auto blk = [](int jj) { return jj; };
    attn_tblock<160, 10>(lds, q0, q1, sink, mk, blk, AM + row0 * DM + hh * 64, DECS, lane);
}
__device__ __forceinline__ void kv_outputs(const Args& a, const bf16* KB, const bf16* VB, size_t gtid, size_t gthreads) {
    float* out = a.out;
    for (size_t i = gtid; i < (size_t)NBATCH * (NMETA + WIN) * 256; i += gthreads) { const int c = (int)(i & 255); const int rr = (int)(i >> 8); const int b = rr / (NMETA + WIN), q = rr - b * (NMETA + WIN);
        const int t = q < NMETA ? q : TP - WIN + (q - NMETA); const size_t src = ((size_t)b * TP + t) * 256 + c;
        const float kv = __uint_as_float((unsigned)KB[src] << 16), vv = __uint_as_float((unsigned)VB[src] << 16);
        if (q < NMETA) { out[O_KMP + ((size_t)b * NMETA + q) * 256 + c] = kv; out[O_VMP + ((size_t)b * NMETA + q) * 256 + c] = vv; }
        else { out[O_KWP + ((size_t)b * WIN + (q - NMETA)) * 256 + c] = kv; out[O_VWP + ((size_t)b * WIN + (q - NMETA)) * 256 + c] = vv; } }
    for (size_t i = gtid; i < (size_t)DECB * WIN * 64; i += gthreads) { const int c4 = (int)(i & 63) * 4; const int rr = (int)(i >> 6); const int b = rr >> 7, jj = rr & 127;
        f32x4 kv, vv;
        if (jj < WIN - DECS) { kv = *(const f32x4*)(a.in[I_CKW] + ((size_t)b * WIN + jj + DECS) * 256 + c4); vv = *(const f32x4*)(a.in[I_CVW] + ((size_t)b * WIN + jj + DECS) * 256 + c4); }
        else { const size_t src = ((size_t)MPR + DECS * b + (jj - (WIN - DECS))) * 256 + c4; const v2u kw = *(const v2u*)(KB + src), vw = *(const v2u*)(VB + src);
            kv = (f32x4){bflo(kw.x), bfhi(kw.x), bflo(kw.y), bfhi(kw.y)}; vv = (f32x4){bflo(vw.x), bfhi(vw.x), bflo(vw.y), bfhi(vw.y)}; }
        *(f32x4*)(out + O_KWS + ((size_t)b * WIN + jj) * 256 + c4) = kv; *(f32x4*)(out + O_VWS + ((size_t)b * WIN + jj) * 256 + c4) = vv; }
}

struct TailSplitOrder {
    pg8::StaticOrder mo; int G, c, kp;
    __device__ void init(int N, int K, int G_, int c_) { mo.init(TS_PM0 * 256, N, G_, c_); mo.nt0 = K / 64; kp = K / TS_PARTS; G = G_; c = c_; }
    __device__ bool next(int i, pg8::Unit& u) const {
        if (mo.next(i, u)) return true;
        const long L = (long)i * G + c - (long)mo.nwg; if (L < 0 || L >= TS_TILES * TS_PARTS) return false;
        const int t = (int)L / TS_PARTS, part = (int)L % TS_PARTS; u.pm = TS_PM0 + t / 8; u.pn = t % 8; u.koff = part * kp * 2; u.nt = kp / 64; return true; }
    __device__ __forceinline__ void a_ready(const pg8::Unit&) const {}
    __device__ __forceinline__ void done(const pg8::Unit&) const {}
};
template <bool FINAL> __device__ __forceinline__ void resid_combine(LAS unsigned char* lds, const bf16* HI, bf16* AB, const float* ssq, float* rs, const float* slab, float sc, float* out, int G, int wave, int gw, int NGW, int lane) {
    LAS float* red = (LAS float*)lds;
    constexpr int NT = MP - TS_PM0 * 256;
    for (int j0 = 0; (int)blockIdx.x + G * j0 < NT; j0 += 3) {
        f32x4 pp[3][4]; v2u hb[3];
#pragma unroll
        for (int j = 0; j < 3; ++j) { const int it = (int)blockIdx.x + G * (j0 + j); const int itc = it < NT ? it : (int)blockIdx.x;
            const int r = itc & 255, row = TS_PM0 * 256 + itc, t = (itc >> 8) * 8 + wave;
            const float* sp = slab + (size_t)(t * TS_PARTS) * 65536 + (size_t)r * 256 + 4 * lane;
#pragma unroll
            for (int p = 0; p < 4; ++p) pp[j][p] = *(const f32x4*)(sp + (size_t)p * 65536);
            hb[j] = *(const v2u*)(HI + (size_t)row * DM + wave * 256 + 4 * lane); }
        if (!FINAL && j0 > 0) __syncthreads();
#pragma unroll
        for (int j = 0; j < 3; ++j) { const int it = (int)blockIdx.x + G * (j0 + j);
            if (it < NT) { const int row = TS_PM0 * 256 + it, col = wave * 256 + 4 * lane;
                const f32x4 hn = (f32x4){bflo(hb[j].x), bfhi(hb[j].x), bflo(hb[j].y), bfhi(hb[j].y)} + ((pp[j][0] + pp[j][1]) + (pp[j][2] + pp[j][3])) * sc;
                if (FINAL) { float* op = nullptr;
                    if (row < MPR) { const int b = row / TP, tt = row - b * TP; if (tt >= NMETA) op = out + O_YP + ((size_t)b * SEQ + (tt - NMETA)) * DM; }
                    else if (row < MREAL) op = out + O_YS + (size_t)(row - MPR) * DM;
                    if (op) *(f32x4*)(op + col) = hn; }
                else { v2u w; w.x = pk2(hn[0], hn[1]); w.y = pk2(hn[2], hn[3]); *(v2u*)(AB + (size_t)row * DM + col) = w;
                    const float ss = wave_sum((hn[0] * hn[0] + hn[1] * hn[1]) + (hn[2] * hn[2] + hn[3] * hn[3]));
                    if (lane == 0) red[j * 8 + wave] = ss; } } }
        if (!FINAL) {
            __syncthreads();
            if (wave == 0 && lane < 3) { const int it = (int)blockIdx.x + G * (j0 + lane);
                if (it < NT) { float s = 0.f;
#pragma unroll
                    for (int w = 0; w < 8; ++w) s += red[lane * 8 + w];
                    rs[TS_PM0 * 256 + it] = rsqrtf(s * (1.0f / DM) + EPS); } } } }
    if (!FINAL) {
        for (int it0 = gw; it0 < TS_PM0 * 128; it0 += 4 * NGW) { float sv[4];
#pragma unroll
            for (int k = 0; k < 4; ++k) { const int it = it0 + k * NGW; sv[k] = it < TS_PM0 * 128 ? ssq[(size_t)(2 * it + (lane >> 5)) * 32 + (lane & 31)] : 0.f; }
#pragma unroll
            for (int k = 0; k < 4; ++k) { const int it = it0 + k * NGW; float s = sv[k];
                s += __shfl_xor(s, 1); s += __shfl_xor(s, 2); s += __shfl_xor(s, 4); s += __shfl_xor(s, 8); s += __shfl_xor(s, 16);
                if (it < TS_PM0 * 128 && (lane & 31) == 0) rs[2 * it + (lane >> 5)] = rsqrtf(s * (1.0f / DM) + EPS); } } }
}
__device__ __forceinline__ void head_combine(bf16* O, const float* rsv, const float* gain, float post, const float* slab, int gw, int NGW, int lane) {
    const int hd = (lane >> 3) & 3, dim = 32 * (lane >> 5) + 4 * (lane & 7);
    const f32x4 gv = *(const f32x4*)(gain + dim);
    for (int it0 = gw; it0 < TS_TILES * 256; it0 += 3 * NGW) {
        f32x4 pp[3][4]; float rsl[3];
#pragma unroll
        for (int k = 0; k < 3; ++k) { const int it = it0 + k * NGW < TS_TILES * 256 ? it0 + k * NGW : it0; const int t = it >> 8, r = it & 255, row = (TS_PM0 + (t >> 3)) * 256 + r;
            const float* sp = slab + (size_t)(t * TS_PARTS) * 65536 + (size_t)r * 256 + 4 * lane;
#pragma unroll
            for (int p = 0; p < 4; ++p) pp[k][p] = *(const f32x4*)(sp + (size_t)p * 65536);
            rsl[k] = rsv[row]; }
#pragma unroll
        for (int k = 0; k < 3; ++k) { const int it = it0 + k * NGW; if (it < TS_TILES * 256) { const int t = it >> 8, r = it & 255, pn = t & 7, row = (TS_PM0 + (t >> 3)) * 256 + r;
            const f32x4 x = ((pp[k][0] + pp[k][1]) + (pp[k][2] + pp[k][3])) * rsl[k];
            float ms = (x[0] * x[0] + x[1] * x[1]) + (x[2] * x[2] + x[3] * x[3]);
            ms += __shfl_xor(ms, 1); ms += __shfl_xor(ms, 2); ms += __shfl_xor(ms, 4); ms += __shfl_xor(ms, 32);
            const float inv = rsqrtf(ms * (1.0f / 64.0f) + EPS) * post;
            const f32x4 o = x * inv * gv;
            v2u w; w.x = pk2(o[0], o[1]); w.y = pk2(o[2], o[3]); *(v2u*)(O + (size_t)row * DM + pn * 256 + hd * 64 + dim) = w; } }
    }
}
#define GEMM_PHASE_TS(EPI_T, E, Aptr, Bptr, K_) do { pg8::Gemm gg{(const pg8::bf16_t*)(Aptr), (const pg8::bf16_t*)(Bptr), MP, DM, (K_)}; int bx_ = (int)blockIdx.x; asm volatile("" : "+s"(bx_)); TailSplitOrder SS; SS.init(DM, (K_), G, bx_); \
    pg8::gemm_phase<EPI_T, TailSplitOrder, true, true>(lds, gg, SS, (E)); } while (0)
typedef EpiResid<false, false> EpiResPlain; typedef EpiResid<true, false> EpiResFinal;
#define GEMM_PHASE(EPI_T, E, Aptr, Bptr, N_, K_) do { pg8::Gemm gg{(const pg8::bf16_t*)(Aptr), (const pg8::bf16_t*)(Bptr), MP, (N_), (K_)}; int bx_ = (int)blockIdx.x; asm volatile("" : "+s"(bx_)); pg8::StaticOrder SS; SS.init(MP, (N_), G, bx_); SS.nt0 = (K_) / 64; \
    pg8::gemm_phase<EPI_T, pg8::StaticOrder, true, true>(lds, gg, SS, (E)); } while (0)

__global__ void __launch_bounds__(NWAVES * 64, 2) yoco_fwd(Args args) {
    extern __shared__ __attribute__((aligned(16))) unsigned char lds_raw[];
    LAS unsigned char* lds = (LAS unsigned char*)lds_raw;
    volatile LAS unsigned* MISC = (volatile LAS unsigned*)(lds + MISC_OFF);
    const int tid = threadIdx.x, lane = tid & 63, wave = __builtin_amdgcn_readfirstlane(tid >> 6);
    const int G = gridDim.x, gw = blockIdx.x * NWAVES + wave, NGW = G * NWAVES;
    unsigned char* ws = args.ws;
    for (int u = tid; u < (LDS_BYTES - MISC_OFF) / 4; u += NWAVES * 64) ((LAS unsigned*)(lds + MISC_OFF))[u] = 0u;
    __syncthreads();
    XcdBarrier bar = xcd_barrier_post((unsigned*)(ws + WS_CTL) + CW_BAR, MISC + 8);

    bf16* AB = (bf16*)(ws + WS_AB); bf16* ACT = (bf16*)(ws + WS_ACT); bf16* QKVO = (bf16*)(ws + WS_ACT);
    float* HM = (float*)(ws + WS_HM); bf16* AM = (bf16*)(ws + WS_AM); bf16* QB = (bf16*)(ws + WS_QB); bf16* KB = (bf16*)(ws + WS_KB); bf16* VB = (bf16*)(ws + WS_VB);
    bf16* AB2 = (bf16*)(ws + WS_AB2); float* SSQ2 = (float*)(ws + WS_SSQ2); float* RS = (float*)(ws + WS_RS); float* RS2 = (float*)(ws + WS_RS2);
    float* SSQ = (float*)(ws + WS_SSQ); float* HSSQ = (float*)(ws + WS_HSSQ); float* GATES = (float*)(ws + WS_GATES);

    p0_prologue(args, lds, gw, NGW, wave, lane);
    xcd_barrier(bar);

    { EpiSwiglu<false> E{ACT, RS}; GEMM_PHASE(EpiSwiglu<false>, E, AB, ws + WS_W1 + 0 * SZ_W1, 2 * DFF, DM); }
    xcd_barrier(bar);
    { EpiResPlain E{AB, AB, SSQ, nullptr, (float*)(ws + WS_SLAB), 0.5f, DFF / 64}; GEMM_PHASE_TS(EpiResPlain, E, ACT, ws + WS_W2 + 0 * SZ_W2, DFF); }
    xcd_barrier(bar);
    resid_combine<false>(lds, AB, AB, SSQ, RS, (const float*)(ws + WS_SLAB), 0.5f, nullptr, G, wave, gw, NGW, lane);
    xcd_barrier(bar);

    { EpiQkvo E{QKVO, RS, GATES, args.in[I_BAG]}; GEMM_PHASE(EpiQkvo, E, AB, ws + WS_WAIN, NAIN_PAD, DM); }
    xcd_barrier(bar);
    for (int u = blockIdx.x; u < NBATCH * AH * 8; u += G) {
        const int v = (((u & 7) * 4 + (u >> 6)) << 3) | ((u >> 3) & 7);
        mlstm_prompt_unit(lds, QKVO, GATES, HM, HSSQ, args.out, v >> 5, (v >> 3) & 3, v & 7, tid, wave, lane); }
    for (int u = blockIdx.x; u < DECB * AH; u += G) mlstm_sample_unit(lds, QKVO, GATES, args.in[I_SC], args.in[I_SN], args.in[I_SM], HM, HSSQ, args.out, u >> 2, u & 3, tid, wave, lane);
    xcd_barrier(bar);
    mlstm_gate_rows(HM, HSSQ, QKVO, args.in[I_AHN], AM, gw, NGW, lane);
    xcd_barrier(bar);
    { EpiResPlain E{AB, AB, SSQ, nullptr, (float*)(ws + WS_SLAB), 1.0f, DM / 64}; GEMM_PHASE_TS(EpiResPlain, E, AM, ws + WS_WAOUT, DM); }
    xcd_barrier(bar);
    resid_combine<false>(lds, AB, AB, SSQ, RS, (const float*)(ws + WS_SLAB), 1.0f, nullptr, G, wave, gw, NGW, lane);
    xcd_barrier(bar);

    { EpiSwiglu<false> E{ACT, RS}; GEMM_PHASE(EpiSwiglu<false>, E, AB, ws + WS_W1 + 1 * SZ_W1, 2 * DFF, DM); }
    xcd_barrier(bar);
    { EpiResPlain E{AB, AB, SSQ, nullptr, (float*)(ws + WS_SLAB), 0.5f, DFF / 64}; GEMM_PHASE_TS(EpiResPlain, E, ACT, ws + WS_W2 + 1 * SZ_W2, DFF); }
    xcd_barrier(bar);
    resid_combine<false>(lds, AB, AB, SSQ, RS, (const float*)(ws + WS_SLAB), 0.5f, nullptr, G, wave, gw, NGW, lane);
    xcd_barrier(bar);

    { EpiSwiglu<false> E{ACT, RS}; GEMM_PHASE(EpiSwiglu<false>, E, AB, ws + WS_W1 + 2 * SZ_W1, 2 * DFF, DM); }
    xcd_barrier(bar);
    { EpiResPlain E{AB, AB2, SSQ2, nullptr, (float*)(ws + WS_SLAB), 0.5f, DFF / 64}; GEMM_PHASE_TS(EpiResPlain, E, ACT, ws + WS_W2 + 2 * SZ_W2, DFF); }
    { EpiHead E{KB, 256, VB, 256, 1, RS, args.in[I_KN], 1.0f, nullptr, DM / 64}; pg8::Gemm gg{(const pg8::bf16_t*)AB, (const pg8::bf16_t*)(ws + WS_WKV), MP, 512, DM}; int bx_ = ((int)blockIdx.x + G - TS_TILES * TS_PARTS % G) % G; asm volatile("" : "+s"(bx_));
      pg8::StaticOrder SS; SS.init(MP, 512, G, bx_); SS.nt0 = DM / 64; pg8::gemm_phase<EpiHead, pg8::StaticOrder, true, true>(lds, gg, SS, E); }
    xcd_barrier(bar);
    resid_combine<false>(lds, AB, AB2, SSQ2, RS2, (const float*)(ws + WS_SLAB), 0.5f, nullptr, G, wave, gw, NGW, lane);
    xcd_barrier(bar);

    { EpiHead E{QB, DM, QB, DM, 8, RS2, args.in[I_QN], 0.125f, (float*)(ws + WS_SLAB), DM / 64}; GEMM_PHASE_TS(EpiHead, E, AB2, ws + WS_WQ, DM); }
    if ((int)blockIdx.x >= TS_TILES * TS_PARTS) kv_outputs(args, KB, VB, (size_t)(blockIdx.x - TS_TILES * TS_PARTS) * (NWAVES * 64) + tid, (size_t)(G - TS_TILES * TS_PARTS) * NWAVES * 64);
    xcd_barrier(bar);
    head_combine(QB, RS2, args.in[I_QN], 0.125f, (const float*)(ws + WS_SLAB), gw, NGW, lane);
    xcd_barrier(bar);
    for (int u = blockIdx.x; u < NBATCH * BKV * 17; u += G) { const int n = u % 17, bg = u / 17; attn_prompt_unit(lds, QB, KB, VB, args.in[I_SINK], AM, bg >> 2, bg & 3, n, tid, wave, lane); }
    for (int u = (int)blockIdx.x - 32; u >= 0 && u < DECB * BKV; u += G - 32) attn_sample_unit(lds, QB, KB, VB, args.in[I_CKM], args.in[I_CVM], args.in[I_CKW], args.in[I_CVW], args.in[I_SINK], AM, u >> 2, u & 3, tid, wave, lane);
    xcd_barrier(bar);
    { EpiResPlain E{AB2, AB, SSQ, nullptr, (float*)(ws + WS_SLAB), 1.0f, DM / 64}; GEMM_PHASE_TS(EpiResPlain, E, AM, ws + WS_WBO, DM); }
    xcd_barrier(bar);
    resid_combine<false>(lds, AB2, AB, SSQ, RS, (const float*)(ws + WS_SLAB), 1.0f, nullptr, G, wave, gw, NGW, lane);
    xcd_barrier(bar);

    { EpiSwiglu<false> E{ACT, RS}; GEMM_PHASE(EpiSwiglu<false>, E, AB, ws + WS_W1 + 3 * SZ_W1, 2 * DFF, DM); }
    xcd_barrier(bar);
    { EpiResFinal E{AB, AB, SSQ, args.out, (float*)(ws + WS_SLAB), 0.5f, DFF / 64}; GEMM_PHASE_TS(EpiResFinal, E, ACT, ws + WS_W2 + 3 * SZ_W2, DFF); }
    xcd_barrier(bar);
    resid_combine<true>(lds, AB, AB, SSQ, RS, (const float*)(ws + WS_SLAB), 0.5f, args.out, G, wave, gw, NGW, lane);
}

extern "C" void kernel_launch(void* const* d_in, const int* in_sizes, int n_in, void* d_out, int out_size, void* d_ws, size_t ws_size, hipStream_t stream) {
    static int grid = 0;
    if (grid == 0) {
        if (n_in != 25 || (size_t)out_size != O_END || ws_size < WS_END) { fprintf(stderr, "kernel_launch: unexpected shapes (n_in %d, out %d vs %zu, ws %zu vs %zu); nothing launched\n", n_in, out_size, (size_t)O_END, ws_size, (size_t)WS_END); grid = -1; return; }
        int dev = 0, cus = 0, per_cu = 0;
        if (hipGetDevice(&dev) != hipSuccess || hipDeviceGetAttribute(&cus, hipDeviceAttributeMultiprocessorCount, dev) != hipSuccess) { grid = -1; return; }
        if (hipFuncSetAttribute((const void*)yoco_fwd, hipFuncAttributeMaxDynamicSharedMemorySize, LDS_BYTES) != hipSuccess) { fprintf(stderr, "kernel_launch: hipFuncSetAttribute failed\n"); grid = -1; return; }
        if (hipOccupancyMaxActiveBlocksPerMultiprocessor(&per_cu, (const void*)yoco_fwd, NWAVES * 64, LDS_BYTES) != hipSuccess || per_cu < 1) fprintf(stderr, "kernel_launch: occupancy query says %d\n", per_cu);
        (void)hipGetLastError();
        grid = cus;
    }
    if (grid < 0) return;
    (void)in_sizes;
    if (hipMemsetAsync((char*)d_ws + WS_CTL, 0, CTL_ZERO_BYTES, stream) != hipSuccess) return;
    Args a{};
    for (int i = 0; i < 25; ++i) a.in[i] = (const float*)d_in[i];
    a.out = (float*)d_out; a.ws = (unsigned char*)d_ws;
    hipLaunchKernelGGL(yoco_fwd, dim3(grid), dim3(NWAVES * 64), LDS_BYTES, stream, a);
}
```

```cpp
#include <hip/hip_runtime.h>
#include <cstdio>
#include <cstdint>
namespace pg8 {
#define PG8_LAS __attribute__((address_space(3)))
typedef unsigned short bf16_t;
typedef short bf16x8 __attribute__((ext_vector_type(8)));
typedef float f32x4 __attribute__((ext_vector_type(4)));
typedef unsigned u32x4 __attribute__((ext_vector_type(4)));
constexpr int BM = 256, BK = 64, HALF = 128, HTB = HALF * BK * 2  , STAGE_BYTES = 8 * HTB, NXCD = 8, WGM = 4;

__host__ __device__ __forceinline__ int lds_byte(int r, int c) { const int st = (r >> 4) * 2 + (c >> 5), rr = r & 15, cc = c & 31, ob = rr * 64 + cc * 2; return st * 1024 + (ob ^ (((ob >> 9) & 1) << 5)); }
__host__ __device__ __forceinline__ void stage_rc(int b, int& R, int& C) { const int st = b / 1024, sb = b % 1024, swz = sb ^ (((sb >> 9) & 1) << 5); R = (st >> 1) * 16 + swz / 64; C = (st & 1) * 32 + (swz % 64) / 2; }
__host__ __device__ __forceinline__ int perm32(int rho) { const int n = rho >> 4, i = rho & 15; return 8 * (i >> 2) + 4 * n + (i & 3); }

struct Unit { int pm, pn, koff, nt; };
struct Gemm { const bf16_t* A; const bf16_t* Bt; int M, N, K; };

struct StaticOrder {
    int nM, nN, nwg, G, c, nt0;
    __host__ __device__ void init(int M, int N, int G_, int c_) { nM = M / BM; nN = N / BM; nwg = nM * nN; G = G_; c = c_; }
    __host__ __device__ bool next(int i, Unit& u) const {
        const long L = (long)i * G + c; if (L >= nwg) return false;
        int wgid = (int)L; { const int q = nwg / NXCD, r = nwg % NXCD, xcd = wgid % NXCD, off = wgid / NXCD; wgid = (xcd < r ? xcd * (q + 1) : r * (q + 1) + (xcd - r) * q) + off; }
        const int nig = WGM * nN, gid = wgid / nig, fm = gid * WGM, gsz = (nM - fm) < WGM ? (nM - fm) : WGM;
        u.pm = fm + ((wgid % nig) % gsz); u.pn = (wgid % nig) / gsz; u.koff = 0; u.nt = nt0; return true;
    }
    __device__ __forceinline__ void a_ready(const Unit&) const {}
    __device__ __forceinline__ void done(const Unit&) const {}
};

__device__ __forceinline__ unsigned cvt_pk_bf16(float lo, float hi) { unsigned r; asm volatile("v_cvt_pk_bf16_f32 %0, %1, %2" : "=v"(r) : "v"(lo), "v"(hi)); return r; }
typedef float f32x2 __attribute__((ext_vector_type(2)));
template <class Epi, class Sched, bool ALIGN_EPI = false, bool SP2 = false>
__device__ __forceinline__ void gemm_phase(PG8_LAS unsigned char* lds, const Gemm g, const Sched& S, const Epi& E) {
    int tid_l = threadIdx.x; asm volatile("" : "+v"(tid_l));
    const int tid = tid_l, wid = __builtin_amdgcn_readfirstlane(tid >> 6), lane = tid & 63, wr = wid >> 2, wc = wid & 3, fr = lane & 15, fq = lane >> 4;
    const int K = g.K, nt = K / BK;
    unsigned voffA[2], voffB[2];
#pragma unroll
    for (int i = 0; i < 2; ++i) { int R, C; stage_rc(tid * 16 + i * 8192, R, C); const int Rb = Epi::PERM ? ((R & ~31) + perm32(R & 31)) : R;
        voffA[i] = (unsigned)(R * K + C) * 2u; voffB[i] = (unsigned)(Rb * K + C) * 2u; }
    const size_t kstep = (size_t)(BK * 2);
    const size_t hstep = (size_t)HALF * K * 2;
    const size_t tstep = 2 * hstep;
    const unsigned ldsw = (unsigned)wid * 1024u;
    const int aoff = lds_byte(wr * 64 + fr, fq * 8), boff = lds_byte(wc * 32 + fr, fq * 8);
#define PG8_SA(b, h) (((b) * 2 + (h)) * HTB)
#define PG8_SB(b, h) ((4 + (b) * 2 + (h)) * HTB)
#define PG8_STAGE(bufoff, gbase, voff) do { _Pragma("unroll") for (int _i = 0; _i < 2; ++_i) \
        __builtin_amdgcn_global_load_lds((const unsigned*)((const char*)(gbase) + (voff)[_i]), (PG8_LAS unsigned*)(lds + (bufoff) + ldsw + _i * 8192), 16, 0, 0); } while (0)
#define PG8_LDA(dst, b, h) do { _Pragma("unroll") for (int m = 0; m < 4; ++m) _Pragma("unroll") for (int k = 0; k < 2; ++k) dst[m][k] = *(const PG8_LAS bf16x8*)(lds + PG8_SA(b, h) + aoff + m * 2048 + k * 1024); } while (0)
#define PG8_LDB(dst, b, h) do { _Pragma("unroll") for (int n = 0; n < 2; ++n) _Pragma("unroll") for (int k = 0; k < 2; ++k) dst[n][k] = *(const PG8_LAS bf16x8*)(lds + PG8_SB(b, h) + boff + n * 2048 + k * 1024); } while (0)
#define PG8_MMA(ai, bj, At, Bt) do { __builtin_amdgcn_s_setprio(1); _Pragma("unroll") for (int m = 0; m < 4; ++m) _Pragma("unroll") for (int n = 0; n < 2; ++n) _Pragma("unroll") for (int k = 0; k < 2; ++k) \
        acc[ai][bj][m][n] = __builtin_amdgcn_mfma_f32_16x16x32_bf16(Bt[n][k], At[m][k], acc[ai][bj][m][n], 0, 0, 0); __builtin_amdgcn_s_setprio(0); } while (0)
#define PG8_WAIT_V(n) asm volatile("s_waitcnt vmcnt(" #n ")" ::: "memory")
#define PG8_WAIT_L(n) asm volatile("s_waitcnt lgkmcnt(" #n ")" ::: "memory")
#define PG8_BAR __builtin_amdgcn_s_barrier()
#define PG8_SCHED __builtin_amdgcn_sched_barrier(0)
    Unit cur, nxt; int ui = 0;
    if (!S.next(0, cur)) return;
    f32x4 acc[2][2][4][2];
#pragma unroll
    for (int a = 0; a < 2; ++a)
#pragma unroll
        for (int b = 0; b < 2; ++b)
#pragma unroll
            for (int m = 0; m < 4; ++m)
#pragma unroll
                for (int n = 0; n < 2; ++n) acc[a][b][m][n] = (f32x4){0.f, 0.f, 0.f, 0.f};
    bf16x8 At[4][2], B0[2][2], B1[2][2];
    const char* cA = (const char*)g.A + (size_t)cur.pm * tstep + cur.koff; const char* cB = (const char*)g.Bt + (size_t)cur.pn * tstep + cur.koff;
    S.a_ready(cur);
    if constexpr (SP2) {
        PG8_STAGE(PG8_SB(0, 0), cB, voffB); PG8_STAGE(PG8_SB(0, 1), cB + hstep, voffB); PG8_STAGE(PG8_SA(0, 0), cA, voffA); PG8_STAGE(PG8_SA(0, 1), cA + hstep, voffA);
        if (wr == 1) PG8_BAR;
        PG8_WAIT_V(2); PG8_BAR;
        PG8_STAGE(PG8_SB(1, 0), cB + kstep, voffB); PG8_STAGE(PG8_SA(1, 0), cA + kstep, voffA); PG8_STAGE(PG8_SB(1, 1), cB + hstep + kstep, voffB);
        PG8_WAIT_V(6); PG8_BAR;
    } else {
        PG8_STAGE(PG8_SB(0, 0), cB, voffB); PG8_STAGE(PG8_SA(0, 0), cA, voffA); PG8_STAGE(PG8_SB(0, 1), cB + hstep, voffB); PG8_STAGE(PG8_SA(0, 1), cA + hstep, voffA);
        if (wr == 1) PG8_BAR;
        PG8_WAIT_V(4); PG8_BAR;
        PG8_STAGE(PG8_SB(1, 0), cB + kstep, voffB); PG8_STAGE(PG8_SA(1, 0), cA + kstep, voffA); PG8_STAGE(PG8_SB(1, 1), cB + hstep + kstep, voffB);
        PG8_WAIT_V(6); PG8_BAR;
    }
    for (;;) {
        const bool has_next = S.next(ui + 1, nxt);
        const char* nA = has_next ? (const char*)g.A + (size_t)nxt.pm * tstep + nxt.koff : cA; const char* nB = has_next ? (const char*)g.Bt + (size_t)nxt.pn * tstep + nxt.koff : cB;
        for (int t = 0; t < cur.nt; t += 2) {
            const bool last = (t == cur.nt - 2);
            const char* a1 = cA + (size_t)(t + 1) * kstep;
            const char* a2 = last ? nA : cA + (size_t)(t + 2) * kstep; const char* b2 = last ? nB : cB + (size_t)(t + 2) * kstep;
            const char* a3 = a2 + kstep; const char* b3 = b2 + kstep;
            if (last && has_next) S.a_ready(nxt);
            if constexpr (SP2) {
            PG8_LDB(B0, 0, 0); PG8_LDB(B1, 0, 1); PG8_SCHED; PG8_LDA(At, 0, 0); PG8_STAGE(PG8_SA(1, 1), a1 + hstep, voffA);
            PG8_WAIT_V(8); PG8_WAIT_L(0); PG8_BAR; PG8_MMA(0, 0, At, B0); PG8_MMA(0, 1, At, B1); PG8_BAR; PG8_SCHED;
            PG8_LDA(At, 0, 1); PG8_STAGE(PG8_SB(0, 0), b2, voffB); PG8_STAGE(PG8_SB(0, 1), b2 + hstep, voffB); PG8_STAGE(PG8_SA(0, 0), a2, voffA);
            PG8_WAIT_V(8); PG8_WAIT_L(0); PG8_BAR; PG8_MMA(1, 0, At, B0); PG8_MMA(1, 1, At, B1); PG8_BAR; PG8_SCHED;
            PG8_LDB(B0, 1, 0); PG8_LDB(B1, 1, 1); PG8_SCHED; PG8_LDA(At, 1, 0); PG8_STAGE(PG8_SA(0, 1), a2 + hstep, voffA);
            PG8_WAIT_V(8); PG8_WAIT_L(0); PG8_BAR; PG8_MMA(0, 0, At, B0); PG8_MMA(0, 1, At, B1); PG8_BAR; PG8_SCHED;
            PG8_LDA(At, 1, 1); PG8_STAGE(PG8_SB(1, 0), b3, voffB); PG8_STAGE(PG8_SB(1, 1), b3 + hstep, voffB); PG8_STAGE(PG8_SA(1, 0), a3, voffA);
            PG8_WAIT_V(8); PG8_WAIT_L(0); PG8_BAR; PG8_MMA(1, 0, At, B0); PG8_MMA(1, 1, At, B1); PG8_BAR; PG8_SCHED;
            } else {
            PG8_LDB(B0, 0, 0); PG8_SCHED; PG8_LDA(At, 0, 0); PG8_STAGE(PG8_SA(1, 1), a1 + hstep, voffA);
            PG8_WAIT_L(8); PG8_BAR; PG8_WAIT_L(0); PG8_MMA(0, 0, At, B0); PG8_BAR; PG8_SCHED;
            PG8_LDB(B1, 0, 1); PG8_STAGE(PG8_SB(0, 0), b2, voffB);
            PG8_BAR; PG8_WAIT_L(0); PG8_MMA(0, 1, At, B1); PG8_BAR;
            PG8_LDA(At, 0, 1); PG8_STAGE(PG8_SA(0, 0), a2, voffA);
            PG8_BAR; PG8_WAIT_L(0); PG8_MMA(1, 0, At, B0); PG8_BAR; PG8_SCHED;
            PG8_STAGE(PG8_SB(0, 1), b2 + hstep, voffB);
            PG8_WAIT_V(6); PG8_BAR; PG8_MMA(1, 1, At, B1); PG8_BAR;
            PG8_LDB(B0, 1, 0); PG8_SCHED; PG8_LDA(At, 1, 0); PG8_STAGE(PG8_SA(0, 1), a2 + hstep, voffA);
            PG8_WAIT_L(8); PG8_BAR; PG8_WAIT_L(0); PG8_MMA(0, 0, At, B0); PG8_BAR; PG8_SCHED;
            PG8_LDB(B1, 1, 1); PG8_STAGE(PG8_SB(1, 0), b3, voffB);
            PG8_BAR; PG8_WAIT_L(0); PG8_MMA(0, 1, At, B1); PG8_BAR;
            PG8_LDA(At, 1, 1); PG8_STAGE(PG8_SA(1, 0), a3, voffA);
            PG8_BAR; PG8_WAIT_L(0); PG8_MMA(1, 0, At, B0); PG8_BAR; PG8_SCHED;
            PG8_STAGE(PG8_SB(1, 1), b3 + hstep, voffB);
            PG8_WAIT_V(6); PG8_BAR; PG8_MMA(1, 1, At, B1); PG8_BAR;
            }
        }
        if constexpr (ALIGN_EPI) { if (wr == 0) PG8_BAR; }
        if constexpr (!Epi::AFTER_DRAIN) { E(acc, cur, wr, wc, fr, fq); S.done(cur); }
        if (!has_next) break;
#pragma unroll
        for (int a = 0; a < 2; ++a)
#pragma unroll
            for (int b = 0; b < 2; ++b)
#pragma unroll
                for (int m = 0; m < 4; ++m)
#pragma unroll
                    for (int n = 0; n < 2; ++n) acc[a][b][m][n] = (f32x4){0.f, 0.f, 0.f, 0.f};
        cur = nxt; cA = nA; cB = nB; ++ui;
        if constexpr (ALIGN_EPI) { if (wr == 1) PG8_BAR; }
    }
    PG8_WAIT_V(0);
    if constexpr (!ALIGN_EPI) { if (wr == 0) PG8_BAR; }
    PG8_BAR;
    if constexpr (Epi::AFTER_DRAIN) { E.fused(acc, cur, wr, wc, fr, fq, lds, wid, lane); S.done(cur); }
#undef PG8_SA
#undef PG8_SB
#undef PG8_STAGE
#undef PG8_LDA
#undef PG8_LDB
#undef PG8_MMA
#undef PG8_WAIT_V
#undef PG8_WAIT_L
#undef PG8_BAR
#undef PG8_SCHED
}
}

constexpr int NWAVES = 8;
constexpr int DM = 2048, DFF = 5632, NBATCH = 8, SEQ = 2048, NMETA = 16, TP = SEQ + NMETA;
constexpr int DECB = 128, DECS = 4, MPR = NBATCH * TP  , MSM = DECB * DECS  , MREAL = MPR + MSM  , MP = 17152  ;
constexpr int AH = 4, ADK = 256, ADV = 512, NAIN = 6144, NAIN_PAD = 6400;
constexpr int BH = 32, BDH = 64, BKV = 4, WIN = 128;
constexpr float EPS = 1e-6f;

constexpr size_t MiB = 1u << 20;
constexpr size_t WS_CTL = 0, CTL_ZERO_BYTES = 1 * MiB;
constexpr size_t SZ_W1 = (size_t)2 * DFF * DM * 2, SZ_W2 = (size_t)DM * DFF * 2;
constexpr size_t WS_W1 = 1 * MiB;
constexpr size_t WS_W2 = WS_W1 + 4 * SZ_W1;
constexpr size_t WS_WAIN = WS_W2 + 4 * SZ_W2;
constexpr size_t WS_WAOUT = WS_WAIN + (size_t)NAIN_PAD * DM * 2;
constexpr size_t WS_WKV = WS_WAOUT + (size_t)DM * DM * 2;
constexpr size_t WS_WQ = WS_WKV + (size_t)512 * DM * 2;
constexpr size_t WS_WBO = WS_WQ + (size_t)DM * DM * 2;
constexpr size_t WS_H = WS_WBO + (size_t)DM * DM * 2;
constexpr size_t WS_AB = WS_H + (size_t)MP * DM * 4;
constexpr size_t WS_ACT = WS_AB + (size_t)MP * DM * 2;
constexpr size_t WS_QKVO = WS_ACT + (size_t)MP * DFF * 2;
constexpr size_t WS_HM = WS_QKVO + (size_t)MP * NAIN * 2;
constexpr size_t WS_AM = WS_HM + (size_t)MP * DM * 4;
constexpr size_t WS_QB = WS_HM;
constexpr size_t WS_KB = WS_AM + (size_t)MP * DM * 2;
constexpr size_t WS_VB = WS_KB + (size_t)MP * 256 * 2;
constexpr size_t WS_SSQ = WS_VB + (size_t)MP * 256 * 2;
constexpr size_t WS_HSSQ = WS_SSQ + (size_t)MP * 32 * 4;
constexpr size_t WS_GATES = WS_HSSQ + (size_t)MP * 32 * 4;
constexpr size_t WS_PF = WS_GATES + (size_t)MP * 8 * 4;
constexpr size_t WS_GA = WS_PF + (size_t)32 * 17 * 8 * 4 * 1024;
constexpr size_t WS_SLAB = WS_GA + (size_t)32 * 17 * 512 * 4;
constexpr size_t WS_AB2 = WS_SLAB + (size_t)24 * 4 * 65536 * 4;
constexpr size_t WS_SSQ2 = WS_AB2 + (size_t)MP * DM * 2;
constexpr size_t WS_RS = WS_SSQ2 + (size_t)MP * 32 * 4;
constexpr size_t WS_RS2 = WS_RS + (size_t)MP * 4;
constexpr size_t WS_END = WS_RS2 + (size_t)MP * 4;
constexpr int CW_BAR = 4096;
constexpr int CW_SQ = 7680;

constexpr size_t O_YP = 0, O_YS = O_YP + (size_t)NBATCH * SEQ * DM, O_CP = O_YS + (size_t)MSM * DM, O_NP = O_CP + (size_t)NBATCH * AH * ADK * ADV,
                 O_MP = O_NP + NBATCH * AH * ADK, O_KMP = O_MP + NBATCH * AH, O_VMP = O_KMP + NBATCH * NMETA * 256, O_KWP = O_VMP + NBATCH * NMETA * 256,
                 O_VWP = O_KWP + NBATCH * WIN * 256, O_CS = O_VWP + NBATCH * WIN * 256, O_NS = O_CS + (size_t)DECB * AH * ADK * ADV, O_MS = O_NS + DECB * AH * ADK,
                 O_KWS = O_MS + DECB * AH, O_VWS = O_KWS + (size_t)DECB * WIN * 256, O_END = O_VWS + (size_t)DECB * WIN * 256;

constexpr int SCR_BYTES = 143360;
constexpr int MISC_OFF = SCR_BYTES;
constexpr int LDS_BYTES = 147456;

#define GAS __attribute__((address_space(1)))
#define LAS __attribute__((address_space(3)))
typedef unsigned short bf16;
typedef unsigned v4u __attribute__((ext_vector_type(4)));
typedef unsigned v2u __attribute__((ext_vector_type(2)));
typedef float f32x4 __attribute__((ext_vector_type(4)));
typedef short bf16x8 __attribute__((ext_vector_type(8)));
#define LDS_WAIT() asm volatile("s_waitcnt lgkmcnt(0)" ::: "memory")
#define MFMA16(a, b, c) __builtin_amdgcn_mfma_f32_16x16x32_bf16((a), (b), (c), 0, 0, 0)
typedef __bf16 bf16n2 __attribute__((ext_vector_type(2)));
typedef float f32n2 __attribute__((ext_vector_type(2)));
__device__ __forceinline__ unsigned pk2(float lo, float hi) { const f32n2 v = {lo, hi}; return __builtin_bit_cast(unsigned, __builtin_convertvector(v, bf16n2)); }
__device__ __forceinline__ unsigned pk2m(float lo, float hi) { return pk2(lo, hi); }
__device__ __forceinline__ bf16 bf16_rne(float x) { return (bf16)(pk2(x, 0.f) & 0xffffu); }
__device__ __forceinline__ float bflo(unsigned w) { return __uint_as_float(w << 16); }
__device__ __forceinline__ float bfhi(unsigned w) { return __uint_as_float(w & 0xffff0000u); }
__device__ __forceinline__ unsigned bfel(const v4u& r, int e) { return (r[e >> 1] >> (16 * (e & 1))) & 0xffffu; }
__device__ __forceinline__ float wave_sum(float v) {
#pragma unroll
    for (int o = 1; o < 64; o <<= 1) v += __shfl_xor(v, o);
    return v;
}
#define XB_TMO      128
#define XB_XCNT(j)  (256  + 64 * (j))
#define XB_XSUB(j)  (1280 + 64 * (j))
#define XB_XGEN(j)  (2304 + 64 * (j))
#define XB_TOP      3328
#define XB_TOPGEN   3392
#define XCD_BAR_WORDS 3456
#define XB_SPIN_CAP (1u << 18)

__device__ __forceinline__ unsigned xb_ld(unsigned* p)              { return __hip_atomic_load(p, __ATOMIC_RELAXED, __HIP_MEMORY_SCOPE_AGENT); }
__device__ __forceinline__ unsigned xb_add(unsigned* p, unsigned v) { return __hip_atomic_fetch_add(p, v, __ATOMIC_RELAXED, __HIP_MEMORY_SCOPE_AGENT); }
__device__ __forceinline__ unsigned xb_xcc_id() { return (unsigned)__builtin_amdgcn_s_getreg((3 << 11) | 20) & 0xFu; }
#define XB_SPIN(cond, bar) do { unsigned _sp = 0; while (cond) { __builtin_amdgcn_s_sleep(1); \
    if ((++_sp & 255u) == 0u) { if (xb_ld(&(bar)[XB_TMO])) break; if (_sp > XB_SPIN_CAP) { atomicAdd(&(bar)[XB_TMO], 1u); break; } } } } while (0)

struct XcdBarrier {
    unsigned* bar; unsigned x;
    volatile LAS unsigned* st;
};

__device__ __forceinline__ XcdBarrier xcd_barrier_post(unsigned* bar, volatile LAS unsigned* st) {
    XcdBarrier b; b.bar = bar; b.x = xb_xcc_id(); b.st = st;
    if (threadIdx.x == 0) (void)xb_add(&bar[XB_XCNT(b.x)], 1u);
    return b;
}
__device__ __forceinline__ void xcd_barrier_complete(unsigned* bar, unsigned x, unsigned& nloc, unsigned& nx) {
    const unsigned G = gridDim.x * gridDim.y * gridDim.z;
    unsigned sum, cnt, mine, sp = 0u;
    for (;;) {
        sum = 0u; cnt = 0u; mine = 0u;
#pragma unroll
        for (unsigned j = 0; j < 16; ++j) { const unsigned c = xb_ld(&bar[XB_XCNT(j)]); sum += c; cnt += (c > 0u) ? 1u : 0u; mine = (j == x) ? c : mine; }
        if (sum == G) break;
        __builtin_amdgcn_s_sleep(1);
        if ((++sp & 255u) == 0u) { if (xb_ld(&bar[XB_TMO])) break; if (sp > XB_SPIN_CAP) { atomicAdd(&bar[XB_TMO], 1u); break; } }
    }
    nloc = mine > 0u ? mine : 1u; nx = cnt > 0u ? cnt : 1u;
}

__device__ __forceinline__ void xcd_barrier(const XcdBarrier& b) {
    asm volatile("s_waitcnt vmcnt(0)" ::: "memory");
    __syncthreads();
    if (threadIdx.x == 0) {
        unsigned* bar = b.bar;
        __builtin_amdgcn_s_waitcnt(0);
        unsigned nloc = b.st[0], nx = b.st[1];
        if (nloc == 0u) { xcd_barrier_complete(bar, b.x, nloc, nx); b.st[0] = nloc; b.st[1] = nx; }
        const unsigned old = xb_add(&bar[XB_XSUB(b.x)], 1u);
        const unsigned gen = old / nloc;
        if (old + 1u == (gen + 1u) * nloc) {
            __builtin_amdgcn_fence(__ATOMIC_RELEASE, "agent");
            asm volatile("s_waitcnt vmcnt(0)" ::: "memory");
            const unsigned og = xb_add(&bar[XB_TOP], 1u);
            const unsigned tg = og / nx;
            if (og + 1u == (tg + 1u) * nx) xb_add(&bar[XB_TOPGEN], 1u);
            else XB_SPIN(xb_ld(&bar[XB_TOPGEN]) == tg, bar);
            __builtin_amdgcn_fence(__ATOMIC_ACQUIRE, "agent");
            xb_add(&bar[XB_XGEN(b.x)], 1u);
            asm volatile("s_waitcnt vmcnt(0)" ::: "memory");
        } else {
            XB_SPIN(xb_ld(&bar[XB_XGEN(b.x)]) == gen, bar);
            __builtin_amdgcn_fence(__ATOMIC_ACQUIRE, "agent");
            asm volatile("s_waitcnt vmcnt(0)" ::: "memory");
        }
    }
    __syncthreads();
}

constexpr int CW_TMO = 0;
constexpr int CW_Q = 8192;
constexpr int CW_CNT = 16384, CNT_STRIDE = 80;
static_assert((CW_CNT + 13 * CNT_STRIDE * 64) * 4 <= (int)CTL_ZERO_BYTES && CW_Q + 13 * 8 * 64 <= CW_CNT, "CTL map");
#define FLOW_NONE 0xffffffffu
struct FlowOrder {
    int nM, nN, nwg, x; unsigned* q; const unsigned* dep; unsigned need; unsigned* pub; unsigned* tmo; volatile LAS unsigned* slot;
    static constexpr int MID_T = 4;
    int pend_pm; unsigned pend_t; int pend_kind;
    __device__ __forceinline__ void init(int N, unsigned xcc, unsigned* ctl, int phase, int dep_bank, unsigned need_, int pub_bank, volatile LAS unsigned* slot_) {
        nM = MP / 256; nN = N / 256; nwg = nM * nN; x = (int)(xcc & 7u); q = ctl + CW_Q + phase * 8 * 64;
        dep = dep_bank >= 0 ? ctl + CW_CNT + dep_bank * CNT_STRIDE * 64 : nullptr; need = need_;
        pub = pub_bank >= 0 ? ctl + CW_CNT + pub_bank * CNT_STRIDE * 64 : nullptr; tmo = ctl + CW_TMO; slot = slot_; pend_pm = -1; pend_t = 0u; pend_kind = 0; }
    __device__ __forceinline__ int lstart(int xx) const { const int q_ = nwg / 8, r = nwg % 8; return xx < r ? xx * (q_ + 1) : r * (q_ + 1) + (xx - r) * q_; }
    __device__ __forceinline__ unsigned lcount(int xx) const { return (unsigned)(nwg / 8 + (xx < nwg % 8 ? 1 : 0)); }
    static constexpr int WG = 2;
    __device__ __forceinline__ void decode(unsigned wgid, pg8::Unit& u) const { const int w = (int)wgid, nig = WG * nN, gid = w / nig, fm = gid * WG, gsz = (nM - fm) < WG ? (nM - fm) : WG;
        u.pm = fm + ((w % nig) % gsz); u.pn = (w % nig) / gsz; }
    __device__ __forceinline__ unsigned take(int xx) const { unsigned t = 0; if ((threadIdx.x & 63) == 0) t = __hip_atomic_fetch_add(q + 64 * xx, 1u, __ATOMIC_RELAXED, __HIP_MEMORY_SCOPE_AGENT);
        t = (unsigned)__builtin_amdgcn_readfirstlane((int)t); return t < lcount(xx) ? (unsigned)lstart(xx) + t : FLOW_NONE; }
    __device__ __forceinline__ unsigned steal() const {
        for (int k = 1; k < 8; ++k) { const int xx = (x + k) & 7;
            const unsigned h = (unsigned)__builtin_amdgcn_readfirstlane((int)__hip_atomic_load(q + 64 * xx, __ATOMIC_RELAXED, __HIP_MEMORY_SCOPE_AGENT)); if (h >= lcount(xx)) continue;
            const unsigned id = take(xx); if (id != FLOW_NONE) return id; }
        return FLOW_NONE; }
    __device__ __forceinline__ unsigned claim_blocking() const {
        if (__builtin_amdgcn_readfirstlane((int)slot[3]) == 0) { const unsigned id = take(x); if (id != FLOW_NONE) return id; if ((threadIdx.x & 63) == 0) slot[3] = 1u; }
        return steal(); }
    __device__ __forceinline__ void begin() const {
        if (threadIdx.x < 64) {
            if (threadIdx.x == 0) { slot[3] = 0u; slot[5] = 0u; }
            const unsigned u0 = claim_blocking(); const unsigned u1 = u0 != FLOW_NONE ? claim_blocking() : FLOW_NONE;
            if (threadIdx.x == 0) { slot[0] = u0; slot[1] = u1; slot[4] = 2u; if (u1 == FLOW_NONE) slot[5] = 1u; } }
        asm volatile("s_waitcnt lgkmcnt(0)" ::: "memory"); __builtin_amdgcn_s_barrier(); asm volatile("" ::: "memory"); }
    __device__ __forceinline__ bool peek(int i, pg8::Unit& u) const { const unsigned id = (unsigned)__builtin_amdgcn_readfirstlane((int)slot[i % 3]); if (id == FLOW_NONE) return false; decode(id, u); return true; }
    __device__ __forceinline__ void a_ready(const pg8::Unit& u, int prev_pm) const {
        if (dep == nullptr || u.pm == prev_pm) return;
        if (threadIdx.x < 64) {
            const unsigned long long t0 = __builtin_amdgcn_s_memrealtime(); unsigned polls = 0;
            while ((unsigned)__builtin_amdgcn_readfirstlane((int)__hip_atomic_load(dep + 64 * u.pm, __ATOMIC_RELAXED, __HIP_MEMORY_SCOPE_AGENT)) < need) {
                if ((++polls & 255u) == 0u && __builtin_amdgcn_readfirstlane((int)__hip_atomic_load(tmo, __ATOMIC_RELAXED, __HIP_MEMORY_SCOPE_AGENT)) != 0) break;
                if (__builtin_amdgcn_s_memrealtime() - t0 > 2000000ull) {
                    if (threadIdx.x == 0) { unsigned expect = 0u; __hip_atomic_compare_exchange_strong(tmo + 1, &expect, 0x600u | (unsigned)(u.pm & 0xff), __ATOMIC_RELAXED, __ATOMIC_RELAXED, __HIP_MEMORY_SCOPE_AGENT); __hip_atomic_store(tmo, 1u, __ATOMIC_RELAXED, __HIP_MEMORY_SCOPE_AGENT); }
                    break; }
                __builtin_amdgcn_s_sleep(2); }
            __builtin_amdgcn_fence(__ATOMIC_ACQUIRE, "agent");
            asm volatile("s_waitcnt vmcnt(0)" ::: "memory");
        }
        asm volatile("" ::: "memory"); __builtin_amdgcn_s_barrier(); asm volatile("" ::: "memory"); }
    __device__ __forceinline__ void done(const pg8::Unit& u) {
        if (pub) pend_pm = u.pm;
        if (threadIdx.x < 64) {
            const bool all_empty = __builtin_amdgcn_readfirstlane((int)slot[5]) != 0, own_empty = __builtin_amdgcn_readfirstlane((int)slot[3]) != 0;
            pend_kind = all_empty ? 0 : (own_empty ? 2 : 1);
            if (pend_kind == 1 && threadIdx.x == 0) pend_t = __hip_atomic_fetch_add(q + 64 * x, 1u, __ATOMIC_RELAXED, __HIP_MEMORY_SCOPE_AGENT); } }
    __device__ __forceinline__ void mid() {
        if (pend_pm < 0 && pend_kind == 0) return;
        asm volatile("s_waitcnt vmcnt(0)" ::: "memory");
        if (pend_pm >= 0) { if ((threadIdx.x & 63) == 0) __hip_atomic_fetch_add(pub + 64 * pend_pm, 1u, __ATOMIC_RELAXED, __HIP_MEMORY_SCOPE_AGENT); pend_pm = -1; }
        if (threadIdx.x < 64 && pend_kind != 0) {
            unsigned id = FLOW_NONE;
            if (pend_kind == 1) { const unsigned t = (unsigned)__builtin_amdgcn_readfirstlane((int)pend_t); if (t < lcount(x)) id = (unsigned)lstart(x) + t; else { if (threadIdx.x == 0) slot[3] = 1u; id = steal(); } }
            else id = steal();
            if (id == FLOW_NONE && threadIdx.x == 0) slot[5] = 1u;
            const unsigned ci = (unsigned)__builtin_amdgcn_readfirstlane((int)slot[4]);
            if (threadIdx.x == 0) { slot[ci % 3u] = id; slot[4] = ci + 1u; }
            pend_kind = 0; } }
    __device__ __forceinline__ void flush() {
        if (pend_pm >= 0) { if ((threadIdx.x & 63) == 0) __hip_atomic_fetch_add(pub + 64 * pend_pm, 1u, __ATOMIC_RELAXED, __HIP_MEMORY_SCOPE_AGENT); pend_pm = -1; } }
};
template <bool WT> __device__ __forceinline__ void st_b128(void* p, const v4u& v) { if constexpr (WT) asm volatile("global_store_dwordx4 %0, %1, off sc1" :: "v"(p), "v"(v) : "memory"); else *(v4u*)p = v; }
template <bool WT> __device__ __forceinline__ void st_b32(void* p, float v) { if constexpr (WT) asm volatile("global_store_dword %0, %1, off sc1" :: "v"(p), "v"(v) : "memory"); else *(float*)p = v; }

__device__ __forceinline__ void row_rscale8(const float* rs, int row0, float (&r8)[8]) {
#pragma unroll
    for (int ai = 0; ai < 2; ++ai)
#pragma unroll
        for (int m = 0; m < 4; ++m) r8[ai * 4 + m] = rs[row0 + ai * 128 + m * 16];
}
__device__ __forceinline__ float silu_f(float g) { return g * __builtin_amdgcn_rcpf(1.0f + __expf(-g)); }

typedef float f32x2 __attribute__((ext_vector_type(2)));
template <bool WT> struct EpiSwiglu {
    static constexpr bool PERM = true, AFTER_DRAIN = false;
    bf16* O; const float* rs;
    __device__ __forceinline__ void operator()(const f32x4 (&acc)[2][2][4][2], const pg8::Unit& u, int wr, int wc, int fr, int fq) const {
        const int row0 = u.pm * 256 + wr * 64 + fr, col0 = u.pn * 128 + wc * 32 + 8 * fq;
        float r8[8]; row_rscale8(rs, row0, r8);
#pragma unroll
        for (int ai = 0; ai < 2; ++ai)
#pragma unroll
            for (int m = 0; m < 4; ++m) {
                const int row = row0 + ai * 128 + m * 16;
                const float r1 = r8[ai * 4 + m] * 1.4426950408889634f, r2 = r8[ai * 4 + m] * 0.6931471805599453f;
                f32x2 o[4];
#pragma unroll
                for (int n = 0; n < 2; ++n)
#pragma unroll
                    for (int jp = 0; jp < 2; ++jp) {
                        const f32x2 g2 = (f32x2){acc[ai][0][m][n][2 * jp], acc[ai][0][m][n][2 * jp + 1]}, u2 = (f32x2){acc[ai][1][m][n][2 * jp], acc[ai][1][m][n][2 * jp + 1]};
                        const f32x2 t2 = g2 * r1;
                        f32x2 d2 = (f32x2){__builtin_amdgcn_exp2f(-t2.x), __builtin_amdgcn_exp2f(-t2.y)} + 1.0f;
                        const f32x2 s2 = (f32x2){__builtin_amdgcn_rcpf(d2.x), __builtin_amdgcn_rcpf(d2.y)};
                        o[2 * n + jp] = (t2 * s2) * (u2 * r2);
                    }
                v4u w; w.x = pk2(o[0].x, o[0].y); w.y = pk2(o[1].x, o[1].y); w.z = pk2(o[2].x, o[2].y); w.w = pk2(o[3].x, o[3].y);
                st_b128<WT>(O + (size_t)row * DFF + col0, w);
            }
    }
};
constexpr int TS_PM0 = 64, TS_PARTS = 4, TS_TILES = 24;
static_assert((DFF / TS_PARTS) % 128 == 0 && (DM / TS_PARTS) % 128 == 0, "split-K part depth");
typedef float f32x8 __attribute__((ext_vector_type(8)));
template <bool FINAL, bool WT> struct EpiResid {
    static constexpr bool PERM = true, AFTER_DRAIN = false;
    const bf16* HI; bf16* AB; float* ssq; float* out; float* slab; float sc; int nt_full;
    __device__ __forceinline__ void operator()(const f32x4 (&acc)[2][2][4][2], const pg8::Unit& u, int wr, int wc, int fr, int fq) const {
        const int row0 = u.pm * 256 + wr * 64 + fr, col0 = u.pn * 256 + wc * 32 + 8 * fq;
        if (u.nt != nt_full) {
            float* sp = slab + (size_t)((((u.pm - TS_PM0) * 8 + u.pn) * TS_PARTS) + u.koff / (u.nt * 128)) * 65536 + (size_t)(wr * 64 + fr) * 256 + wc * 32 + 8 * fq;
#pragma unroll
            for (int ai = 0; ai < 2; ++ai)
#pragma unroll
                for (int m = 0; m < 4; ++m)
#pragma unroll
                    for (int bj = 0; bj < 2; ++bj) { float* q = sp + (ai * 128 + m * 16) * 256 + bj * 128; *(f32x4*)q = acc[ai][bj][m][0]; *(f32x4*)(q + 4) = acc[ai][bj][m][1]; }
            return; }
        f32x8 ssv = (f32x8){0.f, 0.f, 0.f, 0.f, 0.f, 0.f, 0.f, 0.f};
#pragma unroll
        for (int ai = 0; ai < 2; ++ai) {
            v4u hbv[4][2];
#pragma unroll
            for (int m = 0; m < 4; ++m)
#pragma unroll
                for (int bj = 0; bj < 2; ++bj) hbv[m][bj] = *(const v4u*)(HI + (size_t)(row0 + ai * 128 + m * 16) * DM + col0 + bj * 128);
#pragma unroll
            for (int m = 0; m < 4; ++m) {
                const int row = row0 + ai * 128 + m * 16;
                float ss = 0.f;
                float* op = nullptr;
                if (FINAL) {
                    if (row < MPR) { const int b = row / TP, t = row - b * TP; if (t >= NMETA) op = out + O_YP + ((size_t)b * SEQ + (t - NMETA)) * DM + col0; }
                    else if (row < MREAL) op = out + O_YS + (size_t)(row - MPR) * DM + col0;
                }
#pragma unroll
                for (int bj = 0; bj < 2; ++bj) {
                    const v4u hb = hbv[m][bj];
                    const f32x4 h0 = (f32x4){bflo(hb.x), bfhi(hb.x), bflo(hb.y), bfhi(hb.y)}, h1 = (f32x4){bflo(hb.z), bfhi(hb.z), bflo(hb.w), bfhi(hb.w)};
                    const f32x4 n0 = h0 + acc[ai][bj][m][0] * sc, n1 = h1 + acc[ai][bj][m][1] * sc;
                    if (FINAL) { if (op) { *(f32x4*)(op + bj * 128) = n0; *(f32x4*)(op + bj * 128 + 4) = n1; } }
                    else {
                        v4u w; w.x = pk2(n0[0], n0[1]); w.y = pk2(n0[2], n0[3]); w.z = pk2(n1[0], n1[1]); w.w = pk2(n1[2], n1[3]);
                        st_b128<WT>(AB + (size_t)row * DM + col0 + bj * 128, w);
                        ss += (n0[0] * n0[0] + n0[1] * n0[1]) + (n0[2] * n0[2] + n0[3] * n0[3]) + (n1[0] * n1[0] + n1[1] * n1[1]) + (n1[2] * n1[2] + n1[3] * n1[3]);
                    }
                }
                ssv[ai * 4 + m] = ss;
            }
        }
        if (!FINAL) {
#pragma unroll
            for (int i = 0; i < 8; ++i) ssv[i] += __shfl_xor(ssv[i], 16);
#pragma unroll
            for (int i = 0; i < 8; ++i) ssv[i] += __shfl_xor(ssv[i], 32);
            if (fq == 0) {
#pragma unroll
                for (int i = 0; i < 8; ++i) st_b32<WT>(ssq + (size_t)(row0 + (i >> 2) * 128 + (i & 3) * 16) * 32 + u.pn * 4 + wc, ssv[i]); }
        }
    }
};
struct EpiQkvo {
    static constexpr bool PERM = true, AFTER_DRAIN = false;
    bf16* O; const float* rs; float* gates; const float* bias;
    __device__ __forceinline__ void operator()(const f32x4 (&acc)[2][2][4][2], const pg8::Unit& u, int wr, int wc, int fr, int fq) const {
        const int row0 = u.pm * 256 + wr * 64 + fr, col0 = u.pn * 256 + wc * 32 + 8 * fq;
        const bool gate_tile = (u.pn == NAIN / 256);
        float r8[8]; row_rscale8(rs, row0, r8);
#pragma unroll
        for (int i = 0; i < 8; ++i) asm volatile("" : "+v"(r8[i]));
#pragma unroll
        for (int ai = 0; ai < 2; ++ai)
#pragma unroll
            for (int m = 0; m < 4; ++m) {
                const int row = row0 + ai * 128 + m * 16;
                const float r = r8[ai * 4 + m];
                if (!gate_tile) {
#pragma unroll
                    for (int bj = 0; bj < 2; ++bj) { const f32x4 v0 = acc[ai][bj][m][0] * r, v1 = acc[ai][bj][m][1] * r;
                        v4u w; w.x = pk2(v0[0], v0[1]); w.y = pk2(v0[2], v0[3]); w.z = pk2(v1[0], v1[1]); w.w = pk2(v1[2], v1[3]);
                        *(v4u*)(O + (size_t)row * NAIN + col0 + bj * 128) = w; }
                } else if (wc == 0 && fq == 0) {
                    const f32x4 bi = *(const f32x4*)bias, bf = *(const f32x4*)(bias + 4);
                    const f32x4 xi = acc[ai][0][m][0] * r + bi, xf = acc[ai][0][m][1] * r + bf;
                    f32x4 gi, gf;
#pragma unroll
                    for (int j = 0; j < 4; ++j) { gi[j] = 15.0f * tanhf(xi[j] * (1.0f / 15.0f)); const float c = 15.0f * tanhf(xf[j] * (1.0f / 15.0f));
                        gf[j] = fminf(c, 0.f) - log1pf(expf(-fabsf(c))); }
                    *(f32x4*)(gates + (size_t)row * 8) = gi; *(f32x4*)(gates + (size_t)row * 8 + 4) = gf;
                }
            }
    }
};
struct EpiHead {
    static constexpr bool PERM = true, AFTER_DRAIN = false;
    bf16* O0; int ld0; bf16* O1; int ld1; int norm_tiles; const float* rs; const float* gain; float post; float* slab; int nt_full;
    __device__ __forceinline__ void operator()(const f32x4 (&acc)[2][2][4][2], const pg8::Unit& u, int wr, int wc, int fr, int fq) const {
        const int row0 = u.pm * 256 + wr * 64 + fr;
        if (u.nt != nt_full) {
            float* sp = slab + (size_t)((((u.pm - TS_PM0) * 8 + u.pn) * TS_PARTS) + u.koff / (u.nt * 128)) * 65536 + (size_t)(wr * 64 + fr) * 256 + wc * 32 + 8 * fq;
#pragma unroll
            for (int ai = 0; ai < 2; ++ai)
#pragma unroll
                for (int m = 0; m < 4; ++m)
#pragma unroll
                    for (int bj = 0; bj < 2; ++bj) { float* q = sp + (ai * 128 + m * 16) * 256 + bj * 128; *(f32x4*)q = acc[ai][bj][m][0]; *(f32x4*)(q + 4) = acc[ai][bj][m][1]; }
            return; }
        const bool normed = u.pn < norm_tiles;
        bf16* base = normed ? O0 + (size_t)u.pn * 256 : O1 + (size_t)(u.pn - norm_tiles) * 256;
        const int ld = normed ? ld0 : ld1;
        float r8[8]; row_rscale8(rs, row0, r8);
        f32x4 gn[2][2];
#pragma unroll
        for (int bj = 0; bj < 2; ++bj)
#pragma unroll
            for (int n = 0; n < 2; ++n) gn[bj][n] = normed ? *(const f32x4*)(gain + 32 * bj + 8 * fq + 4 * n) * post : (f32x4){1.f, 1.f, 1.f, 1.f};
#pragma unroll
        for (int ai = 0; ai < 2; ++ai)
#pragma unroll
            for (int m = 0; m < 4; ++m) {
                const int row = row0 + ai * 128 + m * 16;
                const float r = r8[ai * 4 + m];
                f32x4 x[2][2]; float ms = 0.f;
#pragma unroll
                for (int bj = 0; bj < 2; ++bj)
#pragma unroll
                    for (int n = 0; n < 2; ++n) { x[bj][n] = acc[ai][bj][m][n] * r; const f32x4 q = x[bj][n] * x[bj][n]; ms += (q[0] + q[1]) + (q[2] + q[3]); }
                ms += __shfl_xor(ms, 16); ms += __shfl_xor(ms, 32);
                const float inv = normed ? rsqrtf(ms * (1.0f / 64.0f) + EPS) : 1.0f;
#pragma unroll
                for (int bj = 0; bj < 2; ++bj) { const f32x4 v0 = x[bj][0] * inv * gn[bj][0], v1 = x[bj][1] * inv * gn[bj][1];
                    v4u w; w.x = pk2(v0[0], v0[1]); w.y = pk2(v0[2], v0[3]); w.z = pk2(v1[0], v1[1]); w.w = pk2(v1[2], v1[3]);
                    *(v4u*)(base + (size_t)row * ld + wc * 64 + 32 * bj + 8 * fq) = w; }
            }
    }
};

struct Args { const float* in[25]; float* out; unsigned char* ws; };
enum { I_XP = 0, I_XS, I_SC, I_SN, I_SM, I_CKM, I_CVM, I_CKW, I_CVW, I_META, I_FFNN, I_WFI, I_WFO, I_MIXN, I_WAI, I_BAG, I_AHN, I_WAO, I_KVN, I_WKV, I_KN, I_WQ, I_QN, I_SINK, I_WBO };
struct CvtItem { const float* lp; const float* gain; bf16* dp; int ldw; int valid; float scale; int K; };
constexpr int IT_W1 = (DM / 64) * (2 * DFF / 64), IT_W2 = (DFF / 64) * (DM / 64), IT_AIN = (DM / 64) * (NAIN_PAD / 64), IT_SQ = (DM / 64) * (DM / 64), IT_KV = (DM / 64) * (512 / 64);
constexpr int CVT_NITEMS = 4 * IT_W1 + 4 * IT_W2 + IT_AIN + IT_SQ + IT_KV + IT_SQ + IT_SQ;
__device__ __forceinline__ CvtItem cvt_decode(const Args& a, int it, int lane) {
    unsigned char* ws = a.ws; const int l16 = lane & 15, q = lane >> 4, nl = 4 * l16;
    CvtItem c; c.valid = 1; c.scale = 1.0f; c.gain = nullptr;
    int r = it, kb, n0, col; const float* W; bf16* dst;
    if (r < 4 * IT_W1) { const int f = r / IT_W1; r -= f * IT_W1; const int nblk = 2 * DFF / 64; kb = r / nblk; n0 = 64 * (r % nblk); const int tile = n0 >> 8, within = (n0 & 255) + nl;
        col = within < 128 ? 128 * tile + within : DFF + 128 * tile + (within - 128);
        W = a.in[I_WFI] + (size_t)f * DM * 2 * DFF; c.ldw = 2 * DFF; c.K = DM; c.gain = a.in[I_FFNN] + f * DM; dst = (bf16*)(ws + WS_W1 + f * SZ_W1); }
    else if ((r -= 4 * IT_W1) < 4 * IT_W2) { const int f = r / IT_W2; r -= f * IT_W2; const int nblk = DM / 64; kb = r / nblk; n0 = 64 * (r % nblk); col = n0 + nl;
        W = a.in[I_WFO] + (size_t)f * DFF * DM; c.ldw = DM; c.K = DFF; dst = (bf16*)(ws + WS_W2 + f * SZ_W2); }
    else if ((r -= 4 * IT_W2) < IT_AIN) { const int nblk = NAIN_PAD / 64; kb = r / nblk; n0 = 64 * (r % nblk); col = n0 + nl;
        c.valid = col < NAIN + 8 ? 1 : 0; if (!c.valid) col = 0; c.scale = (n0 >= 1024 && n0 < 2048) ? 0.0625f : 1.0f;
        W = a.in[I_WAI]; c.ldw = NAIN + 8; c.K = DM; c.gain = a.in[I_MIXN]; dst = (bf16*)(ws + WS_WAIN); }
    else if ((r -= IT_AIN) < IT_SQ) { const int nblk = DM / 64; kb = r / nblk; n0 = 64 * (r % nblk); col = n0 + nl; W = a.in[I_WAO]; c.ldw = DM; c.K = DM; dst = (bf16*)(ws + WS_WAOUT); }
    else if ((r -= IT_SQ) < IT_KV) { const int nblk = 512 / 64; kb = r / nblk; n0 = 64 * (r % nblk); const int d = n0 + nl, tile = d >> 8, within = d & 255, bj = within >> 7, wc = (within >> 5) & 3;
        col = 256 * tile + 64 * wc + 32 * bj + (within & 31); W = a.in[I_WKV]; c.ldw = 512; c.K = DM; c.gain = a.in[I_KVN]; dst = (bf16*)(ws + WS_WKV); }
    else if ((r -= IT_KV) < IT_SQ) { const int nblk = DM / 64; kb = r / nblk; n0 = 64 * (r % nblk); const int d = n0 + nl, tile = d >> 8, within = d & 255, bj = within >> 7, wc = (within >> 5) & 3;
        col = 256 * tile + 64 * wc + 32 * bj + (within & 31); W = a.in[I_WQ]; c.ldw = DM; c.K = DM; c.gain = a.in[I_MIXN] + DM; dst = (bf16*)(ws + WS_WQ); }
    else { r -= IT_SQ; const int nblk = DM / 64; kb = r / nblk; n0 = 64 * (r % nblk); col = n0 + nl; W = a.in[I_WBO]; c.ldw = DM; c.K = DM; dst = (bf16*)(ws + WS_WBO); }
    c.lp = W + (size_t)(64 * kb + q) * c.ldw + col;
    if (c.gain) c.gain += 64 * kb;
    c.dp = dst + (size_t)n0 * c.K + 64 * kb;
    return c;
}
__device__ __forceinline__ void cvt_load(const CvtItem& c, f32x4 (&r)[16]) {
#pragma unroll
    for (int i = 0; i < 16; ++i) r[i] = c.valid ? *(const f32x4*)(c.lp + (size_t)(4 * i) * c.ldw) : (f32x4){0.f, 0.f, 0.f, 0.f};
}
__device__ __forceinline__ void cvt_store(const CvtItem& c, const f32x4 (&r)[16], LAS float* scr, int lane) {
    const int l16 = lane & 15, q = lane >> 4;
#pragma unroll
    for (int i = 0; i < 16; ++i) { LAS float* s = scr + (4 * i + q) * 65 + 4 * l16; s[0] = r[i][0]; s[1] = r[i][1]; s[2] = r[i][2]; s[3] = r[i][3]; }
    LDS_WAIT(); asm volatile("" ::: "memory");
    const int ch = lane & 7;
    f32x4 g0 = (f32x4){c.scale, c.scale, c.scale, c.scale}, g1 = g0;
    if (c.gain) { g0 = *(const f32x4*)(c.gain + 8 * ch) * c.scale; g1 = *(const f32x4*)(c.gain + 8 * ch + 4) * c.scale; }
#pragma unroll
    for (int j = 0; j < 8; ++j) { const int n = (lane >> 3) + 8 * j; const LAS float* s = scr + (8 * ch) * 65 + n;
        v4u o; o.x = pk2(s[0 * 65] * g0[0], s[1 * 65] * g0[1]); o.y = pk2(s[2 * 65] * g0[2], s[3 * 65] * g0[3]); o.z = pk2(s[4 * 65] * g1[0], s[5 * 65] * g1[1]); o.w = pk2(s[6 * 65] * g1[2], s[7 * 65] * g1[3]);
        *(v4u*)(c.dp + (size_t)n * c.K + 8 * ch) = o; }
    LDS_WAIT(); asm volatile("" ::: "memory");
}

__device__ __forceinline__ void p0_prologue(const Args& a, LAS unsigned char* lds, int gw, int NGW, int wave, int lane) {
    LAS float* scr = (LAS float*)(lds + wave * 16640);
    unsigned char* ws = a.ws;
    {
        f32x4 r0[16], r1[16]; int it = gw;
        if (it < CVT_NITEMS) {
            CvtItem c0 = cvt_decode(a, it, lane); CvtItem c1 = cvt_decode(a, it, lane); cvt_load(c0, r0);
            for (;;) {
                it += NGW; const bool h1 = it < CVT_NITEMS; if (h1) { c1 = cvt_decode(a, it, lane); cvt_load(c1, r1); }
                cvt_store(c0, r0, scr, lane);
                if (!h1) break;
                it += NGW; const bool h0 = it < CVT_NITEMS; if (h0) { c0 = cvt_decode(a, it, lane); cvt_load(c0, r0); }
                cvt_store(c1, r1, scr, lane);
                if (!h0) break;
            }
        }
    }
    bf16* AB = (bf16*)(ws + WS_AB); float* RS = (float*)(ws + WS_RS);
    for (int rw0 = gw; rw0 < MP; rw0 += 2 * NGW) {
        f32x4 v0[2][4], v1[2][4];
#pragma unroll
        for (int q = 0; q < 2; ++q) { const int row = rw0 + q * NGW; const float* src = nullptr;
            if (row < MPR) { const int b = row / TP, t = row - b * TP; src = t < NMETA ? a.in[I_META] + (size_t)t * DM : a.in[I_XP] + ((size_t)b * SEQ + (t - NMETA)) * DM; }
            else if (row < MREAL) src = a.in[I_XS] + (size_t)(row - MPR) * DM;
#pragma unroll
            for (int j = 0; j < 4; ++j) { v0[q][j] = (f32x4){0.f, 0.f, 0.f, 0.f}; v1[q][j] = v0[q][j];
                if (src) { v0[q][j] = *(const f32x4*)(src + 512 * j + 8 * lane); v1[q][j] = *(const f32x4*)(src + 512 * j + 8 * lane + 4); } } }
#pragma unroll
        for (int q = 0; q < 2; ++q) { const int row = rw0 + q * NGW; if (row < MP) { float ss = 0.f;
#pragma unroll
            for (int j = 0; j < 4; ++j) {
                v4u w; w.x = pk2(v0[q][j][0], v0[q][j][1]); w.y = pk2(v0[q][j][2], v0[q][j][3]); w.z = pk2(v1[q][j][0], v1[q][j][1]); w.w = pk2(v1[q][j][2], v1[q][j][3]);
                *(v4u*)(AB + (size_t)row * DM + 512 * j + 8 * lane) = w;
                ss += (v0[q][j][0] * v0[q][j][0] + v0[q][j][1] * v0[q][j][1]) + (v0[q][j][2] * v0[q][j][2] + v0[q][j][3] * v0[q][j][3]) + (v1[q][j][0] * v1[q][j][0] + v1[q][j][1] * v1[q][j][1]) + (v1[q][j][2] * v1[q][j][2] + v1[q][j][3] * v1[q][j][3]);
            }
            ss = wave_sum(ss);
            if (lane == 0) RS[row] = rsqrtf(ss * (1.0f / DM) + EPS); } }
    }
}

constexpr int ML_KN = 0, ML_KNS = 272, ML_KT = 34816, ML_KTS = 272, ML_VT = 69632, ML_VTS = 272, ML_CTB = ML_VT + 80 * 272  , ML_CTBS = 528, ML_GA = ML_CTB + 80 * 528  ;
static_assert(ML_GA + 2816 <= SCR_BYTES, "mLSTM LDS map");

#define ML_HALF(DH) do { \
    _Pragma("unroll") for (int ks = 0; ks < 4; ++ks) { bf16x8 fa_[8]; \
        _Pragma("unroll") for (int jb = 0; jb < 8; ++jb) fa_[jb] = *(const LAS bf16x8*)(lds + ML_KN + (16 * jb + i16) * ML_KNS + (32 * ks + 8 * g) * 2); \
        _Pragma("unroll") for (int jb = 0; jb < 8; ++jb) as_[jb] = MFMA16(fa_[jb], qf[4 * (DH) + ks], as_[jb]); } \
    _Pragma("unroll") for (int vb = 0; vb < 5; ++vb) accC[DH][vb] = accC[DH][vb] * decay; \
    _Pragma("unroll") for (int ks = 0; ks < 4; ++ks) { bf16x8 fv_[5]; \
        const bf16x8 bfr = *(const LAS bf16x8*)(lds + ML_KT + (16 * wave + i16) * ML_KTS + (32 * ks + 8 * g) * 2); \
        _Pragma("unroll") for (int vb = 0; vb < 5; ++vb) fv_[vb] = *(const LAS bf16x8*)(lds + ML_VT + (16 * vb + i16) * ML_VTS + (32 * ks + 8 * g) * 2); \
        _Pragma("unroll") for (int vb = 0; vb < 5; ++vb) accC[DH][vb] = MFMA16(fv_[vb], bfr, accC[DH][vb]); } \
} while (0)
#define ML_PUT_CTB(DH) do { _Pragma("unroll") for (int vb = 0; vb < 5; ++vb) _Pragma("unroll") for (int r = 0; r < 4; ++r) \
    *(LAS bf16*)(lds + ML_CTB + (16 * vb + 4 * g + r) * ML_CTBS + (128 * (DH) + 16 * wave + i16) * 2) = bf16_rne(accC[DH][vb][r]); } while (0)
#define ML_LOAD_K_ISSUE(DH, R0, R1) do { _Pragma("unroll") for (int it = 0; it < 2; ++it) { const int dc = wave + 8 * it; \
    const bf16* kp = QKVO + (rowbase + 2 * lane) * NAIN + 1024 + h * ADK + 128 * (DH) + 8 * dc; R0[it] = *(const v4u*)kp; R1[it] = *(const v4u*)(kp + NAIN); } } while (0)
#define ML_LOAD_K_PUT(R0, R1) do { const float w0 = ga[512 + 2 * lane], w1 = ga[512 + 2 * lane + 1]; \
    _Pragma("unroll") for (int it = 0; it < 2; ++it) { const int dc = wave + 8 * it; \
    *(LAS v4u*)(lds + ML_KN + (2 * lane) * ML_KNS + 16 * dc) = R0[it]; *(LAS v4u*)(lds + ML_KN + (2 * lane + 1) * ML_KNS + 16 * dc) = R1[it]; \
    _Pragma("unroll") for (int e = 0; e < 8; ++e) *(LAS unsigned*)(lds + ML_KT + (8 * dc + e) * ML_KTS + 4 * lane) = pk2(__uint_as_float(bfel(R0[it], e) << 16) * w0, __uint_as_float(bfel(R1[it], e) << 16) * w1); } } while (0)

__device__ __forceinline__ void mlstm_prompt_unit(LAS unsigned char* lds, const bf16* QKVO, const float* GATES, float* HM, float* HSSQ, float* out, int b, int h, int j, int tid, int wave, int lane) {
    const int i16 = lane & 15, g = lane >> 4;
    LAS float* ga = (LAS float*)(lds + ML_GA);
    f32x4 accC[2][5];
#pragma unroll
    for (int dh = 0; dh < 2; ++dh)
#pragma unroll
        for (int vb = 0; vb < 5; ++vb) accC[dh][vb] = (f32x4){0.f, 0.f, 0.f, 0.f};
    __syncthreads();
    for (int o = tid * 16; o < 80 * ML_CTBS; o += 512 * 16) *(LAS v4u*)(lds + ML_CTB + o) = (v4u){0u, 0u, 0u, 0u};
    for (int o = tid; o < 16 * 64; o += 512) { const int rr = o >> 6, cc = o & 63; *(LAS unsigned*)(lds + ML_VT + (64 + rr) * ML_VTS + cc * 4) = rr == 0 ? 0x3F803F80u : 0u; }
    float m_prev = 0.f;
    for (int c = 0; c < 17; ++c) {
        const int tok0 = c == 0 ? 0 : NMETA + 128 * (c - 1), nvalid = c == 0 ? NMETA : 128;
        const size_t rowbase = (size_t)b * TP + tok0;
        __syncthreads();
        bf16x8 qf[8];
        { const bf16* qp = QKVO + (rowbase + 16 * wave + i16) * NAIN + h * ADK + 8 * g;
#pragma unroll
          for (int ks = 0; ks < 8; ++ks) qf[ks] = *(const bf16x8*)(qp + 32 * ks); }
        if (wave == 0) {
            const int t0 = 2 * lane, t1 = t0 + 1;
            float ig0 = -1e30f, ig1 = -1e30f, lf0 = 0.f, lf1 = 0.f;
            if (t0 < nvalid) { const float* gp = GATES + (rowbase + t0) * 8; ig0 = gp[h]; lf0 = gp[4 + h]; }
            if (t1 < nvalid) { const float* gp = GATES + (rowbase + t1) * 8; ig1 = gp[h]; lf1 = gp[4 + h]; }
            const float c1 = lf0 + lf1; float sc = c1;
#pragma unroll
            for (int o = 1; o < 64; o <<= 1) { const float t = __shfl_up(sc, o); if (lane >= o) sc += t; }
            const float excl = sc - c1, b0 = excl + lf0, b1 = excl + c1;
            const float a0 = ig0 - b0, a1 = ig1 - b1;
            float smx = fmaxf(a0, a1);
#pragma unroll
            for (int o = 1; o < 64; o <<= 1) { const float t = __shfl_up(smx, o); if (lane >= o) smx = fmaxf(smx, t); }
            float exm = __shfl_up(smx, 1); if (lane == 0) exm = -INFINITY;
            const float p0 = fmaxf(exm, a0), p1 = fmaxf(p0, a1);
            const float pm0 = fmaxf(m_prev, p0), pm1 = fmaxf(m_prev, p1);
            const float Mx = fmaxf(m_prev, __shfl(smx, 63)), blast = __shfl(b1, 63);
            ga[t0] = a0; ga[t1] = a1; ga[128 + t0] = pm0; ga[128 + t1] = pm1;
            ga[256 + t0] = __expf(m_prev - pm0); ga[256 + t1] = __expf(m_prev - pm1);
            ga[384 + t0] = __expf(-(b0 + pm0)); ga[384 + t1] = __expf(-(b1 + pm1));
            ga[512 + t0] = __expf(a0 - Mx); ga[512 + t1] = __expf(a1 - Mx);
            if (lane == 0) ga[640] = __expf(m_prev - Mx);
            m_prev = blast + Mx;
        }
        __syncthreads();
        {
            const bf16* vp = QKVO + (rowbase + 2 * lane) * NAIN + 2048 + h * ADV + 64 * j + 8 * wave;
            const v4u r0 = *(const v4u*)vp, r1 = *(const v4u*)(vp + NAIN);
            v4u ka[2], kb[2]; ML_LOAD_K_ISSUE(0, ka, kb);
#pragma unroll
            for (int e = 0; e < 8; ++e) *(LAS unsigned*)(lds + ML_VT + (8 * wave + e) * ML_VTS + 4 * lane) = bfel(r0, e) | (bfel(r1, e) << 16);
            ML_LOAD_K_PUT(ka, kb);
        }
        __syncthreads();
        const float decay = ga[640];
        f32x4 aqc[5], as_[8];
#pragma unroll
        for (int vb = 0; vb < 5; ++vb) aqc[vb] = (f32x4){0.f, 0.f, 0.f, 0.f};
#pragma unroll
        for (int ks = 0; ks < 8; ++ks) { bf16x8 fb_[5];
#pragma unroll
            for (int vb = 0; vb < 5; ++vb) fb_[vb] = *(const LAS bf16x8*)(lds + ML_CTB + (16 * vb + i16) * ML_CTBS + (32 * ks + 8 * g) * 2);
#pragma unroll
            for (int vb = 0; vb < 5; ++vb) aqc[vb] = MFMA16(qf[ks], fb_[vb], aqc[vb]); }
#pragma unroll
        for (int jb = 0; jb < 8; ++jb) as_[jb] = (f32x4){0.f, 0.f, 0.f, 0.f};
        ML_HALF(0);
        __syncthreads();
        { v4u ka[2], kb[2]; ML_LOAD_K_ISSUE(1, ka, kb);
          ML_PUT_CTB(0);
          ML_LOAD_K_PUT(ka, kb); }
        __syncthreads();
        ML_HALF(1);
        ML_PUT_CTB(1);
        const int tl = 16 * wave + i16; const float pmt = ga[128 + tl];
        bf16x8 pf[4];
#pragma unroll
        for (int kk = 0; kk < 4; ++kk) { float pv[8];
#pragma unroll
            for (int hb = 0; hb < 2; ++hb) { const int jb = 2 * kk + hb; const f32x4 av = *(const LAS f32x4*)(ga + 16 * jb + 4 * g);
#pragma unroll
                for (int r = 0; r < 4; ++r) { const int s = 16 * jb + 4 * g + r; const float wgt = (s <= tl) ? __expf(av[r] - pmt) : 0.f; pv[4 * hb + r] = as_[jb][r] * wgt; } }
            v4u w; w.x = pk2m(pv[0], pv[1]); w.y = pk2m(pv[2], pv[3]); w.z = pk2m(pv[4], pv[5]); w.w = pk2m(pv[6], pv[7]); pf[kk] = __builtin_bit_cast(bf16x8, w); }
        f32x4 apv[5];
#pragma unroll
        for (int vb = 0; vb < 5; ++vb) apv[vb] = (f32x4){0.f, 0.f, 0.f, 0.f};
#pragma unroll
        for (int kk = 0; kk < 4; ++kk) { v4u wv_[5];
#pragma unroll
            for (int vb = 0; vb < 5; ++vb) { const LAS unsigned char* vp = lds + ML_VT + (16 * vb + i16) * ML_VTS + (32 * kk + 4 * g) * 2;
                const v2u lo = *(const LAS v2u*)vp, hi = *(const LAS v2u*)(vp + 32); wv_[vb] = (v4u){lo.x, lo.y, hi.x, hi.y}; }
#pragma unroll
            for (int vb = 0; vb < 5; ++vb) apv[vb] = MFMA16(pf[kk], __builtin_bit_cast(bf16x8, wv_[vb]), apv[vb]); }
        const f32x4 wi4 = *(const LAS f32x4*)(ga + 256 + 16 * wave + 4 * g), ef4 = *(const LAS f32x4*)(ga + 384 + 16 * wave + 4 * g);
#pragma unroll
        for (int r = 0; r < 4; ++r) { const int tr = 16 * wave + 4 * g + r; const float wi = wi4[r];
            float den = apv[4][r] + wi * aqc[4][r]; den = __shfl(den, lane & 48); den = fmaxf(fabsf(den), ef4[r]);
            const float inv = 1.0f / den; float ss = 0.f; const bool ok = tr < nvalid;
#pragma unroll
            for (int vb = 0; vb < 4; ++vb) { const float hv = (apv[vb][r] + wi * aqc[vb][r]) * inv; ss += hv * hv;
                if (ok) HM[(rowbase + tr) * DM + h * ADV + 64 * j + 16 * vb + i16] = hv; }
            ss += __shfl_xor(ss, 1); ss += __shfl_xor(ss, 2); ss += __shfl_xor(ss, 4); ss += __shfl_xor(ss, 8);
            if (ok && i16 == 0) HSSQ[(rowbase + tr) * 32 + h * 8 + j] = ss; }
    }
    const size_t bh = (size_t)b * AH + h;
#pragma unroll
    for (int dh = 0; dh < 2; ++dh) { const int d = 128 * dh + 16 * wave + i16;
#pragma unroll
        for (int vb = 0; vb < 4; ++vb) *(f32x4*)(out + O_CP + (bh * ADK + d) * ADV + 64 * j + 16 * vb + 4 * g) = accC[dh][vb];
        if (j == 0 && g == 0) out[O_NP + bh * ADK + d] = accC[dh][4][0]; }
    if (j == 0 && tid == 0) out[O_MP + bh] = m_prev;
}

__device__ __forceinline__ void mlstm_sample_unit(LAS unsigned char* lds, const bf16* QKVO, const float* GATES, const float* stC, const float* stN, const float* stM,
                                                  float* HM, float* HSSQ, float* out, int b, int h, int tid, int wave, int lane) {
    LAS float* qT = (LAS float*)lds;
    LAS float* wkT = (LAS float*)(lds + 4096);
    LAS float* qN = (LAS float*)(lds + 8192);
    LAS float* kN = (LAS float*)(lds + 12288);
    LAS float* dots = (LAS float*)(lds + 16384);
    LAS float* red = (LAS float*)(lds + 16640);
    const int row0 = MPR + DECS * b; const size_t bh = (size_t)b * AH + h;
    float ig[4], bb[4], a_[4], pm[4], wint[4], efl[4], wst[4];
    const unsigned qq = *(const unsigned*)(QKVO + (size_t)(row0 + (tid >> 7)) * NAIN + h * ADK + (tid & 127) * 2), kk = *(const unsigned*)(QKVO + (size_t)(row0 + (tid >> 7)) * NAIN + h * ADK + (tid & 127) * 2 + 1024);
    v2u vw[4];
#pragma unroll
    for (int s = 0; s < 4; ++s) vw[s] = *(const v2u*)(QKVO + (size_t)(row0 + s) * NAIN + 2048 + h * ADV + 4 * (tid & 127));
    const float mprev = stM[bh];
    { float run = 0.f, pmax = -INFINITY;
#pragma unroll
      for (int s = 0; s < 4; ++s) { ig[s] = GATES[(size_t)(row0 + s) * 8 + h]; run += GATES[(size_t)(row0 + s) * 8 + 4 + h]; bb[s] = run; a_[s] = ig[s] - bb[s]; pmax = fmaxf(pmax, a_[s]);
          pm[s] = fmaxf(mprev, pmax); wint[s] = __expf(mprev - pm[s]); efl[s] = __expf(-(bb[s] + pm[s])); } }
    const float Mx = pm[3], decay = __expf(mprev - Mx), mnew = bb[3] + Mx;
#pragma unroll
    for (int s = 0; s < 4; ++s) wst[s] = __expf(a_[s] - Mx);
    __syncthreads();
    { const int s = tid >> 7, d2 = (tid & 127) * 2;
      const float q0 = bflo(qq), q1 = bfhi(qq), k0 = bflo(kk), k1 = bfhi(kk);
      const float w = s == 0 ? wst[0] : s == 1 ? wst[1] : s == 2 ? wst[2] : wst[3];
      qT[d2 * 4 + s] = q0; qT[(d2 + 1) * 4 + s] = q1; wkT[d2 * 4 + s] = w * k0; wkT[(d2 + 1) * 4 + s] = w * k1;
      qN[s * 256 + d2] = q0; qN[s * 256 + d2 + 1] = q1; kN[s * 256 + d2] = k0; kN[s * 256 + d2 + 1] = k1; }
    __syncthreads();
    for (int x = wave; x < 20; x += 8) { float p = 0.f;
        if (x < 16) { const int t = x >> 2, s = x & 3;
#pragma unroll
            for (int i = 0; i < 4; ++i) p += qN[t * 256 + lane + 64 * i] * kN[s * 256 + lane + 64 * i]; }
        else { const int t = x - 16;
#pragma unroll
            for (int i = 0; i < 4; ++i) p += qN[t * 256 + lane + 64 * i] * stN[bh * ADK + lane + 64 * i]; }
        p = wave_sum(p); if (lane == 0) dots[x] = p; }
    __syncthreads();
    float P[4][4], deninv[4];
#pragma unroll
    for (int t = 0; t < 4; ++t) { float den = 0.f;
#pragma unroll
        for (int s = 0; s < 4; ++s) { P[t][s] = s <= t ? dots[4 * t + s] * __expf(a_[s] - pm[t]) : 0.f; den += P[t][s]; }
        den += wint[t] * dots[16 + t]; deninv[t] = 1.0f / fmaxf(fabsf(den), efl[t]); }
    const int eq = tid & 127, dq = tid >> 7;
    f32x4 vv[4];
#pragma unroll
    for (int s = 0; s < 4; ++s) { const v2u w = vw[s]; vv[s] = (f32x4){bflo(w.x), bfhi(w.x), bflo(w.y), bfhi(w.y)}; }
    f32x4 qc[4];
#pragma unroll
    for (int t = 0; t < 4; ++t) qc[t] = (f32x4){0.f, 0.f, 0.f, 0.f};
    const float* Cin = stC + bh * ADK * ADV + 4 * eq; float* Cout = out + O_CS + bh * ADK * ADV + 4 * eq;
#pragma unroll 8
    for (int dd = 0; dd < 64; ++dd) { const int d = 64 * dq + dd;
        const f32x4 c = *(const f32x4*)(Cin + (size_t)d * ADV); const f32x4 q4 = *(const LAS f32x4*)(qT + 4 * d), k4 = *(const LAS f32x4*)(wkT + 4 * d);
#pragma unroll
        for (int t = 0; t < 4; ++t) qc[t] += c * q4[t];
        *(f32x4*)(Cout + (size_t)d * ADV) = c * decay + vv[0] * k4[0] + vv[1] * k4[1] + vv[2] * k4[2] + vv[3] * k4[3]; }
#pragma unroll
    for (int t = 0; t < 4; ++t) *(LAS f32x4*)(red + (dq * 4 + t) * 512 + 4 * eq) = qc[t];
    __syncthreads();
    { const int e = tid; float ve[4];
#pragma unroll
      for (int s = 0; s < 4; ++s) ve[s] = __uint_as_float((unsigned)QKVO[(size_t)(row0 + s) * NAIN + 2048 + h * ADV + e] << 16);
#pragma unroll
      for (int t = 0; t < 4; ++t) { const float qcs = (red[(0 * 4 + t) * 512 + e] + red[(1 * 4 + t) * 512 + e]) + (red[(2 * 4 + t) * 512 + e] + red[(3 * 4 + t) * 512 + e]);
          float pvv = 0.f;
#pragma unroll
          for (int s = 0; s < 4; ++s) pvv += P[t][s] * ve[s];
          const float hv = (pvv + wint[t] * qcs) * deninv[t];
          HM[(size_t)(row0 + t) * DM + h * ADV + e] = hv;
          const float ss = wave_sum(hv * hv); if (lane == 0) HSSQ[(size_t)(row0 + t) * 32 + h * 8 + wave] = ss; } }
    if (tid < ADK) { const f32x4 k4 = *(const LAS f32x4*)(wkT + 4 * tid); out[O_NS + bh * ADK + tid] = decay * stN[bh * ADK + tid] + ((k4[0] + k4[1]) + (k4[2] + k4[3])); }
    if (tid == 0) out[O_MS + bh] = mnew;
}

__device__ __forceinline__ void mlstm_gate_rows(const float* HM, const float* HSSQ, const bf16* QKVO, const float* gain, bf16* AM, int gw, int NGW, int lane) {
    f32x4 g0[4], g1[4];
#pragma unroll
    for (int i = 0; i < 4; ++i) { g0[i] = *(const f32x4*)(gain + 512 * i + 8 * lane); g1[i] = *(const f32x4*)(gain + 512 * i + 8 * lane + 4); }
    for (int row0 = 2 * gw; row0 < MREAL; row0 += 2 * NGW) {
        f32x4 s0[2][4], s1[2][4], h0[2][4], h1[2][4]; v4u ow[2][4];
#pragma unroll
        for (int q = 0; q < 2; ++q) { const int row = row0 + q < MREAL ? row0 + q : row0;
#pragma unroll
            for (int i = 0; i < 4; ++i) { const int c = 512 * i + 8 * lane;
                s0[q][i] = *(const f32x4*)(HSSQ + (size_t)row * 32 + 8 * i); s1[q][i] = *(const f32x4*)(HSSQ + (size_t)row * 32 + 8 * i + 4);
                h0[q][i] = *(const f32x4*)(HM + (size_t)row * DM + c); h1[q][i] = *(const f32x4*)(HM + (size_t)row * DM + c + 4);
                ow[q][i] = *(const v4u*)(QKVO + (size_t)row * NAIN + 4096 + c); } }
#pragma unroll
        for (int q = 0; q < 2; ++q) { const int row = row0 + q; if (row < MREAL) {
#pragma unroll
            for (int i = 0; i < 4; ++i) {
                const float rs = rsqrtf((((s0[q][i][0] + s0[q][i][1]) + (s0[q][i][2] + s0[q][i][3])) + ((s1[q][i][0] + s1[q][i][1]) + (s1[q][i][2] + s1[q][i][3]))) * (1.0f / ADV) + EPS);
                float o[8];
#pragma unroll
                for (int e = 0; e < 8; ++e) { const float ov = __uint_as_float(bfel(ow[q][i], e) << 16); const float sg = __builtin_amdgcn_rcpf(1.0f + __expf(-ov));
                    const float hv = e < 4 ? h0[q][i][e & 3] * g0[i][e & 3] : h1[q][i][e & 3] * g1[i][e & 3]; o[e] = hv * rs * sg; }
                v4u w; w.x = pk2(o[0], o[1]); w.y = pk2(o[2], o[3]); w.z = pk2(o[4], o[5]); w.w = pk2(o[6], o[7]);
                *(v4u*)(AM + (size_t)row * DM + 512 * i + 8 * lane) = w; } } }
    }
}

template <int NKEY> struct AttnLds { static constexpr int KNS = 144, KN = 0, VT = NKEY * 144, VTS = NKEY * 2 + 16, END = VT + 64 * VTS; };

struct AttnMask { int rel0, lim, mrel;
    __device__ __forceinline__ bool operator()(int jj, int blk, int r, float& dist) const {
        if (jj == 0) { dist = (float)WIN; return mrel - r >= WIN; }
        const int rel = rel0 - 16 * blk - r; dist = (float)rel; return (unsigned)rel <= (unsigned)lim; } };
struct MaskGen { AttnMask m; float slope;
    __device__ __forceinline__ float apply(int jj, int blk, int r, float s) const { float dist; const bool ok = m(jj, blk, r, dist); return ok ? s - slope * dist : -INFINITY; }
    __device__ __forceinline__ float shift() const { return 0.f; } };
struct MaskFast { float u[4], s16, m0, sh; int relT;
    __device__ __forceinline__ void init(float slope, int lane) { const int i16 = lane & 15, g = lane >> 4;
#pragma unroll
        for (int r = 0; r < 4; ++r) u[r] = slope * (float)(4 * g + r);
        s16 = 16.0f * slope; m0 = slope * (float)(16 + i16); sh = slope * (float)(144 + i16); relT = 144 + i16 - 4 * g; }
    __device__ __forceinline__ float apply(int jj, int, int r, float s) const {
        if (jj == 0) return s + m0;
        const float v = (s + u[r]) + s16 * (float)jj;
        if (jj == 1) return relT - 16 - r <= WIN - 1 ? v : -INFINITY;
        if (jj == 9) return relT - 144 - r >= 0 ? v : -INFINITY;
        return v; }
    __device__ __forceinline__ float shift() const { return sh; } };
template <int NKEY, int NJB, class MaskF, class BlkF>
__device__ __forceinline__ void attn_tblock(LAS unsigned char* lds, const bf16x8 qf0, const bf16x8 qf1, float sink_in, const MaskF& mask, const BlkF& blk,
                                            bf16* orow  , int nq_valid, int lane) {
    typedef AttnLds<NKEY> L;
    const int i16 = lane & 15, g = lane >> 4;
    f32x4 sacc[NJB];
#pragma unroll
    for (int jb = 0; jb < NJB; ++jb) { sacc[jb] = (f32x4){0.f, 0.f, 0.f, 0.f};
        const LAS unsigned char* kp = lds + L::KN + (16 * blk(jb) + i16) * L::KNS + 16 * g;
        sacc[jb] = MFMA16(*(const LAS bf16x8*)kp, qf0, sacc[jb]); sacc[jb] = MFMA16(*(const LAS bf16x8*)(kp + 64), qf1, sacc[jb]); }
    const float sink = sink_in + mask.shift();
    float mx = sink;
#pragma unroll
    for (int jb = 0; jb < NJB; ++jb)
#pragma unroll
        for (int r = 0; r < 4; ++r) { const float sv = mask.apply(jb, blk(jb), r, sacc[jb][r]); sacc[jb][r] = sv; mx = fmaxf(mx, sv); }
    mx = fmaxf(mx, __shfl_xor(mx, 16)); mx = fmaxf(mx, __shfl_xor(mx, 32));
    float sum = 0.f;
#pragma unroll
    for (int jb = 0; jb < NJB; ++jb)
#pragma unroll
        for (int r = 0; r < 4; ++r) { const float p = __expf(sacc[jb][r] - mx); sacc[jb][r] = p; sum += p; }
    sum += __shfl_xor(sum, 16); sum += __shfl_xor(sum, 32);
    sum += __expf(sink - mx);
    const float inv = 1.0f / sum;
    f32x4 oacc[4];
#pragma unroll
    for (int db = 0; db < 4; ++db) oacc[db] = (f32x4){0.f, 0.f, 0.f, 0.f};
#pragma unroll
    for (int kk = 0; kk < NJB / 2; ++kk) {
        v4u w; w.x = pk2m(sacc[2 * kk][0], sacc[2 * kk][1]); w.y = pk2m(sacc[2 * kk][2], sacc[2 * kk][3]); w.z = pk2m(sacc[2 * kk + 1][0], sacc[2 * kk + 1][1]); w.w = pk2m(sacc[2 * kk + 1][2], sacc[2 * kk + 1][3]);
        const bf16x8 pf = __builtin_bit_cast(bf16x8, w);
#pragma unroll
        for (int db = 0; db < 4; ++db) { const LAS unsigned char* vp = lds + L::VT + (16 * db + i16) * L::VTS + 8 * g;
            const v2u lo = *(const LAS v2u*)(vp + 32 * blk(2 * kk)), hi = *(const LAS v2u*)(vp + 32 * blk(2 * kk + 1)); const v4u bw = (v4u){lo.x, lo.y, hi.x, hi.y};
            oacc[db] = MFMA16(__builtin_bit_cast(bf16x8, bw), pf, oacc[db]); } }
    if (i16 < nq_valid) {
#pragma unroll
        for (int db = 0; db < 4; ++db) { const f32x4 o = oacc[db] * inv; v2u w; w.x = pk2(o[0], o[1]); w.y = pk2(o[2], o[3]); *(v2u*)(orow + (size_t)i16 * DM + 16 * db + 4 * g) = w; } }
}

__device__ __forceinline__ void attn_prompt_unit(LAS unsigned char* lds, const bf16* QB, const bf16* KB, const bf16* VB, const float* sinks, bf16* AM, int b, int g, int n, int tid, int wave, int lane) {
    typedef AttnLds<288> L;
    const int hh = 8 * g + wave; const float slope = exp2f(-0.25f * (float)(hh + 1)), sink = sinks[hh];
    const bf16* qbase = QB + ((size_t)b * TP + 128 * n + (lane & 15)) * DM + hh * 64 + 8 * (lane >> 4);
    bf16x8 q0 = *(const bf16x8*)qbase, q1 = *(const bf16x8*)(qbase + 32);
    __syncthreads();
    { v4u kr[5], vr0[3], vr1[3];
#pragma unroll
      for (int i = 0; i < 5; ++i) { const int it = tid + 512 * i, kk = it >> 3, ch = it & 7; const int pos = kk < NMETA ? kk : 128 * (n - 1) + kk - NMETA; kr[i] = (v4u){0u, 0u, 0u, 0u};
          if (it < 288 * 8 && kk < NMETA + 256 && pos >= 0 && pos < TP) kr[i] = *(const v4u*)(KB + ((size_t)b * TP + pos) * 256 + g * 64 + 8 * ch); }
#pragma unroll
      for (int i = 0; i < 3; ++i) { const int it = tid + 512 * i, ch = it / 144, p = it - ch * 144; vr0[i] = (v4u){0u, 0u, 0u, 0u}; vr1[i] = vr0[i];
          if (it < 144 * 8) {
              { const int kk = 2 * p, pos = kk < NMETA ? kk : 128 * (n - 1) + kk - NMETA; if (kk < NMETA + 256 && pos >= 0 && pos < TP) vr0[i] = *(const v4u*)(VB + ((size_t)b * TP + pos) * 256 + g * 64 + 8 * ch); }
              { const int kk = 2 * p + 1, pos = kk < NMETA ? kk : 128 * (n - 1) + kk - NMETA; if (kk < NMETA + 256 && pos >= 0 && pos < TP) vr1[i] = *(const v4u*)(VB + ((size_t)b * TP + pos) * 256 + g * 64 + 8 * ch); } } }
#pragma unroll
      for (int i = 0; i < 5; ++i) { const int it = tid + 512 * i, kk = it >> 3, ch = it & 7; if (it < 288 * 8) *(LAS v4u*)(lds + L::KN + kk * L::KNS + 16 * ch) = kr[i]; }
#pragma unroll
      for (int i = 0; i < 3; ++i) { const int it = tid + 512 * i, ch = it / 144, p = it - ch * 144;
          if (it < 144 * 8) {
#pragma unroll
              for (int e = 0; e < 8; ++e) *(LAS unsigned*)(lds + L::VT + (8 * ch + e) * L::VTS + 4 * p) = bfel(vr0[i], e) | (bfel(vr1[i], e) << 16); } } }
    __syncthreads();
    MaskFast mf; mf.init(slope, lane);
    for (int tb = 0; tb < 8; ++tb) { const int tpos0 = 128 * n + 16 * tb; if (tpos0 >= TP) break;
        const size_t row0 = (size_t)b * TP + tpos0;
        const int tbn = (tb < 7 && tpos0 + 16 < TP) ? tb + 1 : tb;
        const bf16x8 n0 = *(const bf16x8*)(qbase + (size_t)tbn * 16 * DM), n1 = *(const bf16x8*)(qbase + (size_t)tbn * 16 * DM + 32);
        __builtin_amdgcn_sched_barrier(0);
        const auto blk = [tb](int jj) { return jj == 0 ? 0 : tb + jj; };
        if (n >= 2) attn_tblock<288, 10>(lds, q0, q1, sink, mf, blk, AM + row0 * DM + hh * 64, 16, lane);
        else { const int tpos = tpos0 + (lane & 15);
            const MaskGen mk{AttnMask{tpos - 128 * (n - 1) + NMETA - 4 * (lane >> 4), tpos < WIN - 1 ? tpos : WIN - 1, tpos - 4 * (lane >> 4)}, slope};
            attn_tblock<288, 10>(lds, q0, q1, sink, mk, blk, AM + row0 * DM + hh * 64, 16, lane); }
        q0 = n0; q1 = n1; }
}
__device__ __forceinline__ void attn_sample_unit(LAS unsigned char* lds, const bf16* QB, const bf16* KB, const bf16* VB, const float* ckm, const float* cvm, const float* ckw, const float* cvw,
                                                 const float* sinks, bf16* AM, int b, int g, int tid, int wave, int lane) {
    typedef AttnLds<160> L;
    const int hh = 8 * g + wave; const float slope = exp2f(-0.25f * (float)(hh + 1)), sink = sinks[hh];
    const size_t row0 = (size_t)MPR + DECS * b;
    const bf16* qbase = QB + (row0 + (lane & 15)) * DM + hh * 64 + 8 * (lane >> 4);
    const bf16x8 q0 = *(const bf16x8*)qbase, q1 = *(const bf16x8*)(qbase + 32);
    __syncthreads();
    { f32x4 kf0[3], kf1[3]; v4u kn[3];
#pragma unroll
      for (int i = 0; i < 3; ++i) { const int it = tid + 512 * i, kk = it >> 3, ch = it & 7; kf0[i] = (f32x4){0.f, 0.f, 0.f, 0.f}; kf1[i] = kf0[i]; kn[i] = (v4u){0u, 0u, 0u, 0u};
          if (it < 160 * 8) {
              if (kk < NMETA + WIN) { const float* src = kk < NMETA ? ckm + (((size_t)b * NMETA + kk) * BKV + g) * 64 + 8 * ch : ckw + (((size_t)b * WIN + (kk - NMETA)) * BKV + g) * 64 + 8 * ch;
                  kf0[i] = *(const f32x4*)src; kf1[i] = *(const f32x4*)(src + 4); }
              else if (kk < NMETA + WIN + DECS) kn[i] = *(const v4u*)(KB + ((size_t)MPR + DECS * b + (kk - NMETA - WIN)) * 256 + g * 64 + 8 * ch); } }
      f32x4 vf0[2][2], vf1[2][2]; v4u vn[2][2];
#pragma unroll
      for (int i = 0; i < 2; ++i) { const int it = tid + 512 * i, ch = it / 80, p = it - ch * 80;
#pragma unroll
          for (int q = 0; q < 2; ++q) { const int kk = 2 * p + q; vf0[i][q] = (f32x4){0.f, 0.f, 0.f, 0.f}; vf1[i][q] = vf0[i][q]; vn[i][q] = (v4u){0u, 0u, 0u, 0u};
              if (it < 80 * 8) {
                  if (kk < NMETA + WIN) { const float* src = kk < NMETA ? cvm + (((size_t)b * NMETA + kk) * BKV + g) * 64 + 8 * ch : cvw + (((size_t)b * WIN + (kk - NMETA)) * BKV + g) * 64 + 8 * ch;
                      vf0[i][q] = *(const f32x4*)src; vf1[i][q] = *(const f32x4*)(src + 4); }
                  else if (kk < NMETA + WIN + DECS) vn[i][q] = *(const v4u*)(VB + ((size_t)MPR + DECS * b + (kk - NMETA - WIN)) * 256 + g * 64 + 8 * ch); } } }
#pragma unroll
      for (int i = 0; i < 3; ++i) { const int it = tid + 512 * i, kk = it >> 3, ch = it & 7;
          if (it < 160 * 8) { v4u r = kn[i];
              if (kk < NMETA + WIN) { r.x = pk2(kf0[i][0], kf0[i][1]); r.y = pk2(kf0[i][2], kf0[i][3]); r.z = pk2(kf1[i][0], kf1[i][1]); r.w = pk2(kf1[i][2], kf1[i][3]); }
              *(LAS v4u*)(lds + L::KN + kk * L::KNS + 16 * ch) = r; } }
#pragma unroll
      for (int i = 0; i < 2; ++i) { const int it = tid + 512 * i, ch = it / 80, p = it - ch * 80;
          if (it < 80 * 8) { v4u rr[2];
#pragma unroll
              for (int q = 0; q < 2; ++q) { const int kk = 2 * p + q; v4u r = vn[i][q];
                  if (kk < NMETA + WIN) { r.x = pk2(vf0[i][q][0], vf0[i][q][1]); r.y = pk2(vf0[i][q][2], vf0[i][q][3]); r.z = pk2(vf1[i][q][0], vf1[i][q][1]); r.w = pk2(vf1[i][q][2], vf1[i][q][3]); }
                  rr[q] = r; }
#pragma unroll
              for (int e = 0; e < 8; ++e) *(LAS unsigned*)(lds + L::VT + (8 * ch + e) * L::VTS + 4 * p) = bfel(rr[0], e) | (bfel(rr[1], e) << 16); } } }
    __syncthreads();
    const MaskGen mk{AttnMask{WIN + (lane & 15) + NMETA - 4 * (lane >> 4), WIN - 1, 1 << 20}, slope};
    const auto blk = [](int jj) { return jj; };
    attn_tblock<160, 10>(lds, q0, q1, sink, mk, blk, AM + row0 * DM + hh * 64, DECS, lane);
}
__device__ __forceinline__ void kv_outputs(const Args& a, const bf16* KB, const bf16* VB, size_t gtid, size_t gthreads) {
    float* out = a.out;
    for (size_t i = gtid; i < (size_t)NBATCH * (NMETA + WIN) * 256; i += gthreads) { const int c = (int)(i & 255); const int rr = (int)(i >> 8); const int b = rr / (NMETA + WIN), q = rr - b * (NMETA + WIN);
        const int t = q < NMETA ? q : TP - WIN + (q - NMETA); const size_t src = ((size_t)b * TP + t) * 256 + c;
        const float kv = __uint_as_float((unsigned)KB[src] << 16), vv = __uint_as_float((unsigned)VB[src] << 16);
        if (q < NMETA) { out[O_KMP + ((size_t)b * NMETA + q) * 256 + c] = kv; out[O_VMP + ((size_t)b * NMETA + q) * 256 + c] = vv; }
        else { out[O_KWP + ((size_t)b * WIN + (q - NMETA)) * 256 + c] = kv; out[O_VWP + ((size_t)b * WIN + (q - NMETA)) * 256 + c] = vv; } }
    for (size_t i = gtid; i < (size_t)DECB * WIN * 64; i += gthreads) { const int c4 = (int)(i & 63) * 4; const int rr = (int)(i >> 6); const int b = rr >> 7, jj = rr & 127;
        f32x4 kv, vv;
        if (jj < WIN - DECS) { kv = *(const f32x4*)(a.in[I_CKW] + ((size_t)b * WIN + jj + DECS) * 256 + c4); vv = *(const f32x4*)(a.in[I_CVW] + ((size_t)b * WIN + jj + DECS) * 256 + c4); }
        else { const size_t src = ((size_t)MPR + DECS * b + (jj - (WIN - DECS))) * 256 + c4; const v2u kw = *(const v2u*)(KB + src), vw = *(const v2u*)(VB + src);
            kv = (f32x4){bflo(kw.x), bfhi(kw.x), bflo(kw.y), bfhi(kw.y)}; vv = (f32x4){bflo(vw.x), bfhi(vw.x), bflo(vw.y), bfhi(vw.y)}; }
        *(f32x4*)(out + O_KWS + ((size_t)b * WIN + jj) * 256 + c4) = kv; *(f32x4*)(out + O_VWS + ((size_t)b * WIN + jj) * 256 + c4) = vv; }
}

struct TailSplitOrder {
    pg8::StaticOrder mo; int G, c, kp;
    __device__ void init(int N, int K, int G_, int c_) { mo.init(TS_PM0 * 256, N, G_, c_); mo.nt0 = K / 64; kp = K / TS_PARTS; G = G_; c = c_; }
    __device__ bool next(int i, pg8::Unit& u) const {
        if (mo.next(i, u)) return true;
        const long L = (long)i * G + c - (long)mo.nwg; if (L < 0 || L >= TS_TILES * TS_PARTS) return false;
        const int t = (int)L / TS_PARTS, part = (int)L % TS_PARTS; u.pm = TS_PM0 + t / 8; u.pn = t % 8; u.koff = part * kp * 2; u.nt = kp / 64; return true; }
    __device__ __forceinline__ void a_ready(const pg8::Unit&) const {}
    __device__ __forceinline__ void done(const pg8::Unit&) const {}
};
template <bool FINAL> __device__ __forceinline__ void resid_combine(LAS unsigned char* lds, const bf16* HI, bf16* AB, const float* ssq, float* rs, const float* slab, float sc, float* out, int G, int wave, int gw, int NGW, int lane) {
    LAS float* red = (LAS float*)lds;
    constexpr int NT = MP - TS_PM0 * 256;
    for (int j0 = 0; (int)blockIdx.x + G * j0 < NT; j0 += 3) {
        f32x4 pp[3][4]; v2u hb[3];
#pragma unroll
        for (int j = 0; j < 3; ++j) { const int it = (int)blockIdx.x + G * (j0 + j); const int itc = it < NT ? it : (int)blockIdx.x;
            const int r = itc & 255, row = TS_PM0 * 256 + itc, t = (itc >> 8) * 8 + wave;
            const float* sp = slab + (size_t)(t * TS_PARTS) * 65536 + (size_t)r * 256 + 4 * lane;
#pragma unroll
            for (int p = 0; p < 4; ++p) pp[j][p] = *(const f32x4*)(sp + (size_t)p * 65536);
            hb[j] = *(const v2u*)(HI + (size_t)row * DM + wave * 256 + 4 * lane); }
        if (!FINAL && j0 > 0) __syncthreads();
#pragma unroll
        for (int j = 0; j < 3; ++j) { const int it = (int)blockIdx.x + G * (j0 + j);
            if (it < NT) { const int row = TS_PM0 * 256 + it, col = wave * 256 + 4 * lane;
                const f32x4 hn = (f32x4){bflo(hb[j].x), bfhi(hb[j].x), bflo(hb[j].y), bfhi(hb[j].y)} + ((pp[j][0] + pp[j][1]) + (pp[j][2] + pp[j][3])) * sc;
                if (FINAL) { float* op = nullptr;
                    if (row < MPR) { const int b = row / TP, tt = row - b * TP; if (tt >= NMETA) op = out + O_YP + ((size_t)b * SEQ + (tt - NMETA)) * DM; }
                    else if (row < MREAL) op = out + O_YS + (size_t)(row - MPR) * DM;
                    if (op) *(f32x4*)(op + col) = hn; }
                else { v2u w; w.x = pk2(hn[0], hn[1]); w.y = pk2(hn[2], hn[3]); *(v2u*)(AB + (size_t)row * DM + col) = w;
                    const float ss = wave_sum((hn[0] * hn[0] + hn[1] * hn[1]) + (hn[2] * hn[2] + hn[3] * hn[3]));
                    if (lane == 0) red[j * 8 + wave] = ss; } } }
        if (!FINAL) {
            __syncthreads();
            if (wave == 0 && lane < 3) { const int it = (int)blockIdx.x + G * (j0 + lane);
                if (it < NT) { float s = 0.f;
#pragma unroll
                    for (int w = 0; w < 8; ++w) s += red[lane * 8 + w];
                    rs[TS_PM0 * 256 + it] = rsqrtf(s * (1.0f / DM) + EPS); } } } }
    if (!FINAL) {
        for (int it0 = gw; it0 < TS_PM0 * 128; it0 += 4 * NGW) { float sv[4];
#pragma unroll
            for (int k = 0; k < 4; ++k) { const int it = it0 + k * NGW; sv[k] = it < TS_PM0 * 128 ? ssq[(size_t)(2 * it + (lane >> 5)) * 32 + (lane & 31)] : 0.f; }
#pragma unroll
            for (int k = 0; k < 4; ++k) { const int it = it0 + k * NGW; float s = sv[k];
                s += __shfl_xor(s, 1); s += __shfl_xor(s, 2); s += __shfl_xor(s, 4); s += __shfl_xor(s, 8); s += __shfl_xor(s, 16);
                if (it < TS_PM0 * 128 && (lane & 31) == 0) rs[2 * it + (lane >> 5)] = rsqrtf(s * (1.0f / DM) + EPS); } } }
}
__device__ __forceinline__ void head_combine(bf16* O, const float* rsv, const float* gain, float post, const float* slab, int gw, int NGW, int lane) {
    const int hd = (lane >> 3) & 3, dim = 32 * (lane >> 5) + 4 * (lane & 7);
    const f32x4 gv = *(const f32x4*)(gain + dim);
    for (int it0 = gw; it0 < TS_TILES * 256; it0 += 3 * NGW) {
        f32x4 pp[3][4]; float rsl[3];
#pragma unroll
        for (int k = 0; k < 3; ++k) { const int it = it0 + k * NGW < TS_TILES * 256 ? it0 + k * NGW : it0; const int t = it >> 8, r = it & 255, row = (TS_PM0 + (t >> 3)) * 256 + r;
            const float* sp = slab + (size_t)(t * TS_PARTS) * 65536 + (size_t)r * 256 + 4 * lane;
#pragma unroll
            for (int p = 0; p < 4; ++p) pp[k][p] = *(const f32x4*)(sp + (size_t)p * 65536);
            rsl[k] = rsv[row]; }
#pragma unroll
        for (int k = 0; k < 3; ++k) { const int it = it0 + k * NGW; if (it < TS_TILES * 256) { const int t = it >> 8, r = it & 255, pn = t & 7, row = (TS_PM0 + (t >> 3)) * 256 + r;
            const f32x4 x = ((pp[k][0] + pp[k][1]) + (pp[k][2] + pp[k][3])) * rsl[k];
            float ms = (x[0] * x[0] + x[1] * x[1]) + (x[2] * x[2] + x[3] * x[3]);
            ms += __shfl_xor(ms, 1); ms += __shfl_xor(ms, 2); ms += __shfl_xor(ms, 4); ms += __shfl_xor(ms, 32);
            const float inv = rsqrtf(ms * (1.0f / 64.0f) + EPS) * post;
            const f32x4 o = x * inv * gv;
            v2u w; w.x = pk2(o[0], o[1]); w.y = pk2(o[2], o[3]); *(v2u*)(O + (size_t)row * DM + pn * 256 + hd * 64 + dim) = w; } }
    }
}
#define GEMM_PHASE_TS(EPI_T, E, Aptr, Bptr, K_) do { pg8::Gemm gg{(const pg8::bf16_t*)(Aptr), (const pg8::bf16_t*)(Bptr), MP, DM, (K_)}; int bx_ = (int)blockIdx.x; asm volatile("" : "+s"(bx_)); TailSplitOrder SS; SS.init(DM, (K_), G, bx_); \
    pg8::gemm_phase<EPI_T, TailSplitOrder, true, true>(lds, gg, SS, (E)); } while (0)
typedef EpiResid<false, false> EpiResPlain; typedef EpiResid<true, false> EpiResFinal;
#define GEMM_PHASE(EPI_T, E, Aptr, Bptr, N_, K_) do { pg8::Gemm gg{(const pg8::bf16_t*)(Aptr), (const pg8::bf16_t*)(Bptr), MP, (N_), (K_)}; int bx_ = (int)blockIdx.x; asm volatile("" : "+s"(bx_)); pg8::StaticOrder SS; SS.init(MP, (N_), G, bx_); SS.nt0 = (K_) / 64; \
    pg8::gemm_phase<EPI_T, pg8::StaticOrder, true, true>(lds, gg, SS, (E)); } while (0)

__global__ void __launch_bounds__(NWAVES * 64, 2) yoco_fwd(Args args) {
    extern __shared__ __attribute__((aligned(16))) unsigned char lds_raw[];
    LAS unsigned char* lds = (LAS unsigned char*)lds_raw;
    volatile LAS unsigned* MISC = (volatile LAS unsigned*)(lds + MISC_OFF);
    const int tid = threadIdx.x, lane = tid & 63, wave = __builtin_amdgcn_readfirstlane(tid >> 6);
    const int G = gridDim.x, gw = blockIdx.x * NWAVES + wave, NGW = G * NWAVES;
    unsigned char* ws = args.ws;
    for (int u = tid; u < (LDS_BYTES - MISC_OFF) / 4; u += NWAVES * 64) ((LAS unsigned*)(lds + MISC_OFF))[u] = 0u;
    __syncthreads();
    XcdBarrier bar = xcd_barrier_post((unsigned*)(ws + WS_CTL) + CW_BAR, MISC + 8);

    bf16* AB = (bf16*)(ws + WS_AB); bf16* ACT = (bf16*)(ws + WS_ACT); bf16* QKVO = (bf16*)(ws + WS_ACT);
    float* HM = (float*)(ws + WS_HM); bf16* AM = (bf16*)(ws + WS_AM); bf16* QB = (bf16*)(ws + WS_QB); bf16* KB = (bf16*)(ws + WS_KB); bf16* VB = (bf16*)(ws + WS_VB);
    bf16* AB2 = (bf16*)(ws + WS_AB2); float* SSQ2 = (float*)(ws + WS_SSQ2); float* RS = (float*)(ws + WS_RS); float* RS2 = (float*)(ws + WS_RS2);
    float* SSQ = (float*)(ws + WS_SSQ); float* HSSQ = (float*)(ws + WS_HSSQ); float* GATES = (float*)(ws + WS_GATES);

    p0_prologue(args, lds, gw, NGW, wave, lane);
    xcd_barrier(bar);

    { EpiSwiglu<false> E{ACT, RS}; GEMM_PHASE(EpiSwiglu<false>, E, AB, ws + WS_W1 + 0 * SZ_W1, 2 * DFF, DM); }
    xcd_barrier(bar);
    { EpiResPlain E{AB, AB, SSQ, nullptr, (float*)(ws + WS_SLAB), 0.5f, DFF / 64}; GEMM_PHASE_TS(EpiResPlain, E, ACT, ws + WS_W2 + 0 * SZ_W2, DFF); }
    xcd_barrier(bar);
    resid_combine<false>(lds, AB, AB, SSQ, RS, (const float*)(ws + WS_SLAB), 0.5f, nullptr, G, wave, gw, NGW, lane);
    xcd_barrier(bar);

    { EpiQkvo E{QKVO, RS, GATES, args.in[I_BAG]}; GEMM_PHASE(EpiQkvo, E, AB, ws + WS_WAIN, NAIN_PAD, DM); }
    xcd_barrier(bar);
    for (int u = blockIdx.x; u < NBATCH * AH * 8; u += G) {
        const int v = (((u & 7) * 4 + (u >> 6)) << 3) | ((u >> 3) & 7);
        mlstm_prompt_unit(lds, QKVO, GATES, HM, HSSQ, args.out, v >> 5, (v >> 3) & 3, v & 7, tid, wave, lane); }
    for (int u = blockIdx.x; u < DECB * AH; u += G) mlstm_sample_unit(lds, QKVO, GATES, args.in[I_SC], args.in[I_SN], args.in[I_SM], HM, HSSQ, args.out, u >> 2, u & 3, tid, wave, lane);
    xcd_barrier(bar);
    mlstm_gate_rows(HM, HSSQ, QKVO, args.in[I_AHN], AM, gw, NGW, lane);
    xcd_barrier(bar);
    { EpiResPlain E{AB, AB, SSQ, nullptr, (float*)(ws + WS_SLAB), 1.0f, DM / 64}; GEMM_PHASE_TS(EpiResPlain, E, AM, ws + WS_WAOUT, DM); }
    xcd_barrier(bar);
    resid_combine<false>(lds, AB, AB, SSQ, RS, (const float*)(ws + WS_SLAB), 1.0f, nullptr, G, wave, gw, NGW, lane);
    xcd_barrier(bar);

    { EpiSwiglu<false> E{ACT, RS}; GEMM_PHASE(EpiSwiglu<false>, E, AB, ws + WS_W1 + 1 * SZ_W1, 2 * DFF, DM); }
    xcd_barrier(bar);
    { EpiResPlain E{AB, AB, SSQ, nullptr, (float*)(ws + WS_SLAB), 0.5f, DFF / 64}; GEMM_PHASE_TS(EpiResPlain, E, ACT, ws + WS_W2 + 1 * SZ_W2, DFF); }
    xcd_barrier(bar);
    resid_combine<false>(lds, AB, AB, SSQ, RS, (const float*)(ws + WS_SLAB), 0.5f, nullptr, G, wave, gw, NGW, lane);
    xcd_barrier(bar);

    { EpiSwiglu<false> E{ACT, RS}; GEMM_PHASE(EpiSwiglu<false>, E, AB, ws + WS_W1 + 2 * SZ_W1, 2 * DFF, DM); }
    xcd_barrier(bar);
    { EpiResPlain E{AB, AB2, SSQ2, nullptr, (float*)(ws + WS_SLAB), 0.5f, DFF / 64}; GEMM_PHASE_TS(EpiResPlain, E, ACT, ws + WS_W2 + 2 * SZ_W2, DFF); }
    { EpiHead E{KB, 256, VB, 256, 1, RS, args.in[I_KN], 1.0f, nullptr, DM / 64}; pg8::Gemm gg{(const pg8::bf16_t*)AB, (const pg8::bf16_t*)(ws + WS_WKV), MP, 512, DM}; int bx_ = ((int)blockIdx.x + G - TS_TILES * TS_PARTS % G) % G; asm volatile("" : "+s"(bx_));
      pg8::StaticOrder SS; SS.init(MP, 512, G, bx_); SS.nt0 = DM / 64; pg8::gemm_phase<EpiHead, pg8::StaticOrder, true, true>(lds, gg, SS, E); }
    xcd_barrier(bar);
    resid_combine<false>(lds, AB, AB2, SSQ2, RS2, (const float*)(ws + WS_SLAB), 0.5f, nullptr, G, wave, gw, NGW, lane);
    xcd_barrier(bar);

    { EpiHead E{QB, DM, QB, DM, 8, RS2, args.in[I_QN], 0.125f, (float*)(ws + WS_SLAB), DM / 64}; GEMM_PHASE_TS(EpiHead, E, AB2, ws + WS_WQ, DM); }
    if ((int)blockIdx.x >= TS_TILES * TS_PARTS) kv_outputs(args, KB, VB, (size_t)(blockIdx.x - TS_TILES * TS_PARTS) * (NWAVES * 64) + tid, (size_t)(G - TS_TILES * TS_PARTS) * NWAVES * 64);
    xcd_barrier(bar);
    head_combine(QB, RS2, args.in[I_QN], 0.125f, (const float*)(ws + WS_SLAB), gw, NGW, lane);
    xcd_barrier(bar);
    for (int u = blockIdx.x; u < NBATCH * BKV * 17; u += G) { const int n = u % 17, bg = u / 17; attn_prompt_unit(lds, QB, KB, VB, args.in[I_SINK], AM, bg >> 2, bg & 3, n, tid, wave, lane); }
    for (int u = (int)blockIdx.x - 32; u >= 0 && u < DECB * BKV; u += G - 32) attn_sample_unit(lds, QB, KB, VB, args.in[I_CKM], args.in[I_CVM], args.in[I_CKW], args.in[I_CVW], args.in[I_SINK], AM, u >> 2, u & 3, tid, wave, lane);
    xcd_barrier(bar);
    { EpiResPlain E{AB2, AB, SSQ, nullptr, (float*)(ws + WS_SLAB), 1.0f, DM / 64}; GEMM_PHASE_TS(EpiResPlain, E, AM, ws + WS_WBO, DM); }
    xcd_barrier(bar);
    resid_combine<false>(lds, AB2, AB, SSQ, RS, (const float*)(ws + WS_SLAB), 1.0f, nullptr, G, wave, gw, NGW, lane);
    xcd_barrier(bar);

    { EpiSwiglu<false> E{ACT, RS}; GEMM_PHASE(EpiSwiglu<false>, E, AB, ws + WS_W1 + 3 * SZ_W1, 2 * DFF, DM); }
    xcd_barrier(bar);
    { EpiResFinal E{AB, AB, SSQ, args.out, (float*)(ws + WS_SLAB), 0.5f, DFF / 64}; GEMM_PHASE_TS(EpiResFinal, E, ACT, ws + WS_W2 + 3 * SZ_W2, DFF); }
    xcd_barrier(bar);
    resid_combine<true>(lds, AB, AB, SSQ, RS, (const float*)(ws + WS_SLAB), 0.5f, args.out, G, wave, gw, NGW, lane);
}

extern "C" void kernel_launch(void* const* d_in, const int* in_sizes, int n_in, void* d_out, int out_size, void* d_ws, size_t ws_size, hipStream_t stream) {
    static int grid = 0;
    if (grid == 0) {
        if (n_in != 25 || (size_t)out_size != O_END || ws_size < WS_END) { fprintf(stderr, "kernel_launch: unexpected shapes (n_in %d, out %d vs %zu, ws %zu vs %zu); nothing launched\n", n_in, out_size, (size_t)O_END, ws_size, (size_t)WS_END); grid = -1; return; }
        int dev = 0, cus = 0, per_cu = 0;
        if (hipGetDevice(&dev) != hipSuccess || hipDeviceGetAttribute(&cus, hipDeviceAttributeMultiprocessorCount, dev) != hipSuccess) { grid = -1; return; }
        if (hipFuncSetAttribute((const void*)yoco_fwd, hipFuncAttributeMaxDynamicSharedMemorySize, LDS_BYTES) != hipSuccess) { fprintf(stderr, "kernel_launch: hipFuncSetAttribute failed\n"); grid = -1; return; }
        if (hipOccupancyMaxActiveBlocksPerMultiprocessor(&per_cu, (const void*)yoco_fwd, NWAVES * 64, LDS_BYTES) != hipSuccess || per_cu < 1) fprintf(stderr, "kernel_launch: occupancy query says %d\n", per_cu);
        (void)hipGetLastError();
        grid = cus;
    }
    if (grid < 0) return;
    (void)in_sizes;
    if (hipMemsetAsync((char*)d_ws + WS_CTL, 0, CTL_ZERO_BYTES, stream) != hipSuccess) return;
    Args a{};
    for (int i = 0; i < 25; ++i) a.in[i] = (const float*)d_in[i];
    a.out = (float*)d_out; a.ws = (unsigned char*)d_ws;
    hipLaunchKernelGGL(yoco_fwd, dim3(grid), dim3(NWAVES * 64), LDS_BYTES, stream, a);
}
```

```cpp
#include <hip/hip_runtime.h>
#include <cstdio>
#include <cstdint>
namespace pg8 {
#define PG8_LAS __attribute__((address_space(3)))
typedef unsigned short bf16_t;
typedef short bf16x8 __attribute__((ext_vector_type(8)));
typedef float f32x4 __attribute__((ext_vector_type(4)));
typedef unsigned u32x4 __attribute__((ext_vector_type(4)));
constexpr int BM = 256, BK = 64, HALF = 128, HTB = HALF * BK * 2  , STAGE_BYTES = 8 * HTB, NXCD = 8, WGM = 4;

__host__ __device__ __forceinline__ int lds_byte(int r, int c) { const int st = (r >> 4) * 2 + (c >> 5), rr = r & 15, cc = c & 31, ob = rr * 64 + cc * 2; return st * 1024 + (ob ^ (((ob >> 9) & 1) << 5)); }
__host__ __device__ __forceinline__ void stage_rc(int b, int& R, int& C) { const int st = b / 1024, sb = b % 1024, swz = sb ^ (((sb >> 9) & 1) << 5); R = (st >> 1) * 16 + swz / 64; C = (st & 1) * 32 + (swz % 64) / 2; }
__host__ __device__ __forceinline__ int perm32(int rho) { const int n = rho >> 4, i = rho & 15; return 8 * (i >> 2) + 4 * n + (i & 3); }

struct Unit { int pm, pn, koff, nt; };
struct Gemm { const bf16_t* A; const bf16_t* Bt; int M, N, K; };

struct StaticOrder {
    int nM, nN, nwg, G, c, nt0;
    __host__ __device__ void init(int M, int N, int G_, int c_) { nM = M / BM; nN = N / BM; nwg = nM * nN; G = G_; c = c_; }
    __host__ __device__ bool next(int i, Unit& u) const {
        const long L = (long)i * G + c; if (L >= nwg) return false;
        int wgid = (int)L; { const int q = nwg / NXCD, r = nwg % NXCD, xcd = wgid % NXCD, off = wgid / NXCD; wgid = (xcd < r ? xcd * (q + 1) : r * (q + 1) + (xcd - r) * q) + off; }
        const int nig = WGM * nN, gid = wgid / nig, fm = gid * WGM, gsz = (nM - fm) < WGM ? (nM - fm) : WGM;
        u.pm = fm + ((wgid % nig) % gsz); u.pn = (wgid % nig) / gsz; u.koff = 0; u.nt = nt0; return true;
    }
    __device__ __forceinline__ void a_ready(const Unit&) const {}
    __device__ __forceinline__ void done(const Unit&) const {}
};

__device__ __forceinline__ unsigned cvt_pk_bf16(float lo, float hi) { unsigned r; asm volatile("v_cvt_pk_bf16_f32 %0, %1, %2" : "=v"(r) : "v"(lo), "v"(hi)); return r; }
typedef float f32x2 __attribute__((ext_vector_type(2)));
template <class Epi, class Sched, bool ALIGN_EPI = false, bool SP2 = false, bool ABLK = false>
__device__ __forceinline__ void gemm_phase(PG8_LAS unsigned char* lds, const Gemm g, const Sched& S, const Epi& E) {
    int tid_l = threadIdx.x; asm volatile("" : "+v"(tid_l));
    const int tid = tid_l, wid = __builtin_amdgcn_readfirstlane(tid >> 6), lane = tid & 63, wr = wid >> 2, wc = wid & 3, fr = lane & 15, fq = lane >> 4;
    const int K = g.K, nt = K / BK;
    unsigned voffA[2], voffB[2];
#pragma unroll
    for (int i = 0; i < 2; ++i) { int R, C; stage_rc(tid * 16 + i * 8192, R, C); const int Rb = Epi::PERM ? ((R & ~31) + perm32(R & 31)) : R;
        voffA[i] = ABLK ? (unsigned)(R * BK + C) * 2u : (unsigned)(R * K + C) * 2u; voffB[i] = (unsigned)(Rb * K + C) * 2u; }
    const size_t kstep = (size_t)(BK * 2);
    const size_t hstep = (size_t)HALF * K * 2;
    const size_t tstep = 2 * hstep;
    const size_t kstepA = ABLK ? (size_t)(2 * HTB) : kstep, hstepA = ABLK ? (size_t)HTB : hstep, tstepA = ABLK ? (size_t)nt * (2 * HTB) : tstep;
    const unsigned ldsw = (unsigned)wid * 1024u;
    const int aoff = lds_byte(wr * 64 + fr, fq * 8), boff = lds_byte(wc * 32 + fr, fq * 8);
#define PG8_SA(b, h) (((b) * 2 + (h)) * HTB)
#define PG8_SB(b, h) ((4 + (b) * 2 + (h)) * HTB)
#define PG8_STAGE(bufoff, gbase, voff) do { _Pragma("unroll") for (int _i = 0; _i < 2; ++_i) \
        __builtin_amdgcn_global_load_lds((const unsigned*)((const char*)(gbase) + (voff)[_i]), (PG8_LAS unsigned*)(lds + (bufoff) + ldsw + _i * 8192), 16, 0, 0); } while (0)
#define PG8_LDA(dst, b, h) do { _Pragma("unroll") for (int m = 0; m < 4; ++m) _Pragma("unroll") for (int k = 0; k < 2; ++k) dst[m][k] = *(const PG8_LAS bf16x8*)(lds + PG8_SA(b, h) + aoff + m * 2048 + k * 1024); } while (0)
#define PG8_LDB(dst, b, h) do { _Pragma("unroll") for (int n = 0; n < 2; ++n) _Pragma("unroll") for (int k = 0; k < 2; ++k) dst[n][k] = *(const PG8_LAS bf16x8*)(lds + PG8_SB(b, h) + boff + n * 2048 + k * 1024); } while (0)
#define PG8_MMA(ai, bj, At, Bt) do { __builtin_amdgcn_s_setprio(1); _Pragma("unroll") for (int m = 0; m < 4; ++m) _Pragma("unroll") for (int n = 0; n < 2; ++n) _Pragma("unroll") for (int k = 0; k < 2; ++k) \
        acc[ai][bj][m][n] = __builtin_amdgcn_mfma_f32_16x16x32_bf16(Bt[n][k], At[m][k], acc[ai][bj][m][n], 0, 0, 0); __builtin_amdgcn_s_setprio(0); } while (0)
#define PG8_WAIT_V(n) asm volatile("s_waitcnt vmcnt(" #n ")" ::: "memory")
#define PG8_WAIT_L(n) asm volatile("s_waitcnt lgkmcnt(" #n ")" ::: "memory")
#define PG8_BAR __builtin_amdgcn_s_barrier()
#define PG8_SCHED __builtin_amdgcn_sched_barrier(0)
    Unit cur, nxt; int ui = 0;
    if (!S.next(0, cur)) return;
    f32x4 acc[2][2][4][2];
#pragma unroll
    for (int a = 0; a < 2; ++a)
#pragma unroll
        for (int b = 0; b < 2; ++b)
#pragma unroll
            for (int m = 0; m < 4; ++m)
#pragma unroll
                for (int n = 0; n < 2; ++n) acc[a][b][m][n] = (f32x4){0.f, 0.f, 0.f, 0.f};
    bf16x8 At[4][2], B0[2][2], B1[2][2];
    const char* cA = (const char*)g.A + (size_t)cur.pm * tstepA + (ABLK ? (size_t)(cur.koff / (BK * 2)) * (2 * HTB) : (size_t)cur.koff); const char* cB = (const char*)g.Bt + (size_t)cur.pn * tstep + cur.koff;
    S.a_ready(cur);
    if constexpr (SP2) {
        PG8_STAGE(PG8_SB(0, 0), cB, voffB); PG8_STAGE(PG8_SB(0, 1), cB + hstep, voffB); PG8_STAGE(PG8_SA(0, 0), cA, voffA); PG8_STAGE(PG8_SA(0, 1), cA + hstepA, voffA);
        if (wr == 1) PG8_BAR;
        PG8_WAIT_V(2); PG8_BAR;
        PG8_STAGE(PG8_SB(1, 0), cB + kstep, voffB); PG8_STAGE(PG8_SA(1, 0), cA + kstepA, voffA); PG8_STAGE(PG8_SB(1, 1), cB + hstep + kstep, voffB);
        PG8_WAIT_V(6); PG8_BAR;
    } else {
        PG8_STAGE(PG8_SB(0, 0), cB, voffB); PG8_STAGE(PG8_SA(0, 0), cA, voffA); PG8_STAGE(PG8_SB(0, 1), cB + hstep, voffB); PG8_STAGE(PG8_SA(0, 1), cA + hstepA, voffA);
        if (wr == 1) PG8_BAR;
        PG8_WAIT_V(4); PG8_BAR;
        PG8_STAGE(PG8_SB(1, 0), cB + kstep, voffB); PG8_STAGE(PG8_SA(1, 0), cA + kstepA, voffA); PG8_STAGE(PG8_SB(1, 1), cB + hstep + kstep, voffB);
        PG8_WAIT_V(6); PG8_BAR;
    }
    for (;;) {
        const bool has_next = S.next(ui + 1, nxt);
        const char* nA = has_next ? (const char*)g.A + (size_t)nxt.pm * tstepA + (ABLK ? (size_t)(nxt.koff / (BK * 2)) * (2 * HTB) : (size_t)nxt.koff) : cA; const char* nB = has_next ? (const char*)g.Bt + (size_t)nxt.pn * tstep + nxt.koff : cB;
        for (int t = 0; t < cur.nt; t += 2) {
            const bool last = (t == cur.nt - 2);
            const char* a1 = cA + (size_t)(t + 1) * kstepA;
            const char* a2 = last ? nA : cA + (size_t)(t + 2) * kstepA; const char* b2 = last ? nB : cB + (size_t)(t + 2) * kstep;
            const char* a3 = a2 + kstepA; const char* b3 = b2 + kstep;
            if (last && has_next) S.a_ready(nxt);
            if constexpr (SP2) {
            PG8_LDB(B0, 0, 0); PG8_LDB(B1, 0, 1); PG8_SCHED; PG8_LDA(At, 0, 0); PG8_STAGE(PG8_SA(1, 1), a1 + hstepA, voffA);
            PG8_WAIT_V(8); PG8_WAIT_L(0); PG8_BAR; PG8_MMA(0, 0, At, B0); PG8_MMA(0, 1, At, B1); PG8_BAR; PG8_SCHED;
            PG8_LDA(At, 0, 1); PG8_STAGE(PG8_SB(0, 0), b2, voffB); PG8_STAGE(PG8_SB(0, 1), b2 + hstep, voffB); PG8_STAGE(PG8_SA(0, 0), a2, voffA);
            PG8_WAIT_V(8); PG8_WAIT_L(0); PG8_BAR; PG8_MMA(1, 0, At, B0); PG8_MMA(1, 1, At, B1); PG8_BAR; PG8_SCHED;
            PG8_LDB(B0, 1, 0); PG8_LDB(B1, 1, 1); PG8_SCHED; PG8_LDA(At, 1, 0); PG8_STAGE(PG8_SA(0, 1), a2 + hstepA, voffA);
            PG8_WAIT_V(8); PG8_WAIT_L(0); PG8_BAR; PG8_MMA(0, 0, At, B0); PG8_MMA(0, 1, At, B1); PG8_BAR; PG8_SCHED;
            PG8_LDA(At, 1, 1); PG8_STAGE(PG8_SB(1, 0), b3, voffB); PG8_STAGE(PG8_SB(1, 1), b3 + hstep, voffB); PG8_STAGE(PG8_SA(1, 0), a3, voffA);
            PG8_WAIT_V(8); PG8_WAIT_L(0); PG8_BAR; PG8_MMA(1, 0, At, B0); PG8_MMA(1, 1, At, B1); PG8_BAR; PG8_SCHED;
            } else {
            PG8_LDB(B0, 0, 0); PG8_SCHED; PG8_LDA(At, 0, 0); PG8_STAGE(PG8_SA(1, 1), a1 + hstepA, voffA);
            PG8_WAIT_L(8); PG8_BAR; PG8_WAIT_L(0); PG8_MMA(0, 0, At, B0); PG8_BAR; PG8_SCHED;
            PG8_LDB(B1, 0, 1); PG8_STAGE(PG8_SB(0, 0), b2, voffB);
            PG8_BAR; PG8_WAIT_L(0); PG8_MMA(0, 1, At, B1); PG8_BAR;
            PG8_LDA(At, 0, 1); PG8_STAGE(PG8_SA(0, 0), a2, voffA);
            PG8_BAR; PG8_WAIT_L(0); PG8_MMA(1, 0, At, B0); PG8_BAR; PG8_SCHED;
            PG8_STAGE(PG8_SB(0, 1), b2 + hstep, voffB);
            PG8_WAIT_V(6); PG8_BAR; PG8_MMA(1, 1, At, B1); PG8_BAR;
            PG8_LDB(B0, 1, 0); PG8_SCHED; PG8_LDA(At, 1, 0); PG8_STAGE(PG8_SA(0, 1), a2 + hstepA, voffA);
            PG8_WAIT_L(8); PG8_BAR; PG8_WAIT_L(0); PG8_MMA(0, 0, At, B0); PG8_BAR; PG8_SCHED;
            PG8_LDB(B1, 1, 1); PG8_STAGE(PG8_SB(1, 0), b3, voffB);
            PG8_BAR; PG8_WAIT_L(0); PG8_MMA(0, 1, At, B1); PG8_BAR;
            PG8_LDA(At, 1, 1); PG8_STAGE(PG8_SA(1, 0), a3, voffA);
            PG8_BAR; PG8_WAIT_L(0); PG8_MMA(1, 0, At, B0); PG8_BAR; PG8_SCHED;
            PG8_STAGE(PG8_SB(1, 1), b3 + hstep, voffB);
            PG8_WAIT_V(6); PG8_BAR; PG8_MMA(1, 1, At, B1); PG8_BAR;
            }
        }
        if constexpr (ALIGN_EPI) { if (wr == 0) PG8_BAR; }
        if constexpr (!Epi::AFTER_DRAIN) { E(acc, cur, wr, wc, fr, fq); S.done(cur); }
        if (!has_next) break;
#pragma unroll
        for (int a = 0; a < 2; ++a)
#pragma unroll
            for (int b = 0; b < 2; ++b)
#pragma unroll
                for (int m = 0; m < 4; ++m)
#pragma unroll
                    for (int n = 0; n < 2; ++n) acc[a][b][m][n] = (f32x4){0.f, 0.f, 0.f, 0.f};
        cur = nxt; cA = nA; cB = nB; ++ui;
        if constexpr (ALIGN_EPI) { if (wr == 1) PG8_BAR; }
    }
    PG8_WAIT_V(0);
    if constexpr (!ALIGN_EPI) { if (wr == 0) PG8_BAR; }
    PG8_BAR;
    if constexpr (Epi::AFTER_DRAIN) { E.fused(acc, cur, wr, wc, fr, fq, lds, wid, lane); S.done(cur); }
#undef PG8_SA
#undef PG8_SB
#undef PG8_STAGE
#undef PG8_LDA
#undef PG8_LDB
#undef PG8_MMA
#undef PG8_WAIT_V
#undef PG8_WAIT_L
#undef PG8_BAR
#undef PG8_SCHED
}
}

constexpr int NWAVES = 8;
constexpr int DM = 2048, DFF = 5632, NBATCH = 8, SEQ = 2048, NMETA = 16, TP = SEQ + NMETA;
constexpr int DECB = 128, DECS = 4, MPR = NBATCH * TP  , MSM = DECB * DECS  , MREAL = MPR + MSM  , MP = 17152  ;
constexpr int AH = 4, ADK = 256, ADV = 512, NAIN = 6144, NAIN_PAD = 6400;
constexpr int BH = 32, BDH = 64, BKV = 4, WIN = 128;
constexpr float EPS = 1e-6f;

constexpr size_t MiB = 1u << 20;
constexpr size_t WS_CTL = 0, CTL_ZERO_BYTES = 1 * MiB;
constexpr size_t SZ_W1 = (size_t)2 * DFF * DM * 2, SZ_W2 = (size_t)DM * DFF * 2;
constexpr size_t WS_W1 = 1 * MiB;
constexpr size_t WS_W2 = WS_W1 + 4 * SZ_W1;
constexpr size_t WS_WAIN = WS_W2 + 4 * SZ_W2;
constexpr size_t WS_WAOUT = WS_WAIN + (size_t)NAIN_PAD * DM * 2;
constexpr size_t WS_WKV = WS_WAOUT + (size_t)DM * DM * 2;
constexpr size_t WS_WQ = WS_WKV + (size_t)512 * DM * 2;
constexpr size_t WS_WBO = WS_WQ + (size_t)DM * DM * 2;
constexpr size_t WS_H = WS_WBO + (size_t)DM * DM * 2;
constexpr size_t WS_AB = WS_H + (size_t)MP * DM * 4;
constexpr size_t WS_ACT = WS_AB + (size_t)MP * DM * 2;
constexpr size_t WS_QKVO = WS_ACT + (size_t)MP * DFF * 2;
constexpr size_t WS_HM = WS_QKVO + (size_t)MP * NAIN * 2;
constexpr size_t WS_AM = WS_HM + (size_t)MP * DM * 4;
constexpr size_t WS_QB = WS_HM;
constexpr size_t WS_KB = WS_AM + (size_t)MP * DM * 2;
constexpr size_t WS_VB = WS_KB + (size_t)MP * 256 * 2;
constexpr size_t WS_SSQ = WS_VB + (size_t)MP * 256 * 2;
constexpr size_t WS_HSSQ = WS_SSQ + (size_t)MP * 32 * 4;
constexpr size_t WS_GATES = WS_HSSQ + (size_t)MP * 32 * 4;
constexpr size_t WS_PF = WS_GATES + (size_t)MP * 8 * 4;
constexpr size_t WS_GA = WS_PF + (size_t)32 * 17 * 8 * 4 * 1024;
constexpr size_t WS_SLAB = WS_GA + (size_t)32 * 17 * 512 * 4;
constexpr size_t WS_AB2 = WS_SLAB + (size_t)24 * 4 * 65536 * 4;
constexpr size_t WS_SSQ2 = WS_AB2 + (size_t)MP * DM * 2;
constexpr size_t WS_RS = WS_SSQ2 + (size_t)MP * 32 * 4;
constexpr size_t WS_RS2 = WS_RS + (size_t)MP * 4;
constexpr size_t WS_END = WS_RS2 + (size_t)MP * 4;
constexpr int CW_BAR = 4096;
constexpr int CW_SQ = 7680;

constexpr size_t O_YP = 0, O_YS = O_YP + (size_t)NBATCH * SEQ * DM, O_CP = O_YS + (size_t)MSM * DM, O_NP = O_CP + (size_t)NBATCH * AH * ADK * ADV,
                 O_MP = O_NP + NBATCH * AH * ADK, O_KMP = O_MP + NBATCH * AH, O_VMP = O_KMP + NBATCH * NMETA * 256, O_KWP = O_VMP + NBATCH * NMETA * 256,
                 O_VWP = O_KWP + NBATCH * WIN * 256, O_CS = O_VWP + NBATCH * WIN * 256, O_NS = O_CS + (size_t)DECB * AH * ADK * ADV, O_MS = O_NS + DECB * AH * ADK,
                 O_KWS = O_MS + DECB * AH, O_VWS = O_KWS + (size_t)DECB * WIN * 256, O_END = O_VWS + (size_t)DECB * WIN * 256;

constexpr int SCR_BYTES = 143360;
constexpr int MISC_OFF = SCR_BYTES;
constexpr int LDS_BYTES = 147456;

#define GAS __attribute__((address_space(1)))
#define LAS __attribute__((address_space(3)))
typedef unsigned short bf16;
typedef unsigned v4u __attribute__((ext_vector_type(4)));
typedef unsigned v2u __attribute__((ext_vector_type(2)));
typedef float f32x4 __attribute__((ext_vector_type(4)));
typedef short bf16x8 __attribute__((ext_vector_type(8)));
#define LDS_WAIT() asm volatile("s_waitcnt lgkmcnt(0)" ::: "memory")
#define MFMA16(a, b, c) __builtin_amdgcn_mfma_f32_16x16x32_bf16((a), (b), (c), 0, 0, 0)
typedef __bf16 bf16n2 __attribute__((ext_vector_type(2)));
typedef float f32n2 __attribute__((ext_vector_type(2)));
__device__ __forceinline__ unsigned pk2(float lo, float hi) { const f32n2 v = {lo, hi}; return __builtin_bit_cast(unsigned, __builtin_convertvector(v, bf16n2)); }
__device__ __forceinline__ unsigned pk2m(float lo, float hi) { return pk2(lo, hi); }
__device__ __forceinline__ bf16 bf16_rne(float x) { return (bf16)(pk2(x, 0.f) & 0xffffu); }
__device__ __forceinline__ float bflo(unsigned w) { return __uint_as_float(w << 16); }
__device__ __forceinline__ float bfhi(unsigned w) { return __uint_as_float(w & 0xffff0000u); }
__device__ __forceinline__ unsigned bfel(const v4u& r, int e) { return (r[e >> 1] >> (16 * (e & 1))) & 0xffffu; }
__device__ __forceinline__ float wave_sum(float v) {
#pragma unroll
    for (int o = 1; o < 64; o <<= 1) v += __shfl_xor(v, o);
    return v;
}
#define XB_TMO      128
#define XB_XCNT(j)  (256  + 64 * (j))
#define XB_XSUB(j)  (1280 + 64 * (j))
#define XB_XGEN(j)  (2304 + 64 * (j))
#define XB_TOP      3328
#define XB_TOPGEN   3392
#define XCD_BAR_WORDS 3456
#define XB_SPIN_CAP (1u << 18)

__device__ __forceinline__ unsigned xb_ld(unsigned* p)              { return __hip_atomic_load(p, __ATOMIC_RELAXED, __HIP_MEMORY_SCOPE_AGENT); }
__device__ __forceinline__ unsigned xb_add(unsigned* p, unsigned v) { return __hip_atomic_fetch_add(p, v, __ATOMIC_RELAXED, __HIP_MEMORY_SCOPE_AGENT); }
__device__ __forceinline__ unsigned xb_xcc_id() { return (unsigned)__builtin_amdgcn_s_getreg((3 << 11) | 20) & 0xFu; }
#define XB_SPIN(cond, bar) do { unsigned _sp = 0; while (cond) { __builtin_amdgcn_s_sleep(1); \
    if ((++_sp & 255u) == 0u) { if (xb_ld(&(bar)[XB_TMO])) break; if (_sp > XB_SPIN_CAP) { atomicAdd(&(bar)[XB_TMO], 1u); break; } } } } while (0)

struct XcdBarrier {
    unsigned* bar; unsigned x;
    volatile LAS unsigned* st;
};

__device__ __forceinline__ XcdBarrier xcd_barrier_post(unsigned* bar, volatile LAS unsigned* st) {
    XcdBarrier b; b.bar = bar; b.x = xb_xcc_id(); b.st = st;
    if (threadIdx.x == 0) (void)xb_add(&bar[XB_XCNT(b.x)], 1u);
    return b;
}
__device__ __forceinline__ void xcd_barrier_complete(unsigned* bar, unsigned x, unsigned& nloc, unsigned& nx) {
    const unsigned G = gridDim.x * gridDim.y * gridDim.z;
    unsigned sum, cnt, mine, sp = 0u;
    for (;;) {
        sum = 0u; cnt = 0u; mine = 0u;
#pragma unroll
        for (unsigned j = 0; j < 16; ++j) { const unsigned c = xb_ld(&bar[XB_XCNT(j)]); sum += c; cnt += (c > 0u) ? 1u : 0u; mine = (j == x) ? c : mine; }
        if (sum == G) break;
        __builtin_amdgcn_s_sleep(1);
        if ((++sp & 255u) == 0u) { if (xb_ld(&bar[XB_TMO])) break; if (sp > XB_SPIN_CAP) { atomicAdd(&bar[XB_TMO], 1u); break; } }
    }
    nloc = mine > 0u ? mine : 1u; nx = cnt > 0u ? cnt : 1u;
}

__device__ __forceinline__ void xcd_barrier(const XcdBarrier& b) {
    asm volatile("s_waitcnt vmcnt(0)" ::: "memory");
    __syncthreads();
    if (threadIdx.x == 0) {
        unsigned* bar = b.bar;
        __builtin_amdgcn_s_waitcnt(0);
        unsigned nloc = b.st[0], nx = b.st[1];
        if (nloc == 0u) { xcd_barrier_complete(bar, b.x, nloc, nx); b.st[0] = nloc; b.st[1] = nx; }
        const unsigned old = xb_add(&bar[XB_XSUB(b.x)], 1u);
        const unsigned gen = old / nloc;
        if (old + 1u == (gen + 1u) * nloc) {
            __builtin_amdgcn_fence(__ATOMIC_RELEASE, "agent");
            asm volatile("s_waitcnt vmcnt(0)" ::: "memory");
            const unsigned og = xb_add(&bar[XB_TOP], 1u);
            const unsigned tg = og / nx;
            if (og + 1u == (tg + 1u) * nx) xb_add(&bar[XB_TOPGEN], 1u);
            else XB_SPIN(xb_ld(&bar[XB_TOPGEN]) == tg, bar);
            __builtin_amdgcn_fence(__ATOMIC_ACQUIRE, "agent");
            xb_add(&bar[XB_XGEN(b.x)], 1u);
            asm volatile("s_waitcnt vmcnt(0)" ::: "memory");
        } else {
            XB_SPIN(xb_ld(&bar[XB_XGEN(b.x)]) == gen, bar);
            __builtin_amdgcn_fence(__ATOMIC_ACQUIRE, "agent");
            asm volatile("s_waitcnt vmcnt(0)" ::: "memory");
        }
    }
    __syncthreads();
}

constexpr int CW_TMO = 0;
constexpr int CW_Q = 8192;
constexpr int CW_CNT = 16384, CNT_STRIDE = 80;
static_assert((CW_CNT + 13 * CNT_STRIDE * 64) * 4 <= (int)CTL_ZERO_BYTES && CW_Q + 13 * 8 * 64 <= CW_CNT, "CTL map");
#define FLOW_NONE 0xffffffffu
struct FlowOrder {
    int nM, nN, nwg, x; unsigned* q; const unsigned* dep; unsigned need; unsigned* pub; unsigned* tmo; volatile LAS unsigned* slot;
    static constexpr int MID_T = 4;
    int pend_pm; unsigned pend_t; int pend_kind;
    __device__ __forceinline__ void init(int N, unsigned xcc, unsigned* ctl, int phase, int dep_bank, unsigned need_, int pub_bank, volatile LAS unsigned* slot_) {
        nM = MP / 256; nN = N / 256; nwg = nM * nN; x = (int)(xcc & 7u); q = ctl + CW_Q + phase * 8 * 64;
        dep = dep_bank >= 0 ? ctl + CW_CNT + dep_bank * CNT_STRIDE * 64 : nullptr; need = need_;
        pub = pub_bank >= 0 ? ctl + CW_CNT + pub_bank * CNT_STRIDE * 64 : nullptr; tmo = ctl + CW_TMO; slot = slot_; pend_pm = -1; pend_t = 0u; pend_kind = 0; }
    __device__ __forceinline__ int lstart(int xx) const { const int q_ = nwg / 8, r = nwg % 8; return xx < r ? xx * (q_ + 1) : r * (q_ + 1) + (xx - r) * q_; }
    __device__ __forceinline__ unsigned lcount(int xx) const { return (unsigned)(nwg / 8 + (xx < nwg % 8 ? 1 : 0)); }
    static constexpr int WG = 2;
    __device__ __forceinline__ void decode(unsigned wgid, pg8::Unit& u) const { const int w = (int)wgid, nig = WG * nN, gid = w / nig, fm = gid * WG, gsz = (nM - fm) < WG ? (nM - fm) : WG;
        u.pm = fm + ((w % nig) % gsz); u.pn = (w % nig) / gsz; }
    __device__ __forceinline__ unsigned take(int xx) const { unsigned t = 0; if ((threadIdx.x & 63) == 0) t = __hip_atomic_fetch_add(q + 64 * xx, 1u, __ATOMIC_RELAXED, __HIP_MEMORY_SCOPE_AGENT);
        t = (unsigned)__builtin_amdgcn_readfirstlane((int)t); return t < lcount(xx) ? (unsigned)lstart(xx) + t : FLOW_NONE; }
    __device__ __forceinline__ unsigned steal() const {
        for (int k = 1; k < 8; ++k) { const int xx = (x + k) & 7;
            const unsigned h = (unsigned)__builtin_amdgcn_readfirstlane((int)__hip_atomic_load(q + 64 * xx, __ATOMIC_RELAXED, __HIP_MEMORY_SCOPE_AGENT)); if (h >= lcount(xx)) continue;
            const unsigned id = take(xx); if (id != FLOW_NONE) return id; }
        return FLOW_NONE; }
    __device__ __forceinline__ unsigned claim_blocking() const {
        if (__builtin_amdgcn_readfirstlane((int)slot[3]) == 0) { const unsigned id = take(x); if (id != FLOW_NONE) return id; if ((threadIdx.x & 63) == 0) slot[3] = 1u; }
        return steal(); }
    __device__ __forceinline__ void begin() const {
        if (threadIdx.x < 64) {
            if (threadIdx.x == 0) { slot[3] = 0u; slot[5] = 0u; }
            const unsigned u0 = claim_blocking(); const unsigned u1 = u0 != FLOW_NONE ? claim_blocking() : FLOW_NONE;
            if (threadIdx.x == 0) { slot[0] = u0; slot[1] = u1; slot[4] = 2u; if (u1 == FLOW_NONE) slot[5] = 1u; } }
        asm volatile("s_waitcnt lgkmcnt(0)" ::: "memory"); __builtin_amdgcn_s_barrier(); asm volatile("" ::: "memory"); }
    __device__ __forceinline__ bool peek(int i, pg8::Unit& u) const { const unsigned id = (unsigned)__builtin_amdgcn_readfirstlane((int)slot[i % 3]); if (id == FLOW_NONE) return false; decode(id, u); return true; }
    __device__ __forceinline__ void a_ready(const pg8::Unit& u, int prev_pm) const {
        if (dep == nullptr || u.pm == prev_pm) return;
        if (threadIdx.x < 64) {
            const unsigned long long t0 = __builtin_amdgcn_s_memrealtime(); unsigned polls = 0;
            while ((unsigned)__builtin_amdgcn_readfirstlane((int)__hip_atomic_load(dep + 64 * u.pm, __ATOMIC_RELAXED, __HIP_MEMORY_SCOPE_AGENT)) < need) {
                if ((++polls & 255u) == 0u && __builtin_amdgcn_readfirstlane((int)__hip_atomic_load(tmo, __ATOMIC_RELAXED, __HIP_MEMORY_SCOPE_AGENT)) != 0) break;
                if (__builtin_amdgcn_s_memrealtime() - t0 > 2000000ull) {
                    if (threadIdx.x == 0) { unsigned expect = 0u; __hip_atomic_compare_exchange_strong(tmo + 1, &expect, 0x600u | (unsigned)(u.pm & 0xff), __ATOMIC_RELAXED, __ATOMIC_RELAXED, __HIP_MEMORY_SCOPE_AGENT); __hip_atomic_store(tmo, 1u, __ATOMIC_RELAXED, __HIP_MEMORY_SCOPE_AGENT); }
                    break; }
                __builtin_amdgcn_s_sleep(2); }
            __builtin_amdgcn_fence(__ATOMIC_ACQUIRE, "agent");
            asm volatile("s_waitcnt vmcnt(0)" ::: "memory");
        }
        asm volatile("" ::: "memory"); __builtin_amdgcn_s_barrier(); asm volatile("" ::: "memory"); }
    __device__ __forceinline__ void done(const pg8::Unit& u) {
        if (pub) pend_pm = u.pm;
        if (threadIdx.x < 64) {
            const bool all_empty = __builtin_amdgcn_readfirstlane((int)slot[5]) != 0, own_empty = __builtin_amdgcn_readfirstlane((int)slot[3]) != 0;
            pend_kind = all_empty ? 0 : (own_empty ? 2 : 1);
            if (pend_kind == 1 && threadIdx.x == 0) pend_t = __hip_atomic_fetch_add(q + 64 * x, 1u, __ATOMIC_RELAXED, __HIP_MEMORY_SCOPE_AGENT); } }
    __device__ __forceinline__ void mid() {
        if (pend_pm < 0 && pend_kind == 0) return;
        asm volatile("s_waitcnt vmcnt(0)" ::: "memory");
        if (pend_pm >= 0) { if ((threadIdx.x & 63) == 0) __hip_atomic_fetch_add(pub + 64 * pend_pm, 1u, __ATOMIC_RELAXED, __HIP_MEMORY_SCOPE_AGENT); pend_pm = -1; }
        if (threadIdx.x < 64 && pend_kind != 0) {
            unsigned id = FLOW_NONE;
            if (pend_kind == 1) { const unsigned t = (unsigned)__builtin_amdgcn_readfirstlane((int)pend_t); if (t < lcount(x)) id = (unsigned)lstart(x) + t; else { if (threadIdx.x == 0) slot[3] = 1u; id = steal(); } }
            else id = steal();
            if (id == FLOW_NONE && threadIdx.x == 0) slot[5] = 1u;
            const unsigned ci = (unsigned)__builtin_amdgcn_readfirstlane((int)slot[4]);
            if (threadIdx.x == 0) { slot[ci % 3u] = id; slot[4] = ci + 1u; }
            pend_kind = 0; } }
    __device__ __forceinline__ void flush() {
        if (pend_pm >= 0) { if ((threadIdx.x & 63) == 0) __hip_atomic_fetch_add(pub + 64 * pend_pm, 1u, __ATOMIC_RELAXED, __HIP_MEMORY_SCOPE_AGENT); pend_pm = -1; } }
};
template <bool WT> __device__ __forceinline__ void st_b128(void* p, const v4u& v) { if constexpr (WT) asm volatile("global_store_dwordx4 %0, %1, off sc1" :: "v"(p), "v"(v) : "memory"); else *(v4u*)p = v; }
template <bool WT> __device__ __forceinline__ void st_b32(void* p, float v) { if constexpr (WT) asm volatile("global_store_dword %0, %1, off sc1" :: "v"(p), "v"(v) : "memory"); else *(float*)p = v; }

__device__ __forceinline__ void row_rscale8(const float* rs, int row0, float (&r8)[8]) {
#pragma unroll
    for (int ai = 0; ai < 2; ++ai)
#pragma unroll
        for (int m = 0; m < 4; ++m) r8[ai * 4 + m] = rs[row0 + ai * 128 + m * 16];
}
__device__ __forceinline__ float silu_f(float g) { return g * __builtin_amdgcn_rcpf(1.0f + __expf(-g)); }

typedef float f32x2 __attribute__((ext_vector_type(2)));
template <bool WT> struct EpiSwiglu {
    static constexpr bool PERM = true, AFTER_DRAIN = false;
    bf16* O; const float* rs;
    __device__ __forceinline__ void operator()(const f32x4 (&acc)[2][2][4][2], const pg8::Unit& u, int wr, int wc, int fr, int fq) const {
        const int row0 = u.pm * 256 + wr * 64 + fr, col0 = u.pn * 128 + wc * 32 + 8 * fq;
        float r8[8]; row_rscale8(rs, row0, r8);
#pragma unroll
        for (int ai = 0; ai < 2; ++ai)
#pragma unroll
            for (int m = 0; m < 4; ++m) {
                const int row = row0 + ai * 128 + m * 16;
                const float r1 = r8[ai * 4 + m] * 1.4426950408889634f, r2 = r8[ai * 4 + m] * 0.6931471805599453f;
                f32x2 o[4];
#pragma unroll
                for (int n = 0; n < 2; ++n)
#pragma unroll
                    for (int jp = 0; jp < 2; ++jp) {
                        const f32x2 g2 = (f32x2){acc[ai][0][m][n][2 * jp], acc[ai][0][m][n][2 * jp + 1]}, u2 = (f32x2){acc[ai][1][m][n][2 * jp], acc[ai][1][m][n][2 * jp + 1]};
                        const f32x2 t2 = g2 * r1;
                        f32x2 d2 = (f32x2){__builtin_amdgcn_exp2f(-t2.x), __builtin_amdgcn_exp2f(-t2.y)} + 1.0f;
                        const f32x2 s2 = (f32x2){__builtin_amdgcn_rcpf(d2.x), __builtin_amdgcn_rcpf(d2.y)};
                        o[2 * n + jp] = (t2 * s2) * (u2 * r2);
                    }
                v4u w; w.x = pk2(o[0].x, o[0].y); w.y = pk2(o[1].x, o[1].y); w.z = pk2(o[2].x, o[2].y); w.w = pk2(o[3].x, o[3].y);
                const int kt = u.pn * 2 + (wc >> 1), R = wr * 64 + m * 16 + fr, C = (wc & 1) * 32 + 8 * fq;
                st_b128<WT>(O + ((((size_t)u.pm * (DFF / 64) + kt) * 2 + ai) * 8192 + (size_t)R * 64 + C), w);
            }
    }
};
constexpr int TS_PM0 = 64, TS_PARTS = 4, TS_TILES = 24;
static_assert((DFF / TS_PARTS) % 128 == 0 && (DM / TS_PARTS) % 128 == 0, "split-K part depth");
typedef float f32x8 __attribute__((ext_vector_type(8)));
template <bool FINAL, bool WT> struct EpiResid {
    static constexpr bool PERM = true, AFTER_DRAIN = false;
    const bf16* HI; bf16* AB; float* ssq; float* out; float* slab; float sc; int nt_full;
    __device__ __forceinline__ void operator()(const f32x4 (&acc)[2][2][4][2], const pg8::Unit& u, int wr, int wc, int fr, int fq) const {
        const int row0 = u.pm * 256 + wr * 64 + fr, col0 = u.pn * 256 + wc * 32 + 8 * fq;
        if (u.nt != nt_full) {
            float* sp = slab + (size_t)((((u.pm - TS_PM0) * 8 + u.pn) * TS_PARTS) + u.koff / (u.nt * 128)) * 65536 + (size_t)(wr * 64 + fr) * 256 + wc * 32 + 8 * fq;
#pragma unroll
            for (int ai = 0; ai < 2; ++ai)
#pragma unroll
                for (int m = 0; m < 4; ++m)
#pragma unroll
                    for (int bj = 0; bj < 2; ++bj) { float* q = sp + (ai * 128 + m * 16) * 256 + bj * 128; *(f32x4*)q = acc[ai][bj][m][0]; *(f32x4*)(q + 4) = acc[ai][bj][m][1]; }
            return; }
        f32x8 ssv = (f32x8){0.f, 0.f, 0.f, 0.f, 0.f, 0.f, 0.f, 0.f};
#pragma unroll
        for (int ai = 0; ai < 2; ++ai) {
            v4u hbv[4][2];
#pragma unroll
            for (int m = 0; m < 4; ++m)
#pragma unroll
                for (int bj = 0; bj < 2; ++bj) hbv[m][bj] = *(const v4u*)(HI + (size_t)(row0 + ai * 128 + m * 16) * DM + col0 + bj * 128);
#pragma unroll
            for (int m = 0; m < 4; ++m) {
                const int row = row0 + ai * 128 + m * 16;
                float ss = 0.f;
                float* op = nullptr;
                if (FINAL) {
                    if (row < MPR) { const int b = row / TP, t = row - b * TP; if (t >= NMETA) op = out + O_YP + ((size_t)b * SEQ + (t - NMETA)) * DM + col0; }
                    else if (row < MREAL) op = out + O_YS + (size_t)(row - MPR) * DM + col0;
                }
#pragma unroll
                for (int bj = 0; bj < 2; ++bj) {
                    const v4u hb = hbv[m][bj];
                    const f32x4 h0 = (f32x4){bflo(hb.x), bfhi(hb.x), bflo(hb.y), bfhi(hb.y)}, h1 = (f32x4){bflo(hb.z), bfhi(hb.z), bflo(hb.w), bfhi(hb.w)};
                    const f32x4 n0 = h0 + acc[ai][bj][m][0] * sc, n1 = h1 + acc[ai][bj][m][1] * sc;
                    if (FINAL) { if (op) { *(f32x4*)(op + bj * 128) = n0; *(f32x4*)(op + bj * 128 + 4) = n1; } }
                    else {
                        v4u w; w.x = pk2(n0[0], n0[1]); w.y = pk2(n0[2], n0[3]); w.z = pk2(n1[0], n1[1]); w.w = pk2(n1[2], n1[3]);
                        st_b128<WT>(AB + (size_t)row * DM + col0 + bj * 128, w);
                        ss += (n0[0] * n0[0] + n0[1] * n0[1]) + (n0[2] * n0[2] + n0[3] * n0[3]) + (n1[0] * n1[0] + n1[1] * n1[1]) + (n1[2] * n1[2] + n1[3] * n1[3]);
                    }
                }
                ssv[ai * 4 + m] = ss;
            }
        }
        if (!FINAL) {
#pragma unroll
            for (int i = 0; i < 8; ++i) ssv[i] += __shfl_xor(ssv[i], 16);
#pragma unroll
            for (int i = 0; i < 8; ++i) ssv[i] += __shfl_xor(ssv[i], 32);
            if (fq == 0) {
#pragma unroll
                for (int i = 0; i < 8; ++i) st_b32<WT>(ssq + (size_t)(row0 + (i >> 2) * 128 + (i & 3) * 16) * 32 + u.pn * 4 + wc, ssv[i]); }
        }
    }
};
struct EpiQkvo {
    static constexpr bool PERM = true, AFTER_DRAIN = false;
    bf16* O; const float* rs; float* gates; const float* bias;
    __device__ __forceinline__ void operator()(const f32x4 (&acc)[2][2][4][2], const pg8::Unit& u, int wr, int wc, int fr, int fq) const {
        const int row0 = u.pm * 256 + wr * 64 + fr, col0 = u.pn * 256 + wc * 32 + 8 * fq;
        const bool gate_tile = (u.pn == NAIN / 256);
        float r8[8]; row_rscale8(rs, row0, r8);
#pragma unroll
        for (int i = 0; i < 8; ++i) asm volatile("" : "+v"(r8[i]));
#pragma unroll
        for (int ai = 0; ai < 2; ++ai)
#pragma unroll
            for (int m = 0; m < 4; ++m) {
                const int row = row0 + ai * 128 + m * 16;
                const float r = r8[ai * 4 + m];
                if (!gate_tile) {
#pragma unroll
                    for (int bj = 0; bj < 2; ++bj) { const f32x4 v0 = acc[ai][bj][m][0] * r, v1 = acc[ai][bj][m][1] * r;
                        v4u w; w.x = pk2(v0[0], v0[1]); w.y = pk2(v0[2], v0[3]); w.z = pk2(v1[0], v1[1]); w.w = pk2(v1[2], v1[3]);
                        *(v4u*)(O + (size_t)row * NAIN + col0 + bj * 128) = w; }
                } else if (wc == 0 && fq == 0) {
                    const f32x4 bi = *(const f32x4*)bias, bf = *(const f32x4*)(bias + 4);
                    const f32x4 xi = acc[ai][0][m][0] * r + bi, xf = acc[ai][0][m][1] * r + bf;
                    f32x4 gi, gf;
#pragma unroll
                    for (int j = 0; j < 4; ++j) { gi[j] = 15.0f * tanhf(xi[j] * (1.0f / 15.0f)); const float c = 15.0f * tanhf(xf[j] * (1.0f / 15.0f));
                        gf[j] = fminf(c, 0.f) - log1pf(expf(-fabsf(c))); }
                    *(f32x4*)(gates + (size_t)row * 8) = gi; *(f32x4*)(gates + (size_t)row * 8 + 4) = gf;
                }
            }
    }
};
struct EpiHead {
    static constexpr bool PERM = true, AFTER_DRAIN = false;
    bf16* O0; int ld0; bf16* O1; int ld1; int norm_tiles; const float* rs; const float* gain; float post; float* slab; int nt_full;
    __device__ __forceinline__ void operator()(const f32x4 (&acc)[2][2][4][2], const pg8::Unit& u, int wr, int wc, int fr, int fq) const {
        const int row0 = u.pm * 256 + wr * 64 + fr;
        if (u.nt != nt_full) {
            float* sp = slab + (size_t)((((u.pm - TS_PM0) * 8 + u.pn) * TS_PARTS) + u.koff / (u.nt * 128)) * 65536 + (size_t)(wr * 64 + fr) * 256 + wc * 32 + 8 * fq;
#pragma unroll
            for (int ai = 0; ai < 2; ++ai)
#pragma unroll
                for (int m = 0; m < 4; ++m)
#pragma unroll
                    for (int bj = 0; bj < 2; ++bj) { float* q = sp + (ai * 128 + m * 16) * 256 + bj * 128; *(f32x4*)q = acc[ai][bj][m][0]; *(f32x4*)(q + 4) = acc[ai][bj][m][1]; }
            return; }
        const bool normed = u.pn < norm_tiles;
        bf16* base = normed ? O0 + (size_t)u.pn * 256 : O1 + (size_t)(u.pn - norm_tiles) * 256;
        const int ld = normed ? ld0 : ld1;
        float r8[8]; row_rscale8(rs, row0, r8);
        f32x4 gn[2][2];
#pragma unroll
        for (int bj = 0; bj < 2; ++bj)
#pragma unroll
            for (int n = 0; n < 2; ++n) gn[bj][n] = normed ? *(const f32x4*)(gain + 32 * bj + 8 * fq + 4 * n) * post : (f32x4){1.f, 1.f, 1.f, 1.f};
#pragma unroll
        for (int ai = 0; ai < 2; ++ai)
#pragma unroll
            for (int m = 0; m < 4; ++m) {
                const int row = row0 + ai * 128 + m * 16;
                const float r = r8[ai * 4 + m];
                f32x4 x[2][2]; float ms = 0.f;
#pragma unroll
                for (int bj = 0; bj < 2; ++bj)
#pragma unroll
                    for (int n = 0; n < 2; ++n) { x[bj][n] = acc[ai][bj][m][n] * r; const f32x4 q = x[bj][n] * x[bj][n]; ms += (q[0] + q[1]) + (q[2] + q[3]); }
                ms += __shfl_xor(ms, 16); ms += __shfl_xor(ms, 32);
                const float inv = normed ? rsqrtf(ms * (1.0f / 64.0f) + EPS) : 1.0f;
#pragma unroll
                for (int bj = 0; bj < 2; ++bj) { const f32x4 v0 = x[bj][0] * inv * gn[bj][0], v1 = x[bj][1] * inv * gn[bj][1];
                    v4u w; w.x = pk2(v0[0], v0[1]); w.y = pk2(v0[2], v0[3]); w.z = pk2(v1[0], v1[1]); w.w = pk2(v1[2], v1[3]);
                    *(v4u*)(base + (size_t)row * ld + wc * 64 + 32 * bj + 8 * fq) = w; }
            }
    }
};

struct Args { const float* in[25]; float* out; unsigned char* ws; };
enum { I_XP = 0, I_XS, I_SC, I_SN, I_SM, I_CKM, I_CVM, I_CKW, I_CVW, I_META, I_FFNN, I_WFI, I_WFO, I_MIXN, I_WAI, I_BAG, I_AHN, I_WAO, I_KVN, I_WKV, I_KN, I_WQ, I_QN, I_SINK, I_WBO };
struct CvtItem { const float* lp; const float* gain; bf16* dp; int ldw; int valid; float scale; int K; };
constexpr int IT_W1 = (DM / 64) * (2 * DFF / 64), IT_W2 = (DFF / 64) * (DM / 64), IT_AIN = (DM / 64) * (NAIN_PAD / 64), IT_SQ = (DM / 64) * (DM / 64), IT_KV = (DM / 64) * (512 / 64);
constexpr int CVT_NITEMS = 4 * IT_W1 + 4 * IT_W2 + IT_AIN + IT_SQ + IT_KV + IT_SQ + IT_SQ;
__device__ __forceinline__ CvtItem cvt_decode(const Args& a, int it, int lane) {
    unsigned char* ws = a.ws; const int l16 = lane & 15, q = lane >> 4, nl = 4 * l16;
    CvtItem c; c.valid = 1; c.scale = 1.0f; c.gain = nullptr;
    int r = it, kb, n0, col; const float* W; bf16* dst;
    if (r < 4 * IT_W1) { const int f = r / IT_W1; r -= f * IT_W1; const int nblk = 2 * DFF / 64; kb = r / nblk; n0 = 64 * (r % nblk); const int tile = n0 >> 8, within = (n0 & 255) + nl;
        col = within < 128 ? 128 * tile + within : DFF + 128 * tile + (within - 128);
        W = a.in[I_WFI] + (size_t)f * DM * 2 * DFF; c.ldw = 2 * DFF; c.K = DM; c.gain = a.in[I_FFNN] + f * DM; dst = (bf16*)(ws + WS_W1 + f * SZ_W1); }
    else if ((r -= 4 * IT_W1) < 4 * IT_W2) { const int f = r / IT_W2; r -= f * IT_W2; const int nblk = DM / 64; kb = r / nblk; n0 = 64 * (r % nblk); col = n0 + nl;
        W = a.in[I_WFO] + (size_t)f * DFF * DM; c.ldw = DM; c.K = DFF; dst = (bf16*)(ws + WS_W2 + f * SZ_W2); }
    else if ((r -= 4 * IT_W2) < IT_AIN) { const int nblk = NAIN_PAD / 64; kb = r / nblk; n0 = 64 * (r % nblk); col = n0 + nl;
        c.valid = col < NAIN + 8 ? 1 : 0; if (!c.valid) col = 0; c.scale = (n0 >= 1024 && n0 < 2048) ? 0.0625f : 1.0f;
        W = a.in[I_WAI]; c.ldw = NAIN + 8; c.K = DM; c.gain = a.in[I_MIXN]; dst = (bf16*)(ws + WS_WAIN); }
    else if ((r -= IT_AIN) < IT_SQ) { const int nblk = DM / 64; kb = r / nblk; n0 = 64 * (r % nblk); col = n0 + nl; W = a.in[I_WAO]; c.ldw = DM; c.K = DM; dst = (bf16*)(ws + WS_WAOUT); }
    else if ((r -= IT_SQ) < IT_KV) { const int nblk = 512 / 64; kb = r / nblk; n0 = 64 * (r % nblk); const int d = n0 + nl, tile = d >> 8, within = d & 255, bj = within >> 7, wc = (within >> 5) & 3;
        col = 256 * tile + 64 * wc + 32 * bj + (within & 31); W = a.in[I_WKV]; c.ldw = 512; c.K = DM; c.gain = a.in[I_KVN]; dst = (bf16*)(ws + WS_WKV); }
    else if ((r -= IT_KV) < IT_SQ) { const int nblk = DM / 64; kb = r / nblk; n0 = 64 * (r % nblk); const int d = n0 + nl, tile = d >> 8, within = d & 255, bj = within >> 7, wc = (within >> 5) & 3;
        col = 256 * tile + 64 * wc + 32 * bj + (within & 31); W = a.in[I_WQ]; c.ldw = DM; c.K = DM; c.gain = a.in[I_MIXN] + DM; dst = (bf16*)(ws + WS_WQ); }
    else { r -= IT_SQ; const int nblk = DM / 64; kb = r / nblk; n0 = 64 * (r % nblk); col = n0 + nl; W = a.in[I_WBO]; c.ldw = DM; c.K = DM; dst = (bf16*)(ws + WS_WBO); }
    c.lp = W + (size_t)(64 * kb + q) * c.ldw + col;
    if (c.gain) c.gain += 64 * kb;
    c.dp = dst + (size_t)n0 * c.K + 64 * kb;
    return c;
}
__device__ __forceinline__ void cvt_load(const CvtItem& c, f32x4 (&r)[16]) {
#pragma unroll
    for (int i = 0; i < 16; ++i) r[i] = c.valid ? *(const f32x4*)(c.lp + (size_t)(4 * i) * c.ldw) : (f32x4){0.f, 0.f, 0.f, 0.f};
}
__device__ __forceinline__ void cvt_store(const CvtItem& c, const f32x4 (&r)[16], LAS float* scr, int lane) {
    const int l16 = lane & 15, q = lane >> 4;
#pragma unroll
    for (int i = 0; i < 16; ++i) { LAS float* s = scr + (4 * i + q) * 65 + 4 * l16; s[0] = r[i][0]; s[1] = r[i][1]; s[2] = r[i][2]; s[3] = r[i][3]; }
    LDS_WAIT(); asm volatile("" ::: "memory");
    const int ch = lane & 7;
    f32x4 g0 = (f32x4){c.scale, c.scale, c.scale, c.scale}, g1 = g0;
    if (c.gain) { g0 = *(const f32x4*)(c.gain + 8 * ch) * c.scale; g1 = *(const f32x4*)(c.gain + 8 * ch + 4) * c.scale; }
#pragma unroll
    for (int j = 0; j < 8; ++j) { const int n = (lane >> 3) + 8 * j; const LAS float* s = scr + (8 * ch) * 65 + n;
        v4u o; o.x = pk2(s[0 * 65] * g0[0], s[1 * 65] * g0[1]); o.y = pk2(s[2 * 65] * g0[2], s[3 * 65] * g0[3]); o.z = pk2(s[4 * 65] * g1[0], s[5 * 65] * g1[1]); o.w = pk2(s[6 * 65] * g1[2], s[7 * 65] * g1[3]);
        *(v4u*)(c.dp + (size_t)n * c.K + 8 * ch) = o; }
    LDS_WAIT(); asm volatile("" ::: "memory");
}

__device__ __forceinline__ void p0_prologue(const Args& a, LAS unsigned char* lds, int gw, int NGW, int wave, int lane) {
    LAS float* scr = (LAS float*)(lds + wave * 16640);
    unsigned char* ws = a.ws;
    {
        f32x4 r0[16], r1[16]; int it = gw;
        if (it < CVT_NITEMS) {
            CvtItem c0 = cvt_decode(a, it, lane); CvtItem c1 = cvt_decode(a, it, lane); cvt_load(c0, r0);
            for (;;) {
                it += NGW; const bool h1 = it < CVT_NITEMS; if (h1) { c1 = cvt_decode(a, it, lane); cvt_load(c1, r1); }
                cvt_store(c0, r0, scr, lane);
                if (!h1) break;
                it += NGW; const bool h0 = it < CVT_NITEMS; if (h0) { c0 = cvt_decode(a, it, lane); cvt_load(c0, r0); }
                cvt_store(c1, r1, scr, lane);
                if (!h0) break;
            }
        }
    }
    bf16* AB = (bf16*)(ws + WS_AB); float* RS = (float*)(ws + WS_RS);
    for (int rw0 = gw; rw0 < MP; rw0 += 2 * NGW) {
        f32x4 v0[2][4], v1[2][4];
#pragma unroll
        for (int q = 0; q < 2; ++q) { const int row = rw0 + q * NGW; const float* src = nullptr;
            if (row < MPR) { const int b = row / TP, t = row - b * TP; src = t < NMETA ? a.in[I_META] + (size_t)t * DM : a.in[I_XP] + ((size_t)b * SEQ + (t - NMETA)) * DM; }
            else if (row < MREAL) src = a.in[I_XS] + (size_t)(row - MPR) * DM;
#pragma unroll
            for (int j = 0; j < 4; ++j) { v0[q][j] = (f32x4){0.f, 0.f, 0.f, 0.f}; v1[q][j] = v0[q][j];
                if (src) { v0[q][j] = *(const f32x4*)(src + 512 * j + 8 * lane); v1[q][j] = *(const f32x4*)(src + 512 * j + 8 * lane + 4); } } }
#pragma unroll
        for (int q = 0; q < 2; ++q) { const int row = rw0 + q * NGW; if (row < MP) { float ss = 0.f;
#pragma unroll
            for (int j = 0; j < 4; ++j) {
                v4u w; w.x = pk2(v0[q][j][0], v0[q][j][1]); w.y = pk2(v0[q][j][2], v0[q][j][3]); w.z = pk2(v1[q][j][0], v1[q][j][1]); w.w = pk2(v1[q][j][2], v1[q][j][3]);
                *(v4u*)(AB + (size_t)row * DM + 512 * j + 8 * lane) = w;
                ss += (v0[q][j][0] * v0[q][j][0] + v0[q][j][1] * v0[q][j][1]) + (v0[q][j][2] * v0[q][j][2] + v0[q][j][3] * v0[q][j][3]) + (v1[q][j][0] * v1[q][j][0] + v1[q][j][1] * v1[q][j][1]) + (v1[q][j][2] * v1[q][j][2] + v1[q][j][3] * v1[q][j][3]);
            }
            ss = wave_sum(ss);
            if (lane == 0) RS[row] = rsqrtf(ss * (1.0f / DM) + EPS); } }
    }
}

constexpr int ML_KN = 0, ML_KNS = 272, ML_KT = 34816, ML_KTS = 272, ML_VT = 69632, ML_VTS = 272, ML_CTB = ML_VT + 80 * 272  , ML_CTBS = 528, ML_GA = ML_CTB + 80 * 528  ;
static_assert(ML_GA + 2816 <= SCR_BYTES, "mLSTM LDS map");

#define ML_HALF(DH) do { \
    _Pragma("unroll") for (int ks = 0; ks < 4; ++ks) { bf16x8 fa_[8]; \
        _Pragma("unroll") for (int jb = 0; jb < 8; ++jb) fa_[jb] = *(const LAS bf16x8*)(lds + ML_KN + (16 * jb + i16) * ML_KNS + (32 * ks + 8 * g) * 2); \
        _Pragma("unroll") for (int jb = 0; jb < 8; ++jb) as_[jb] = MFMA16(fa_[jb], qf[4 * (DH) + ks], as_[jb]); } \
    _Pragma("unroll") for (int vb = 0; vb < 5; ++vb) accC[DH][vb] = accC[DH][vb] * decay; \
    _Pragma("unroll") for (int ks = 0; ks < 4; ++ks) { bf16x8 fv_[5]; \
        const bf16x8 bfr = *(const LAS bf16x8*)(lds + ML_KT + (16 * wave + i16) * ML_KTS + (32 * ks + 8 * g) * 2); \
        _Pragma("unroll") for (int vb = 0; vb < 5; ++vb) fv_[vb] = *(const LAS bf16x8*)(lds + ML_VT + (16 * vb + i16) * ML_VTS + (32 * ks + 8 * g) * 2); \
        _Pragma("unroll") for (int vb = 0; vb < 5; ++vb) accC[DH][vb] = MFMA16(fv_[vb], bfr, accC[DH][vb]); } \
} while (0)
#define ML_PUT_CTB(DH) do { _Pragma("unroll") for (int vb = 0; vb < 5; ++vb) _Pragma("unroll") for (int r = 0; r < 4; ++r) \
    *(LAS bf16*)(lds + ML_CTB + (16 * vb + 4 * g + r) * ML_CTBS + (128 * (DH) + 16 * wave + i16) * 2) = bf16_rne(accC[DH][vb][r]); } while (0)
#define ML_LOAD_K_ISSUE(DH, R0, R1) do { _Pragma("unroll") for (int it = 0; it < 2; ++it) { const int dc = wave + 8 * it; \
    const bf16* kp = QKVO + (rowbase + 2 * lane) * NAIN + 1024 + h * ADK + 128 * (DH) + 8 * dc; R0[it] = *(const v4u*)kp; R1[it] = *(const v4u*)(kp + NAIN); } } while (0)
#define ML_LOAD_K_PUT(R0, R1) do { const float w0 = ga[512 + 2 * lane], w1 = ga[512 + 2 * lane + 1]; \
    _Pragma("unroll") for (int it = 0; it < 2; ++it) { const int dc = wave + 8 * it; \
    *(LAS v4u*)(lds + ML_KN + (2 * lane) * ML_KNS + 16 * dc) = R0[it]; *(LAS v4u*)(lds + ML_KN + (2 * lane + 1) * ML_KNS + 16 * dc) = R1[it]; \
    _Pragma("unroll") for (int e = 0; e < 8; ++e) *(LAS unsigned*)(lds + ML_KT + (8 * dc + e) * ML_KTS + 4 * lane) = pk2(__uint_as_float(bfel(R0[it], e) << 16) * w0, __uint_as_float(bfel(R1[it], e) << 16) * w1); } } while (0)

__device__ __forceinline__ void mlstm_prompt_unit(LAS unsigned char* lds, const bf16* QKVO, const float* GATES, float* HM, float* HSSQ, float* out, int b, int h, int j, int tid, int wave, int lane) {
    const int i16 = lane & 15, g = lane >> 4;
    LAS float* ga = (LAS float*)(lds + ML_GA);
    f32x4 accC[2][5];
#pragma unroll
    for (int dh = 0; dh < 2; ++dh)
#pragma unroll
        for (int vb = 0; vb < 5; ++vb) accC[dh][vb] = (f32x4){0.f, 0.f, 0.f, 0.f};
    __syncthreads();
    for (int o = tid * 16; o < 80 * ML_CTBS; o += 512 * 16) *(LAS v4u*)(lds + ML_CTB + o) = (v4u){0u, 0u, 0u, 0u};
    for (int o = tid; o < 16 * 64; o += 512) { const int rr = o >> 6, cc = o & 63; *(LAS unsigned*)(lds + ML_VT + (64 + rr) * ML_VTS + cc * 4) = rr == 0 ? 0x3F803F80u : 0u; }
    float m_prev = 0.f;
    for (int c = 0; c < 17; ++c) {
        const int tok0 = c == 0 ? 0 : NMETA + 128 * (c - 1), nvalid = c == 0 ? NMETA : 128;
        const size_t rowbase = (size_t)b * TP + tok0;
        __syncthreads();
        bf16x8 qf[8];
        { const bf16* qp = QKVO + (rowbase + 16 * wave + i16) * NAIN + h * ADK + 8 * g;
#pragma unroll
          for (int ks = 0; ks < 8; ++ks) qf[ks] = *(const bf16x8*)(qp + 32 * ks); }
        if (wave == 0) {
            const int t0 = 2 * lane, t1 = t0 + 1;
            float ig0 = -1e30f, ig1 = -1e30f, lf0 = 0.f, lf1 = 0.f;
            if (t0 < nvalid) { const float* gp = GATES + (rowbase + t0) * 8; ig0 = gp[h]; lf0 = gp[4 + h]; }
            if (t1 < nvalid) { const float* gp = GATES + (rowbase + t1) * 8; ig1 = gp[h]; lf1 = gp[4 + h]; }
            const float c1 = lf0 + lf1; float sc = c1;
#pragma unroll
            for (int o = 1; o < 64; o <<= 1) { const float t = __shfl_up(sc, o); if (lane >= o) sc += t; }
            const float excl = sc - c1, b0 = excl + lf0, b1 = excl + c1;
            const float a0 = ig0 - b0, a1 = ig1 - b1;
            float smx = fmaxf(a0, a1);
#pragma unroll
            for (int o = 1; o < 64; o <<= 1) { const float t = __shfl_up(smx, o); if (lane >= o) smx = fmaxf(smx, t); }
            float exm = __shfl_up(smx, 1); if (lane == 0) exm = -INFINITY;
            const float p0 = fmaxf(exm, a0), p1 = fmaxf(p0, a1);
            const float pm0 = fmaxf(m_prev, p0), pm1 = fmaxf(m_prev, p1);
            const float Mx = fmaxf(m_prev, __shfl(smx, 63)), blast = __shfl(b1, 63);
            ga[t0] = a0; ga[t1] = a1; ga[128 + t0] = pm0; ga[128 + t1] = pm1;
            ga[256 + t0] = __expf(m_prev - pm0); ga[256 + t1] = __expf(m_prev - pm1);
            ga[384 + t0] = __expf(-(b0 + pm0)); ga[384 + t1] = __expf(-(b1 + pm1));
            ga[512 + t0] = __expf(a0 - Mx); ga[512 + t1] = __expf(a1 - Mx);
            if (lane == 0) ga[640] = __expf(m_prev - Mx);
            m_prev = blast + Mx;
        }
        __syncthreads();
        {
            const bf16* vp = QKVO + (rowbase + 2 * lane) * NAIN + 2048 + h * ADV + 64 * j + 8 * wave;
            const v4u r0 = *(const v4u*)vp, r1 = *(const v4u*)(vp + NAIN);
            v4u ka[2], kb[2]; ML_LOAD_K_ISSUE(0, ka, kb);
#pragma unroll
            for (int e = 0; e < 8; ++e) *(LAS unsigned*)(lds + ML_VT + (8 * wave + e) * ML_VTS + 4 * lane) = bfel(r0, e) | (bfel(r1, e) << 16);
            ML_LOAD_K_PUT(ka, kb);
        }
        __syncthreads();
        const float decay = ga[640];
        f32x4 aqc[5], as_[8];
#pragma unroll
        for (int vb = 0; vb < 5; ++vb) aqc[vb] = (f32x4){0.f, 0.f, 0.f, 0.f};
#pragma unroll
        for (int ks = 0; ks < 8; ++ks) { bf16x8 fb_[5];
#pragma unroll
            for (int vb = 0; vb < 5; ++vb) fb_[vb] = *(const LAS bf16x8*)(lds + ML_CTB + (16 * vb + i16) * ML_CTBS + (32 * ks + 8 * g) * 2);
#pragma unroll
            for (int vb = 0; vb < 5; ++vb) aqc[vb] = MFMA16(qf[ks], fb_[vb], aqc[vb]); }
#pragma unroll
        for (int jb = 0; jb < 8; ++jb) as_[jb] = (f32x4){0.f, 0.f, 0.f, 0.f};
        ML_HALF(0);
        __syncthreads();
        { v4u ka[2], kb[2]; ML_LOAD_K_ISSUE(1, ka, kb);
          ML_PUT_CTB(0);
          ML_LOAD_K_PUT(ka, kb); }
        __syncthreads();
        ML_HALF(1);
        ML_PUT_CTB(1);
        const int tl = 16 * wave + i16; const float pmt = ga[128 + tl];
        bf16x8 pf[4];
#pragma unroll
        for (int kk = 0; kk < 4; ++kk) { float pv[8];
#pragma unroll
            for (int hb = 0; hb < 2; ++hb) { const int jb = 2 * kk + hb; const f32x4 av = *(const LAS f32x4*)(ga + 16 * jb + 4 * g);
#pragma unroll
                for (int r = 0; r < 4; ++r) { const int s = 16 * jb + 4 * g + r; const float wgt = (s <= tl) ? __expf(av[r] - pmt) : 0.f; pv[4 * hb + r] = as_[jb][r] * wgt; } }
            v4u w; w.x = pk2m(pv[0], pv[1]); w.y = pk2m(pv[2], pv[3]); w.z = pk2m(pv[4], pv[5]); w.w = pk2m(pv[6], pv[7]); pf[kk] = __builtin_bit_cast(bf16x8, w); }
        f32x4 apv[5];
#pragma unroll
        for (int vb = 0; vb < 5; ++vb) apv[vb] = (f32x4){0.f, 0.f, 0.f, 0.f};
#pragma unroll
        for (int kk = 0; kk < 4; ++kk) { v4u wv_[5];
#pragma unroll
            for (int vb = 0; vb < 5; ++vb) { const LAS unsigned char* vp = lds + ML_VT + (16 * vb + i16) * ML_VTS + (32 * kk + 4 * g) * 2;
                const v2u lo = *(const LAS v2u*)vp, hi = *(const LAS v2u*)(vp + 32); wv_[vb] = (v4u){lo.x, lo.y, hi.x, hi.y}; }
#pragma unroll
            for (int vb = 0; vb < 5; ++vb) apv[vb] = MFMA16(pf[kk], __builtin_bit_cast(bf16x8, wv_[vb]), apv[vb]); }
        const f32x4 wi4 = *(const LAS f32x4*)(ga + 256 + 16 * wave + 4 * g), ef4 = *(const LAS f32x4*)(ga + 384 + 16 * wave + 4 * g);
#pragma unroll
        for (int r = 0; r < 4; ++r) { const int tr = 16 * wave + 4 * g + r; const float wi = wi4[r];
            float den = apv[4][r] + wi * aqc[4][r]; den = __shfl(den, lane & 48); den = fmaxf(fabsf(den), ef4[r]);
            const float inv = 1.0f / den; float ss = 0.f; const bool ok = tr < nvalid;
#pragma unroll
            for (int vb = 0; vb < 4; ++vb) { const float hv = (apv[vb][r] + wi * aqc[vb][r]) * inv; ss += hv * hv;
                if (ok) HM[(rowbase + tr) * DM + h * ADV + 64 * j + 16 * vb + i16] = hv; }
            ss += __shfl_xor(ss, 1); ss += __shfl_xor(ss, 2); ss += __shfl_xor(ss, 4); ss += __shfl_xor(ss, 8);
            if (ok && i16 == 0) HSSQ[(rowbase + tr) * 32 + h * 8 + j] = ss; }
    }
    const size_t bh = (size_t)b * AH + h;
#pragma unroll
    for (int dh = 0; dh < 2; ++dh) { const int d = 128 * dh + 16 * wave + i16;
#pragma unroll
        for (int vb = 0; vb < 4; ++vb) *(f32x4*)(out + O_CP + (bh * ADK + d) * ADV + 64 * j + 16 * vb + 4 * g) = accC[dh][vb];
        if (j == 0 && g == 0) out[O_NP + bh * ADK + d] = accC[dh][4][0]; }
    if (j == 0 && tid == 0) out[O_MP + bh] = m_prev;
}

__device__ __forceinline__ void mlstm_sample_unit(LAS unsigned char* lds, const bf16* QKVO, const float* GATES, const float* stC, const float* stN, const float* stM,
                                                  float* HM, float* HSSQ, float* out, int b, int h, int tid, int wave, int lane) {
    LAS float* qT = (LAS float*)lds;
    LAS float* wkT = (LAS float*)(lds + 4096);
    LAS float* qN = (LAS float*)(lds + 8192);
    LAS float* kN = (LAS float*)(lds + 12288);
    LAS float* dots = (LAS float*)(lds + 16384);
    LAS float* red = (LAS float*)(lds + 16640);
    const int row0 = MPR + DECS * b; const size_t bh = (size_t)b * AH + h;
    float ig[4], bb[4], a_[4], pm[4], wint[4], efl[4], wst[4];
    const unsigned qq = *(const unsigned*)(QKVO + (size_t)(row0 + (tid >> 7)) * NAIN + h * ADK + (tid & 127) * 2), kk = *(const unsigned*)(QKVO + (size_t)(row0 + (tid >> 7)) * NAIN + h * ADK + (tid & 127) * 2 + 1024);
    v2u vw[4];
#pragma unroll
    for (int s = 0; s < 4; ++s) vw[s] = *(const v2u*)(QKVO + (size_t)(row0 + s) * NAIN + 2048 + h * ADV + 4 * (tid & 127));
    const float mprev = stM[bh];
    { float run = 0.f, pmax = -INFINITY;
#pragma unroll
      for (int s = 0; s < 4; ++s) { ig[s] = GATES[(size_t)(row0 + s) * 8 + h]; run += GATES[(size_t)(row0 + s) * 8 + 4 + h]; bb[s] = run; a_[s] = ig[s] - bb[s]; pmax = fmaxf(pmax, a_[s]);
          pm[s] = fmaxf(mprev, pmax); wint[s] = __expf(mprev - pm[s]); efl[s] = __expf(-(bb[s] + pm[s])); } }
    const float Mx = pm[3], decay = __expf(mprev - Mx), mnew = bb[3] + Mx;
#pragma unroll
    for (int s = 0; s < 4; ++s) wst[s] = __expf(a_[s] - Mx);
    __syncthreads();
    { const int s = tid >> 7, d2 = (tid & 127) * 2;
      const float q0 = bflo(qq), q1 = bfhi(qq), k0 = bflo(kk), k1 = bfhi(kk);
      const float w = s == 0 ? wst[0] : s == 1 ? wst[1] : s == 2 ? wst[2] : wst[3];
      qT[d2 * 4 + s] = q0; qT[(d2 + 1) * 4 + s] = q1; wkT[d2 * 4 + s] = w * k0; wkT[(d2 + 1) * 4 + s] = w * k1;
      qN[s * 256 + d2] = q0; qN[s * 256 + d2 + 1] = q1; kN[s * 256 + d2] = k0; kN[s * 256 + d2 + 1] = k1; }
    __syncthreads();
    for (int x = wave; x < 20; x += 8) { float p = 0.f;
        if (x < 16) { const int t = x >> 2, s = x & 3;
#pragma unroll
            for (int i = 0; i < 4; ++i) p += qN[t * 256 + lane + 64 * i] * kN[s * 256 + lane + 64 * i]; }
        else { const int t = x - 16;
#pragma unroll
            for (int i = 0; i < 4; ++i) p += qN[t * 256 + lane + 64 * i] * stN[bh * ADK + lane + 64 * i]; }
        p = wave_sum(p); if (lane == 0) dots[x] = p; }
    __syncthreads();
    float P[4][4], deninv[4];
#pragma unroll
    for (int t = 0; t < 4; ++t) { float den = 0.f;
#pragma unroll
        for (int s = 0; s < 4; ++s) { P[t][s] = s <= t ? dots[4 * t + s] * __expf(a_[s] - pm[t]) : 0.f; den += P[t][s]; }
        den += wint[t] * dots[16 + t]; deninv[t] = 1.0f / fmaxf(fabsf(den), efl[t]); }
    const int eq = tid & 127, dq = tid >> 7;
    f32x4 vv[4];
#pragma unroll
    for (int s = 0; s < 4; ++s) { const v2u w = vw[s]; vv[s] = (f32x4){bflo(w.x), bfhi(w.x), bflo(w.y), bfhi(w.y)}; }
    f32x4 qc[4];
#pragma unroll
    for (int t = 0; t < 4; ++t) qc[t] = (f32x4){0.f, 0.f, 0.f, 0.f};
    const float* Cin = stC + bh * ADK * ADV + 4 * eq; float* Cout = out + O_CS + bh * ADK * ADV + 4 * eq;
#pragma unroll 8
    for (int dd = 0; dd < 64; ++dd) { const int d = 64 * dq + dd;
        const f32x4 c = *(const f32x4*)(Cin + (size_t)d * ADV); const f32x4 q4 = *(const LAS f32x4*)(qT + 4 * d), k4 = *(const LAS f32x4*)(wkT + 4 * d);
#pragma unroll
        for (int t = 0; t < 4; ++t) qc[t] += c * q4[t];
        *(f32x4*)(Cout + (size_t)d * ADV) = c * decay + vv[0] * k4[0] + vv[1] * k4[1] + vv[2] * k4[2] + vv[3] * k4[3]; }
#pragma unroll
    for (int t = 0; t < 4; ++t) *(LAS f32x4*)(red + (dq * 4 + t) * 512 + 4 * eq) = qc[t];
    __syncthreads();
    { const int e = tid; float ve[4];
#pragma unroll
      for (int s = 0; s < 4; ++s) ve[s] = __uint_as_float((unsigned)QKVO[(size_t)(row0 + s) * NAIN + 2048 + h * ADV + e] << 16);
#pragma unroll
      for (int t = 0; t < 4; ++t) { const float qcs = (red[(0 * 4 + t) * 512 + e] + red[(1 * 4 + t) * 512 + e]) + (red[(2 * 4 + t) * 512 + e] + red[(3 * 4 + t) * 512 + e]);
          float pvv = 0.f;
#pragma unroll
          for (int s = 0; s < 4; ++s) pvv += P[t][s] * ve[s];
          const float hv = (pvv + wint[t] * qcs) * deninv[t];
          HM[(size_t)(row0 + t) * DM + h * ADV + e] = hv;
          const float ss = wave_sum(hv * hv); if (lane == 0) HSSQ[(size_t)(row0 + t) * 32 + h * 8 + wave] = ss; } }
    if (tid < ADK) { const f32x4 k4 = *(const LAS f32x4*)(wkT + 4 * tid); out[O_NS + bh * ADK + tid] = decay * stN[bh * ADK + tid] + ((k4[0] + k4[1]) + (k4[2] + k4[3])); }
    if (tid == 0) out[O_MS + bh] = mnew;
}

__device__ __forceinline__ void mlstm_gate_rows(const float* HM, const float* HSSQ, const bf16* QKVO, const float* gain, bf16* AM, int gw, int NGW, int lane) {
    f32x4 g0[4], g1[4];
#pragma unroll
    for (int i = 0; i < 4; ++i) { g0[i] = *(const f32x4*)(gain + 512 * i + 8 * lane); g1[i] = *(const f32x4*)(gain + 512 * i + 8 * lane + 4); }
    for (int row0 = 2 * gw; row0 < MREAL; row0 += 2 * NGW) {
        f32x4 s0[2][4], s1[2][4], h0[2][4], h1[2][4]; v4u ow[2][4];
#pragma unroll
        for (int q = 0; q < 2; ++q) { const int row = row0 + q < MREAL ? row0 + q : row0;
#pragma unroll
            for (int i = 0; i < 4; ++i) { const int c = 512 * i + 8 * lane;
                s0[q][i] = *(const f32x4*)(HSSQ + (size_t)row * 32 + 8 * i); s1[q][i] = *(const f32x4*)(HSSQ + (size_t)row * 32 + 8 * i + 4);
                h0[q][i] = *(const f32x4*)(HM + (size_t)row * DM + c); h1[q][i] = *(const f32x4*)(HM + (size_t)row * DM + c + 4);
                ow[q][i] = *(const v4u*)(QKVO + (size_t)row * NAIN + 4096 + c); } }
#pragma unroll
        for (int q = 0; q < 2; ++q) { const int row = row0 + q; if (row < MREAL) {
#pragma unroll
            for (int i = 0; i < 4; ++i) {
                const float rs = rsqrtf((((s0[q][i][0] + s0[q][i][1]) + (s0[q][i][2] + s0[q][i][3])) + ((s1[q][i][0] + s1[q][i][1]) + (s1[q][i][2] + s1[q][i][3]))) * (1.0f / ADV) + EPS);
                float o[8];
#pragma unroll
                for (int e = 0; e < 8; ++e) { const float ov = __uint_as_float(bfel(ow[q][i], e) << 16); const float sg = __builtin_amdgcn_rcpf(1.0f + __expf(-ov));
                    const float hv = e < 4 ? h0[q][i][e & 3] * g0[i][e & 3] : h1[q][i][e & 3] * g1[i][e & 3]; o[e] = hv * rs * sg; }
                v4u w; w.x = pk2(o[0], o[1]); w.y = pk2(o[2], o[3]); w.z = pk2(o[4], o[5]); w.w = pk2(o[6], o[7]);
                *(v4u*)(AM + (size_t)row * DM + 512 * i + 8 * lane) = w; } } }
    }
}

template <int NKEY> struct AttnLds { static constexpr int KNS = 144, KN = 0, VT = NKEY * 144, VTS = NKEY * 2 + 16, END = VT + 64 * VTS; };

struct AttnMask { int rel0, lim, mrel;
    __device__ __forceinline__ bool operator()(int jj, int blk, int r, float& dist) const {
        if (jj == 0) { dist = (float)WIN; return mrel - r >= WIN; }
        const int rel = rel0 - 16 * blk - r; dist = (float)rel; return (unsigned)rel <= (unsigned)lim; } };
struct MaskGen { AttnMask m; float slope;
    __device__ __forceinline__ float apply(int jj, int blk, int r, float s) const { float dist; const bool ok = m(jj, blk, r, dist); return ok ? s - slope * dist : -INFINITY; }
    __device__ __forceinline__ float shift() const { return 0.f; } };
struct MaskFast { float u[4], s16, m0, sh; int relT;
    __device__ __forceinline__ void init(float slope, int lane) { const int i16 = lane & 15, g = lane >> 4;
#pragma unroll
        for (int r = 0; r < 4; ++r) u[r] = slope * (float)(4 * g + r);
        s16 = 16.0f * slope; m0 = slope * (float)(16 + i16); sh = slope * (float)(144 + i16); relT = 144 + i16 - 4 * g; }
    __device__ __forceinline__ float apply(int jj, int, int r, float s) const {
        if (jj == 0) return s + m0;
        const float v = (s + u[r]) + s16 * (float)jj;
        if (jj == 1) return relT - 16 - r <= WIN - 1 ? v : -INFINITY;
        if (jj == 9) return relT - 144 - r >= 0 ? v : -INFINITY;
        return v; }
    __device__ __forceinline__ float shift() const { return sh; } };
template <int NKEY, int NJB, class MaskF, class BlkF>
__device__ __forceinline__ void attn_tblock(LAS unsigned char* lds, const bf16x8 qf0, const bf16x8 qf1, float sink_in, const MaskF& mask, const BlkF& blk,
                                            bf16* orow  , int nq_valid, int lane) {
    typedef AttnLds<NKEY> L;
    const int i16 = lane & 15, g = lane >> 4;
    f32x4 sacc[NJB];
#pragma unroll
    for (int jb = 0; jb < NJB; ++jb) { sacc[jb] = (f32x4){0.f, 0.f, 0.f, 0.f};
        const LAS unsigned char* kp = lds + L::KN + (16 * blk(jb) + i16) * L::KNS + 16 * g;
        sacc[jb] = MFMA16(*(const LAS bf16x8*)kp, qf0, sacc[jb]); sacc[jb] = MFMA16(*(const LAS bf16x8*)(kp + 64), qf1, sacc[jb]); }
    const float sink = sink_in + mask.shift();
    float mx = sink;
#pragma unroll
    for (int jb = 0; jb < NJB; ++jb)
#pragma unroll
        for (int r = 0; r < 4; ++r) { const float sv = mask.apply(jb, blk(jb), r, sacc[jb][r]); sacc[jb][r] = sv; mx = fmaxf(mx, sv); }
    mx = fmaxf(mx, __shfl_xor(mx, 16)); mx = fmaxf(mx, __shfl_xor(mx, 32));
    float sum = 0.f;
#pragma unroll
    for (int jb = 0; jb < NJB; ++jb)
#pragma unroll
        for (int r = 0; r < 4; ++r) { const float p = __expf(sacc[jb][r] - mx); sacc[jb][r] = p; sum += p; }
    sum += __shfl_xor(sum, 16); sum += __shfl_xor(sum, 32);
    sum += __expf(sink - mx);
    const float inv = 1.0f / sum;
    f32x4 oacc[4];
#pragma unroll
    for (int db = 0; db < 4; ++db) oacc[db] = (f32x4){0.f, 0.f, 0.f, 0.f};
#pragma unroll
    for (int kk = 0; kk < NJB / 2; ++kk) {
        v4u w; w.x = pk2m(sacc[2 * kk][0], sacc[2 * kk][1]); w.y = pk2m(sacc[2 * kk][2], sacc[2 * kk][3]); w.z = pk2m(sacc[2 * kk + 1][0], sacc[2 * kk + 1][1]); w.w = pk2m(sacc[2 * kk + 1][2], sacc[2 * kk + 1][3]);
        const bf16x8 pf = __builtin_bit_cast(bf16x8, w);
#pragma unroll
        for (int db = 0; db < 4; ++db) { const LAS unsigned char* vp = lds + L::VT + (16 * db + i16) * L::VTS + 8 * g;
            const v2u lo = *(const LAS v2u*)(vp + 32 * blk(2 * kk)), hi = *(const LAS v2u*)(vp + 32 * blk(2 * kk + 1)); const v4u bw = (v4u){lo.x, lo.y, hi.x, hi.y};
            oacc[db] = MFMA16(__builtin_bit_cast(bf16x8, bw), pf, oacc[db]); } }
    if (i16 < nq_valid) {
#pragma unroll
        for (int db = 0; db < 4; ++db) { const f32x4 o = oacc[db] * inv; v2u w; w.x = pk2(o[0], o[1]); w.y = pk2(o[2], o[3]); *(v2u*)(orow + (size_t)i16 * DM + 16 * db + 4 * g) = w; } }
}

__device__ __forceinline__ void attn_prompt_unit(LAS unsigned char* lds, const bf16* QB, const bf16* KB, const bf16* VB, const float* sinks, bf16* AM, int b, int g, int n, int tid, int wave, int lane) {
    typedef AttnLds<288> L;
    const int hh = 8 * g + wave; const float slope = exp2f(-0.25f * (float)(hh + 1)), sink = sinks[hh];
    const bf16* qbase = QB + ((size_t)b * TP + 128 * n + (lane & 15)) * DM + hh * 64 + 8 * (lane >> 4);
    bf16x8 q0 = *(const bf16x8*)qbase, q1 = *(const bf16x8*)(qbase + 32);
    __syncthreads();
    { v4u kr[5], vr0[3], vr1[3];
#pragma unroll
      for (int i = 0; i < 5; ++i) { const int it = tid + 512 * i, kk = it >> 3, ch = it & 7; const int pos = kk < NMETA ? kk : 128 * (n - 1) + kk - NMETA; kr[i] = (v4u){0u, 0u, 0u, 0u};
          if (it < 288 * 8 && kk < NMETA + 256 && pos >= 0 && pos < TP) kr[i] = *(const v4u*)(KB + ((size_t)b * TP + pos) * 256 + g * 64 + 8 * ch); }
#pragma unroll
      for (int i = 0; i < 3; ++i) { const int it = tid + 512 * i, ch = it / 144, p = it - ch * 144; vr0[i] = (v4u){0u, 0u, 0u, 0u}; vr1[i] = vr0[i];
          if (it < 144 * 8) {
              { const int kk = 2 * p, pos = kk < NMETA ? kk : 128 * (n - 1) + kk - NMETA; if (kk < NMETA + 256 && pos >= 0 && pos < TP) vr0[i] = *(const v4u*)(VB + ((size_t)b * TP + pos) * 256 + g * 64 + 8 * ch); }
              { const int kk = 2 * p + 1, pos = kk < NMETA ? kk : 128 * (n - 1) + kk - NMETA; if (kk < NMETA + 256 && pos >= 0 && pos < TP) vr1[i] = *(const v4u*)(VB + ((size_t)b * TP + pos) * 256 + g * 64 + 8 * ch); } } }
#pragma unroll
      for (int i = 0; i < 5; ++i) { const int it = tid + 512 * i, kk = it >> 3, ch = it & 7; if (it < 288 * 8) *(LAS v4u*)(lds + L::KN + kk * L::KNS + 16 * ch) = kr[i]; }
#pragma unroll
      for (int i = 0; i < 3; ++i) { const int it = tid + 512 * i, ch = it / 144, p = it - ch * 144;
          if (it < 144 * 8) {
#pragma unroll
              for (int e = 0; e < 8; ++e) *(LAS unsigned*)(lds + L::VT + (8 * ch + e) * L::VTS + 4 * p) = bfel(vr0[i], e) | (bfel(vr1[i], e) << 16); } } }
    __syncthreads();
    MaskFast mf; mf.init(slope, lane);
    for (int tb = 0; tb < 8; ++tb) { const int tpos0 = 128 * n + 16 * tb; if (tpos0 >= TP) break;
        const size_t row0 = (size_t)b * TP + tpos0;
        const int tbn = (tb < 7 && tpos0 + 16 < TP) ? tb + 1 : tb;
        const bf16x8 n0 = *(const bf16x8*)(qbase + (size_t)tbn * 16 * DM), n1 = *(const bf16x8*)(qbase + (size_t)tbn * 16 * DM + 32);
        __builtin_amdgcn_sched_barrier(0);
        const auto blk = [tb](int jj) { return jj == 0 ? 0 : tb + jj; };
        if (n >= 2) attn_tblock<288, 10>(lds, q0, q1, sink, mf, blk, AM + row0 * DM + hh * 64, 16, lane);
        else { const int tpos = tpos0 + (lane & 15);
            const MaskGen mk{AttnMask{tpos - 128 * (n - 1) + NMETA - 4 * (lane >> 4), tpos < WIN - 1 ? tpos : WIN - 1, tpos - 4 * (lane >> 4)}, slope};
            attn_tblock<288, 10>(lds, q0, q1, sink, mk, blk, AM + row0 * DM + hh * 64, 16, lane); }
        q0 = n0; q1 = n1; }
}
__device__ __forceinline__ void attn_sample_unit(LAS unsigned char* lds, const bf16* QB, const bf16* KB, const bf16* VB, const float* ckm, const float* cvm, const float* ckw, const float* cvw,
                                                 const float* sinks, bf16* AM, int b, int g, int tid, int wave, int lane) {
    typedef AttnLds<160> L;
    const int hh = 8 * g + wave; const float slope = exp2f(-0.25f * (float)(hh + 1)), sink = sinks[hh];
    const size_t row0 = (size_t)MPR + DECS * b;
    const bf16* qbase = QB + (row0 + (lane & 15)) * DM + hh * 64 + 8 * (lane >> 4);
    const bf16x8 q0 = *(const bf16x8*)qbase, q1 = *(const bf16x8*)(qbase + 32);
    __syncthreads();
    { f32x4 kf0[3], kf1[3]; v4u kn[3];
#pragma unroll
      for (int i = 0; i < 3; ++i) { const int it = tid + 512 * i, kk = it >> 3, ch = it & 7; kf0[i] = (f32x4){0.f, 0.f, 0.f, 0.f}; kf1[i] = kf0[i]; kn[i] = (v4u){0u, 0u, 0u, 0u};
          if (it < 160 * 8) {
              if (kk < NMETA + WIN) { const float* src = kk < NMETA ? ckm + (((size_t)b * NMETA + kk) * BKV + g) * 64 + 8 * ch : ckw + (((size_t)b * WIN + (kk - NMETA)) * BKV + g) * 64 + 8 * ch;
                  kf0[i] = *(const f32x4*)src; kf1[i] = *(const f32x4*)(src + 4); }
              else if (kk < NMETA + WIN + DECS) kn[i] = *(const v4u*)(KB + ((size_t)MPR + DECS * b + (kk - NMETA - WIN)) * 256 + g * 64 + 8 * ch); } }
      f32x4 vf0[2][2], vf1[2][2]; v4u vn[2][2];
#pragma unroll
      for (int i = 0; i < 2; ++i) { const int it = tid + 512 * i, ch = it / 80, p = it - ch * 80;
#pragma unroll
          for (int q = 0; q < 2; ++q) { const int kk = 2 * p + q; vf0[i][q] = (f32x4){0.f, 0.f, 0.f, 0.f}; vf1[i][q] = vf0[i][q]; vn[i][q] = (v4u){0u, 0u, 0u, 0u};
              if (it < 80 * 8) {
                  if (kk < NMETA + WIN) { const float* src = kk < NMETA ? cvm + (((size_t)b * NMETA + kk) * BKV + g) * 64 + 8 * ch : cvw + (((size_t)b * WIN + (kk - NMETA)) * BKV + g) * 64 + 8 * ch;
                      vf0[i][q] = *(const f32x4*)src; vf1[i][q] = *(const f32x4*)(src + 4); }
                  else if (kk < NMETA + WIN + DECS) vn[i][q] = *(const v4u*)(VB + ((size_t)MPR + DECS * b + (kk - NMETA - WIN)) * 256 + g * 64 + 8 * ch); } } }
#pragma unroll
      for (int i = 0; i < 3; ++i) { const int it = tid + 512 * i, kk = it >> 3, ch = it & 7;
          if (it < 160 * 8) { v4u r = kn[i];
              if (kk < NMETA + WIN) { r.x = pk2(kf0[i][0], kf0[i][1]); r.y = pk2(kf0[i][2], kf0[i][3]); r.z = pk2(kf1[i][0], kf1[i][1]); r.w = pk2(kf1[i][2], kf1[i][3]); }
              *(LAS v4u*)(lds + L::KN + kk * L::KNS + 16 * ch) = r; } }
#pragma unroll
      for (int i = 0; i < 2; ++i) { const int it = tid + 512 * i, ch = it / 80, p = it - ch * 80;
          if (it < 80 * 8) { v4u rr[2];
#pragma unroll
              for (int q = 0; q < 2; ++q) { const int kk = 2 * p + q; v4u r = vn[i][q];
                  if (kk < NMETA + WIN) { r.x = pk2(vf0[i][q][0], vf0[i][q][1]); r.y = pk2(vf0[i][q][2], vf0[i][q][3]); r.z = pk2(vf1[i][q][0], vf1[i][q][1]); r.w = pk2(vf1[i][q][2], vf1[i][q][3]); }
                  rr[q] = r; }
#pragma unroll
              for (int e = 0; e < 8; ++e) *(LAS unsigned*)(lds + L::VT + (8 * ch + e) * L::VTS + 4 * p) = bfel(rr[0], e) | (bfel(rr[1], e) << 16); } } }
    __syncthreads();
    const MaskGen mk{AttnMask{WIN + (lane & 15) + NMETA - 4 * (lane >> 4), WIN - 1, 1 << 20}, slope};
    const auto blk = [](int jj) { return jj; };
    attn_tblock<160, 10>(lds, q0, q1, sink, mk, blk, AM + row0 * DM + hh * 64, DECS, lane);
}
__device__ __forceinline__ void kv_outputs(const Args& a, const bf16* KB, const bf16* VB, size_t gtid, size_t gthreads) {
    float* out = a.out;
    for (size_t i = gtid; i < (size_t)NBATCH * (NMETA + WIN) * 256; i += gthreads) { const int c = (int)(i & 255); const int rr = (int)(i >> 8); const int b = rr / (NMETA + WIN), q = rr - b * (NMETA + WIN);
        const int t = q < NMETA ? q : TP - WIN + (q - NMETA); const size_t src = ((size_t)b * TP + t) * 256 + c;
        const float kv = __uint_as_float((unsigned)KB[src] << 16), vv = __uint_as_float((unsigned)VB[src] << 16);
        if (q < NMETA) { out[O_KMP + ((size_t)b * NMETA + q) * 256 + c] = kv; out[O_VMP + ((size_t)b * NMETA + q) * 256 + c] = vv; }
        else { out[O_KWP + ((size_t)b * WIN + (q - NMETA)) * 256 + c] = kv; out[O_VWP + ((size_t)b * WIN + (q - NMETA)) * 256 + c] = vv; } }
    for (size_t i = gtid; i < (size_t)DECB * WIN * 64; i += gthreads) { const int c4 = (int)(i & 63) * 4; const int rr = (int)(i >> 6); const int b = rr >> 7, jj = rr & 127;
        f32x4 kv, vv;
        if (jj < WIN - DECS) { kv = *(const f32x4*)(a.in[I_CKW] + ((size_t)b * WIN + jj + DECS) * 256 + c4); vv = *(const f32x4*)(a.in[I_CVW] + ((size_t)b * WIN + jj + DECS) * 256 + c4); }
        else { const size_t src = ((size_t)MPR + DECS * b + (jj - (WIN - DECS))) * 256 + c4; const v2u kw = *(const v2u*)(KB + src), vw = *(const v2u*)(VB + src);
            kv = (f32x4){bflo(kw.x), bfhi(kw.x), bflo(kw.y), bfhi(kw.y)}; vv = (f32x4){bflo(vw.x), bfhi(vw.x), bflo(vw.y), bfhi(vw.y)}; }
        *(f32x4*)(out + O_KWS + ((size_t)b * WIN + jj) * 256 + c4) = kv; *(f32x4*)(out + O_VWS + ((size_t)b * WIN + jj) * 256 + c4) = vv; }
}

struct TailSplitOrder {
    pg8::StaticOrder mo; int G, c, kp;
    __device__ void init(int N, int K, int G_, int c_) { mo.init(TS_PM0 * 256, N, G_, c_); mo.nt0 = K / 64; kp = K / TS_PARTS; G = G_; c = c_; }
    __device__ bool next(int i, pg8::Unit& u) const {
        if (mo.next(i, u)) return true;
        const long L = (long)i * G + c - (long)mo.nwg; if (L < 0 || L >= TS_TILES * TS_PARTS) return false;
        const int t = (int)L / TS_PARTS, part = (int)L % TS_PARTS; u.pm = TS_PM0 + t / 8; u.pn = t % 8; u.koff = part * kp * 2; u.nt = kp / 64; return true; }
    __device__ __forceinline__ void a_ready(const pg8::Unit&) const {}
    __device__ __forceinline__ void done(const pg8::Unit&) const {}
};
template <bool FINAL> __device__ __forceinline__ void resid_combine(LAS unsigned char* lds, const bf16* HI, bf16* AB, const float* ssq, float* rs, const float* slab, float sc, float* out, int G, int wave, int gw, int NGW, int lane) {
    LAS float* red = (LAS float*)lds;
    constexpr int NT = MP - TS_PM0 * 256;
    for (int j0 = 0; (int)blockIdx.x + G * j0 < NT; j0 += 3) {
        f32x4 pp[3][4]; v2u hb[3];
#pragma unroll
        for (int j = 0; j < 3; ++j) { const int it = (int)blockIdx.x + G * (j0 + j); const int itc = it < NT ? it : (int)blockIdx.x;
            const int r = itc & 255, row = TS_PM0 * 256 + itc, t = (itc >> 8) * 8 + wave;
            const float* sp = slab + (size_t)(t * TS_PARTS) * 65536 + (size_t)r * 256 + 4 * lane;
#pragma unroll
            for (int p = 0; p < 4; ++p) pp[j][p] = *(const f32x4*)(sp + (size_t)p * 65536);
            hb[j] = *(const v2u*)(HI + (size_t)row * DM + wave * 256 + 4 * lane); }
        if (!FINAL && j0 > 0) __syncthreads();
#pragma unroll
        for (int j = 0; j < 3; ++j) { const int it = (int)blockIdx.x + G * (j0 + j);
            if (it < NT) { const int row = TS_PM0 * 256 + it, col = wave * 256 + 4 * lane;
                const f32x4 hn = (f32x4){bflo(hb[j].x), bfhi(hb[j].x), bflo(hb[j].y), bfhi(hb[j].y)} + ((pp[j][0] + pp[j][1]) + (pp[j][2] + pp[j][3])) * sc;
                if (FINAL) { float* op = nullptr;
                    if (row < MPR) { const int b = row / TP, tt = row - b * TP; if (tt >= NMETA) op = out + O_YP + ((size_t)b * SEQ + (tt - NMETA)) * DM; }
                    else if (row < MREAL) op = out + O_YS + (size_t)(row - MPR) * DM;
                    if (op) *(f32x4*)(op + col) = hn; }
                else { v2u w; w.x = pk2(hn[0], hn[1]); w.y = pk2(hn[2], hn[3]); *(v2u*)(AB + (size_t)row * DM + col) = w;
                    const float ss = wave_sum((hn[0] * hn[0] + hn[1] * hn[1]) + (hn[2] * hn[2] + hn[3] * hn[3]));
                    if (lane == 0) red[j * 8 + wave] = ss; } } }
        if (!FINAL) {
            __syncthreads();
            if (wave == 0 && lane < 3) { const int it = (int)blockIdx.x + G * (j0 + lane);
                if (it < NT) { float s = 0.f;
#pragma unroll
                    for (int w = 0; w < 8; ++w) s += red[lane * 8 + w];
                    rs[TS_PM0 * 256 + it] = rsqrtf(s * (1.0f / DM) + EPS); } } } }
    if (!FINAL) {
        for (int it0 = gw; it0 < TS_PM0 * 128; it0 += 4 * NGW) { float sv[4];
#pragma unroll
            for (int k = 0; k < 4; ++k) { const int it = it0 + k * NGW; sv[k] = it < TS_PM0 * 128 ? ssq[(size_t)(2 * it + (lane >> 5)) * 32 + (lane & 31)] : 0.f; }
#pragma unroll
            for (int k = 0; k < 4; ++k) { const int it = it0 + k * NGW; float s = sv[k];
                s += __shfl_xor(s, 1); s += __shfl_xor(s, 2); s += __shfl_xor(s, 4); s += __shfl_xor(s, 8); s += __shfl_xor(s, 16);
                if (it < TS_PM0 * 128 && (lane & 31) == 0) rs[2 * it + (lane >> 5)] = rsqrtf(s * (1.0f / DM) + EPS); } } }
}
__device__ __forceinline__ void head_combine(bf16* O, const float* rsv, const float* gain, float post, const float* slab, int gw, int NGW, int lane) {
    const int hd = (lane >> 3) & 3, dim = 32 * (lane >> 5) + 4 * (lane & 7);
    const f32x4 gv = *(const f32x4*)(gain + dim);
    for (int it0 = gw; it0 < TS_TILES * 256; it0 += 3 * NGW) {
        f32x4 pp[3][4]; float rsl[3];
#pragma unroll
        for (int k = 0; k < 3; ++k) { const int it = it0 + k * NGW < TS_TILES * 256 ? it0 + k * NGW : it0; const int t = it >> 8, r = it & 255, row = (TS_PM0 + (t >> 3)) * 256 + r;
            const float* sp = slab + (size_t)(t * TS_PARTS) * 65536 + (size_t)r * 256 + 4 * lane;
#pragma unroll
            for (int p = 0; p < 4; ++p) pp[k][p] = *(const f32x4*)(sp + (size_t)p * 65536);
            rsl[k] = rsv[row]; }
#pragma unroll
        for (int k = 0; k < 3; ++k) { const int it = it0 + k * NGW; if (it < TS_TILES * 256) { const int t = it >> 8, r = it & 255, pn = t & 7, row = (TS_PM0 + (t >> 3)) * 256 + r;
            const f32x4 x = ((pp[k][0] + pp[k][1]) + (pp[k][2] + pp[k][3])) * rsl[k];
            float ms = (x[0] * x[0] + x[1] * x[1]) + (x[2] * x[2] + x[3] * x[3]);
            ms += __shfl_xor(ms, 1); ms += __shfl_xor(ms, 2); ms += __shfl_xor(ms, 4); ms += __shfl_xor(ms, 32);
            const float inv = rsqrtf(ms * (1.0f / 64.0f) + EPS) * post;
            const f32x4 o = x * inv * gv;
            v2u w; w.x = pk2(o[0], o[1]); w.y = pk2(o[2], o[3]); *(v2u*)(O + (size_t)row * DM + pn * 256 + hd * 64 + dim) = w; } }
    }
}
#define GEMM_PHASE_TS(EPI_T, E, Aptr, Bptr, K_) do { pg8::Gemm gg{(const pg8::bf16_t*)(Aptr), (const pg8::bf16_t*)(Bptr), MP, DM, (K_)}; int bx_ = (int)blockIdx.x; asm volatile("" : "+s"(bx_)); TailSplitOrder SS; SS.init(DM, (K_), G, bx_); \
    pg8::gemm_phase<EPI_T, TailSplitOrder, true, true>(lds, gg, SS, (E)); } while (0)
#define GEMM_PHASE_TSA(EPI_T, E, Aptr, Bptr, K_) do { pg8::Gemm gg{(const pg8::bf16_t*)(Aptr), (const pg8::bf16_t*)(Bptr), MP, DM, (K_)}; int bx_ = (int)blockIdx.x; asm volatile("" : "+s"(bx_)); TailSplitOrder SS; SS.init(DM, (K_), G, bx_); \
    pg8::gemm_phase<EPI_T, TailSplitOrder, true, true, true>(lds, gg, SS, (E)); } while (0)
typedef EpiResid<false, false> EpiResPlain; typedef EpiResid<true, false> EpiResFinal;
#define GEMM_PHASE(EPI_T, E, Aptr, Bptr, N_, K_) do { pg8::Gemm gg{(const pg8::bf16_t*)(Aptr), (const pg8::bf16_t*)(Bptr), MP, (N_), (K_)}; int bx_ = (int)blockIdx.x; asm volatile("" : "+s"(bx_)); pg8::StaticOrder SS; SS.init(MP, (N_), G, bx_); SS.nt0 = (K_) / 64; \
    pg8::gemm_phase<EPI_T, pg8::StaticOrder, true, true>(lds, gg, SS, (E)); } while (0)

__global__ void __launch_bounds__(NWAVES * 64, 2) yoco_fwd(Args args) {
    extern __shared__ __attribute__((aligned(16))) unsigned char lds_raw[];
    LAS unsigned char* lds = (LAS unsigned char*)lds_raw;
    volatile LAS unsigned* MISC = (volatile LAS unsigned*)(lds + MISC_OFF);
    const int tid = threadIdx.x, lane = tid & 63, wave = __builtin_amdgcn_readfirstlane(tid >> 6);
    const int G = gridDim.x, gw = blockIdx.x * NWAVES + wave, NGW = G * NWAVES;
    unsigned char* ws = args.ws;
    for (int u = tid; u < (LDS_BYTES - MISC_OFF) / 4; u += NWAVES * 64) ((LAS unsigned*)(lds + MISC_OFF))[u] = 0u;
    __syncthreads();
    XcdBarrier bar = xcd_barrier_post((unsigned*)(ws + WS_CTL) + CW_BAR, MISC + 8);

    bf16* AB = (bf16*)(ws + WS_AB); bf16* ACT = (bf16*)(ws + WS_ACT); bf16* QKVO = (bf16*)(ws + WS_ACT);
    float* HM = (float*)(ws + WS_HM); bf16* AM = (bf16*)(ws + WS_AM); bf16* QB = (bf16*)(ws + WS_QB); bf16* KB = (bf16*)(ws + WS_KB); bf16* VB = (bf16*)(ws + WS_VB);
    bf16* AB2 = (bf16*)(ws + WS_AB2); float* SSQ2 = (float*)(ws + WS_SSQ2); float* RS = (float*)(ws + WS_RS); float* RS2 = (float*)(ws + WS_RS2);
    float* SSQ = (float*)(ws + WS_SSQ); float* HSSQ = (float*)(ws + WS_HSSQ); float* GATES = (float*)(ws + WS_GATES);

    p0_prologue(args, lds, gw, NGW, wave, lane);
    xcd_barrier(bar);

    { EpiSwiglu<false> E{ACT, RS}; GEMM_PHASE(EpiSwiglu<false>, E, AB, ws + WS_W1 + 0 * SZ_W1, 2 * DFF, DM); }
    xcd_barrier(bar);
    { EpiResPlain E{AB, AB, SSQ, nullptr, (float*)(ws + WS_SLAB), 0.5f, DFF / 64}; GEMM_PHASE_TSA(EpiResPlain, E, ACT, ws + WS_W2 + 0 * SZ_W2, DFF); }
    xcd_barrier(bar);
    resid_combine<false>(lds, AB, AB, SSQ, RS, (const float*)(ws + WS_SLAB), 0.5f, nullptr, G, wave, gw, NGW, lane);
    xcd_barrier(bar);

    { EpiQkvo E{QKVO, RS, GATES, args.in[I_BAG]}; GEMM_PHASE(EpiQkvo, E, AB, ws + WS_WAIN, NAIN_PAD, DM); }
    xcd_barrier(bar);
    for (int u = blockIdx.x; u < NBATCH * AH * 8; u += G) {
        const int v = (((u & 7) * 4 + (u >> 6)) << 3) | ((u >> 3) & 7);
        mlstm_prompt_unit(lds, QKVO, GATES, HM, HSSQ, args.out, v >> 5, (v >> 3) & 3, v & 7, tid, wave, lane); }
    for (int u = blockIdx.x; u < DECB * AH; u += G) mlstm_sample_unit(lds, QKVO, GATES, args.in[I_SC], args.in[I_SN], args.in[I_SM], HM, HSSQ, args.out, u >> 2, u & 3, tid, wave, lane);
    xcd_barrier(bar);
    mlstm_gate_rows(HM, HSSQ, QKVO, args.in[I_AHN], AM, gw, NGW, lane);
    xcd_barrier(bar);
    { EpiResPlain E{AB, AB, SSQ, nullptr, (float*)(ws + WS_SLAB), 1.0f, DM / 64}; GEMM_PHASE_TS(EpiResPlain, E, AM, ws + WS_WAOUT, DM); }
    xcd_barrier(bar);
    resid_combine<false>(lds, AB, AB, SSQ, RS, (const float*)(ws + WS_SLAB), 1.0f, nullptr, G, wave, gw, NGW, lane);
    xcd_barrier(bar);

    { EpiSwiglu<false> E{ACT, RS}; GEMM_PHASE(EpiSwiglu<false>, E, AB, ws + WS_W1 + 1 * SZ_W1, 2 * DFF, DM); }
    xcd_barrier(bar);
    { EpiResPlain E{AB, AB, SSQ, nullptr, (float*)(ws + WS_SLAB), 0.5f, DFF / 64}; GEMM_PHASE_TSA(EpiResPlain, E, ACT, ws + WS_W2 + 1 * SZ_W2, DFF); }
    xcd_barrier(bar);
    resid_combine<false>(lds, AB, AB, SSQ, RS, (const float*)(ws + WS_SLAB), 0.5f, nullptr, G, wave, gw, NGW, lane);
    xcd_barrier(bar);

    { EpiSwiglu<false> E{ACT, RS}; GEMM_PHASE(EpiSwiglu<false>, E, AB, ws + WS_W1 + 2 * SZ_W1, 2 * DFF, DM); }
    xcd_barrier(bar);
    { EpiResPlain E{AB, AB2, SSQ2, nullptr, (float*)(ws + WS_SLAB), 0.5f, DFF / 64}; GEMM_PHASE_TSA(EpiResPlain, E, ACT, ws + WS_W2 + 2 * SZ_W2, DFF); }
    { EpiHead E{KB, 256, VB, 256, 1, RS, args.in[I_KN], 1.0f, nullptr, DM / 64}; pg8::Gemm gg{(const pg8::bf16_t*)AB, (const pg8::bf16_t*)(ws + WS_WKV), MP, 512, DM}; int bx_ = ((int)blockIdx.x + G - TS_TILES * TS_PARTS % G) % G; asm volatile("" : "+s"(bx_));
      pg8::StaticOrder SS; SS.init(MP, 512, G, bx_); SS.nt0 = DM / 64; pg8::gemm_phase<EpiHead, pg8::StaticOrder, true, true>(lds, gg, SS, E); }
    xcd_barrier(bar);
    resid_combine<false>(lds, AB, AB2, SSQ2, RS2, (const float*)(ws + WS_SLAB), 0.5f, nullptr, G, wave, gw, NGW, lane);
    xcd_barrier(bar);

    { EpiHead E{QB, DM, QB, DM, 8, RS2, args.in[I_QN], 0.125f, (float*)(ws + WS_SLAB), DM / 64}; GEMM_PHASE_TS(EpiHead, E, AB2, ws + WS_WQ, DM); }
    if ((int)blockIdx.x >= TS_TILES * TS_PARTS) kv_outputs(args, KB, VB, (size_t)(blockIdx.x - TS_TILES * TS_PARTS) * (NWAVES * 64) + tid, (size_t)(G - TS_TILES * TS_PARTS) * NWAVES * 64);
    xcd_barrier(bar);
    head_combine(QB, RS2, args.in[I_QN], 0.125f, (const float*)(ws + WS_SLAB), gw, NGW, lane);
    xcd_barrier(bar);
    for (int u = blockIdx.x; u < NBATCH * BKV * 17; u += G) { const int n = u % 17, bg = u / 17; attn_prompt_unit(lds, QB, KB, VB, args.in[I_SINK], AM, bg >> 2, bg & 3, n, tid, wave, lane); }
    for (int u = (int)blockIdx.x - 32; u >= 0 && u < DECB * BKV; u += G - 32) attn_sample_unit(lds, QB, KB, VB, args.in[I_CKM], args.in[I_CVM], args.in[I_CKW], args.in[I_CVW], args.in[I_SINK], AM, u >> 2, u & 3, tid, wave, lane);
    xcd_barrier(bar);
    { EpiResPlain E{AB2, AB, SSQ, nullptr, (float*)(ws + WS_SLAB), 1.0f, DM / 64}; GEMM_PHASE_TS(EpiResPlain, E, AM, ws + WS_WBO, DM); }
    xcd_barrier(bar);
    resid_combine<false>(lds, AB2, AB, SSQ, RS, (const float*)(ws + WS_SLAB), 1.0f, nullptr, G, wave, gw, NGW, lane);
    xcd_barrier(bar);

    { EpiSwiglu<false> E{ACT, RS}; GEMM_PHASE(EpiSwiglu<false>, E, AB, ws + WS_W1 + 3 * SZ_W1, 2 * DFF, DM); }
    xcd_barrier(bar);
    { EpiResFinal E{AB, AB, SSQ, args.out, (float*)(ws + WS_SLAB), 0.5f, DFF / 64}; GEMM_PHASE_TSA(EpiResFinal, E, ACT, ws + WS_W2 + 3 * SZ_W2, DFF); }
    xcd_barrier(bar);
    resid_combine<true>(lds, AB, AB, SSQ, RS, (const float*)(ws + WS_SLAB), 0.5f, args.out, G, wave, gw, NGW, lane);
}

extern "C" void kernel_launch(void* const* d_in, const int* in_sizes, int n_in, void* d_out, int out_size, void* d_ws, size_t ws_size, hipStream_t stream) {
    static int grid = 0;
    if (grid == 0) {
        if (n_in != 25 || (size_t)out_size != O_END || ws_size < WS_END) { fprintf(stderr, "kernel_launch: unexpected shapes (n_in %d, out %d vs %zu, ws %zu vs %zu); nothing launched\n", n_in, out_size, (size_t)O_END, ws_size, (size_t)WS_END); grid = -1; return; }
        int dev = 0, cus = 0, per_cu = 0;
        if (hipGetDevice(&dev) != hipSuccess || hipDeviceGetAttribute(&cus, hipDeviceAttributeMultiprocessorCount, dev) != hipSuccess) { grid = -1; return; }
        if (hipFuncSetAttribute((const void*)yoco_fwd, hipFuncAttributeMaxDynamicSharedMemorySize, LDS_BYTES) != hipSuccess) { fprintf(stderr, "kernel_launch: hipFuncSetAttribute failed\n"); grid = -1; return; }
        if (hipOccupancyMaxActiveBlocksPerMultiprocessor(&per_cu, (const void*)yoco_fwd, NWAVES * 64, LDS_BYTES) != hipSuccess || per_cu < 1) fprintf(stderr, "kernel_launch: occupancy query says %d\n", per_cu);
        (void)hipGetLastError();
        grid = cus;
    }
    if (grid < 0) return;
    (void)in_sizes;
    if (hipMemsetAsync((char*)d_ws + WS_CTL, 0, CTL_ZERO_BYTES, stream) != hipSuccess) return;
    Args a{};
    for (int i = 0; i < 25; ++i) a.in[i] = (const float*)d_in[i];
    a.out = (float*)d_out; a.ws = (unsigned char*)d_ws;
    hipLaunchKernelGGL(yoco_fwd, dim3(grid), dim3(NWAVES * 64), LDS_BYTES, stream, a);
}
```

```cpp
#include <hip/hip_runtime.h>
#include <cstdio>
#include <cstdint>
namespace pg8 {
#define PG8_LAS __attribute__((address_space(3)))
typedef unsigned short bf16_t;
typedef short bf16x8 __attribute__((ext_vector_type(8)));
typedef float f32x4 __attribute__((ext_vector_type(4)));
typedef unsigned u32x4 __attribute__((ext_vector_type(4)));
constexpr int BM = 256, BK = 64, HALF = 128, HTB = HALF * BK * 2  , STAGE_BYTES = 8 * HTB, NXCD = 8, WGM = 4;

__host__ __device__ __forceinline__ int lds_byte(int r, int c) { const int st = (r >> 4) * 2 + (c >> 5), rr = r & 15, cc = c & 31, ob = rr * 64 + cc * 2; return st * 1024 + (ob ^ (((ob >> 9) & 1) << 5)); }
__host__ __device__ __forceinline__ void stage_rc(int b, int& R, int& C) { const int st = b / 1024, sb = b % 1024, swz = sb ^ (((sb >> 9) & 1) << 5); R = (st >> 1) * 16 + swz / 64; C = (st & 1) * 32 + (swz % 64) / 2; }
__host__ __device__ __forceinline__ int perm32(int rho) { const int n = rho >> 4, i = rho & 15; return 8 * (i >> 2) + 4 * n + (i & 3); }

struct Unit { int pm, pn, koff, nt; };
struct Gemm { const bf16_t* A; const bf16_t* Bt; int M, N, K; };

struct StaticOrder {
    int nM, nN, nwg, G, c, nt0;
    __host__ __device__ void init(int M, int N, int G_, int c_) { nM = M / BM; nN = N / BM; nwg = nM * nN; G = G_; c = c_; }
    __host__ __device__ bool next(int i, Unit& u) const {
        const long L = (long)i * G + c; if (L >= nwg) return false;
        int wgid = (int)L; { const int q = nwg / NXCD, r = nwg % NXCD, xcd = wgid % NXCD, off = wgid / NXCD; wgid = (xcd < r ? xcd * (q + 1) : r * (q + 1) + (xcd - r) * q) + off; }
        const int nig = WGM * nN, gid = wgid / nig, fm = gid * WGM, gsz = (nM - fm) < WGM ? (nM - fm) : WGM;
        u.pm = fm + ((wgid % nig) % gsz); u.pn = (wgid % nig) / gsz; u.koff = 0; u.nt = nt0; return true;
    }
    __device__ __forceinline__ void a_ready(const Unit&) const {}
    __device__ __forceinline__ void done(const Unit&) const {}
};

__device__ __forceinline__ unsigned cvt_pk_bf16(float lo, float hi) { unsigned r; asm volatile("v_cvt_pk_bf16_f32 %0, %1, %2" : "=v"(r) : "v"(lo), "v"(hi)); return r; }
typedef float f32x2 __attribute__((ext_vector_type(2)));
template <class Epi, class Sched, bool ALIGN_EPI = false, bool SP2 = false, bool ABLK = false>
__device__ __forceinline__ void gemm_phase(PG8_LAS unsigned char* lds, const Gemm g, const Sched& S, const Epi& E) {
    int tid_l = threadIdx.x; asm volatile("" : "+v"(tid_l));
    const int tid = tid_l, wid = __builtin_amdgcn_readfirstlane(tid >> 6), lane = tid & 63, wr = wid >> 2, wc = wid & 3, fr = lane & 15, fq = lane >> 4;
    const int K = g.K, nt = K / BK;
    unsigned voffA[2], voffB[2];
#pragma unroll
    for (int i = 0; i < 2; ++i) { int R, C; stage_rc(tid * 16 + i * 8192, R, C); const int Rb = Epi::PERM ? ((R & ~31) + perm32(R & 31)) : R;
        voffA[i] = ABLK ? (unsigned)(R * BK + C) * 2u : (unsigned)(R * K + C) * 2u; voffB[i] = (unsigned)(Rb * BK + C) * 2u; }
    const size_t kstep = (size_t)(BK * 2);
    const size_t hstep = (size_t)HALF * K * 2;
    const size_t tstep = 2 * hstep;
    const size_t kstepB = (size_t)(2 * HTB), hstepB = (size_t)HTB, tstepB = (size_t)nt * (2 * HTB);
    const size_t kstepA = ABLK ? (size_t)(2 * HTB) : kstep, hstepA = ABLK ? (size_t)HTB : hstep, tstepA = ABLK ? (size_t)nt * (2 * HTB) : tstep;
    const unsigned ldsw = (unsigned)wid * 1024u;
    const int aoff = lds_byte(wr * 64 + fr, fq * 8), boff = lds_byte(wc * 32 + fr, fq * 8);
#define PG8_SA(b, h) (((b) * 2 + (h)) * HTB)
#define PG8_SB(b, h) ((4 + (b) * 2 + (h)) * HTB)
#define PG8_STAGE(bufoff, gbase, voff) do { _Pragma("unroll") for (int _i = 0; _i < 2; ++_i) \
        __builtin_amdgcn_global_load_lds((const unsigned*)((const char*)(gbase) + (voff)[_i]), (PG8_LAS unsigned*)(lds + (bufoff) + ldsw + _i * 8192), 16, 0, 0); } while (0)
#define PG8_LDA(dst, b, h) do { _Pragma("unroll") for (int m = 0; m < 4; ++m) _Pragma("unroll") for (int k = 0; k < 2; ++k) dst[m][k] = *(const PG8_LAS bf16x8*)(lds + PG8_SA(b, h) + aoff + m * 2048 + k * 1024); } while (0)
#define PG8_LDB(dst, b, h) do { _Pragma("unroll") for (int n = 0; n < 2; ++n) _Pragma("unroll") for (int k = 0; k < 2; ++k) dst[n][k] = *(const PG8_LAS bf16x8*)(lds + PG8_SB(b, h) + boff + n * 2048 + k * 1024); } while (0)
#define PG8_MMA(ai, bj, At, Bt) do { __builtin_amdgcn_s_setprio(1); _Pragma("unroll") for (int m = 0; m < 4; ++m) _Pragma("unroll") for (int n = 0; n < 2; ++n) _Pragma("unroll") for (int k = 0; k < 2; ++k) \
        acc[ai][bj][m][n] = __builtin_amdgcn_mfma_f32_16x16x32_bf16(Bt[n][k], At[m][k], acc[ai][bj][m][n], 0, 0, 0); __builtin_amdgcn_s_setprio(0); } while (0)
#define PG8_WAIT_V(n) asm volatile("s_waitcnt vmcnt(" #n ")" ::: "memory")
#define PG8_WAIT_L(n) asm volatile("s_waitcnt lgkmcnt(" #n ")" ::: "memory")
#define PG8_BAR __builtin_amdgcn_s_barrier()
#define PG8_SCHED __builtin_amdgcn_sched_barrier(0)
    Unit cur, nxt; int ui = 0;
    if (!S.next(0, cur)) return;
    f32x4 acc[2][2][4][2];
#pragma unroll
    for (int a = 0; a < 2; ++a)
#pragma unroll
        for (int b = 0; b < 2; ++b)
#pragma unroll
            for (int m = 0; m < 4; ++m)
#pragma unroll
                for (int n = 0; n < 2; ++n) acc[a][b][m][n] = (f32x4){0.f, 0.f, 0.f, 0.f};
    bf16x8 At[4][2], B0[2][2], B1[2][2];
    const char* cA = (const char*)g.A + (size_t)cur.pm * tstepA + (ABLK ? (size_t)(cur.koff / (BK * 2)) * (2 * HTB) : (size_t)cur.koff); const char* cB = (const char*)g.Bt + (size_t)cur.pn * tstepB + (size_t)(cur.koff / (BK * 2)) * (2 * HTB);
    S.a_ready(cur);
    if constexpr (SP2) {
        PG8_STAGE(PG8_SB(0, 0), cB, voffB); PG8_STAGE(PG8_SB(0, 1), cB + hstepB, voffB); PG8_STAGE(PG8_SA(0, 0), cA, voffA); PG8_STAGE(PG8_SA(0, 1), cA + hstepA, voffA);
        if (wr == 1) PG8_BAR;
        PG8_WAIT_V(2); PG8_BAR;
        PG8_STAGE(PG8_SB(1, 0), cB + kstepB, voffB); PG8_STAGE(PG8_SA(1, 0), cA + kstepA, voffA); PG8_STAGE(PG8_SB(1, 1), cB + hstepB + kstepB, voffB);
        PG8_WAIT_V(6); PG8_BAR;
    } else {
        PG8_STAGE(PG8_SB(0, 0), cB, voffB); PG8_STAGE(PG8_SA(0, 0), cA, voffA); PG8_STAGE(PG8_SB(0, 1), cB + hstepB, voffB); PG8_STAGE(PG8_SA(0, 1), cA + hstepA, voffA);
        if (wr == 1) PG8_BAR;
        PG8_WAIT_V(4); PG8_BAR;
        PG8_STAGE(PG8_SB(1, 0), cB + kstepB, voffB); PG8_STAGE(PG8_SA(1, 0), cA + kstepA, voffA); PG8_STAGE(PG8_SB(1, 1), cB + hstepB + kstepB, voffB);
        PG8_WAIT_V(6); PG8_BAR;
    }
    for (;;) {
        const bool has_next = S.next(ui + 1, nxt);
        const char* nA = has_next ? (const char*)g.A + (size_t)nxt.pm * tstepA + (ABLK ? (size_t)(nxt.koff / (BK * 2)) * (2 * HTB) : (size_t)nxt.koff) : cA; const char* nB = has_next ? (const char*)g.Bt + (size_t)nxt.pn * tstepB + (size_t)(nxt.koff / (BK * 2)) * (2 * HTB) : cB;
        for (int t = 0; t < cur.nt; t += 2) {
            const bool last = (t == cur.nt - 2);
            const char* a1 = cA + (size_t)(t + 1) * kstepA;
            const char* a2 = last ? nA : cA + (size_t)(t + 2) * kstepA; const char* b2 = last ? nB : cB + (size_t)(t + 2) * kstepB;
            const char* a3 = a2 + kstepA; const char* b3 = b2 + kstepB;
            if (last && has_next) S.a_ready(nxt);
            if constexpr (SP2) {
            PG8_LDB(B0, 0, 0); PG8_LDB(B1, 0, 1); PG8_SCHED; PG8_LDA(At, 0, 0); PG8_STAGE(PG8_SA(1, 1), a1 + hstepA, voffA);
            PG8_WAIT_V(8); PG8_WAIT_L(0); PG8_BAR; PG8_MMA(0, 0, At, B0); PG8_MMA(0, 1, At, B1); PG8_BAR; PG8_SCHED;
            PG8_LDA(At, 0, 1); PG8_STAGE(PG8_SB(0, 0), b2, voffB); PG8_STAGE(PG8_SB(0, 1), b2 + hstepB, voffB); PG8_STAGE(PG8_SA(0, 0), a2, voffA);
            PG8_WAIT_V(8); PG8_WAIT_L(0); PG8_BAR; PG8_MMA(1, 0, At, B0); PG8_MMA(1, 1, At, B1); PG8_BAR; PG8_SCHED;
            PG8_LDB(B0, 1, 0); PG8_LDB(B1, 1, 1); PG8_SCHED; PG8_LDA(At, 1, 0); PG8_STAGE(PG8_SA(0, 1), a2 + hstepA, voffA);
            PG8_WAIT_V(8); PG8_WAIT_L(0); PG8_BAR; PG8_MMA(0, 0, At, B0); PG8_MMA(0, 1, At, B1); PG8_BAR; PG8_SCHED;
            PG8_LDA(At, 1, 1); PG8_STAGE(PG8_SB(1, 0), b3, voffB); PG8_STAGE(PG8_SB(1, 1), b3 + hstepB, voffB); PG8_STAGE(PG8_SA(1, 0), a3, voffA);
            PG8_WAIT_V(8); PG8_WAIT_L(0); PG8_BAR; PG8_MMA(1, 0, At, B0); PG8_MMA(1, 1, At, B1); PG8_BAR; PG8_SCHED;
            } else {
            PG8_LDB(B0, 0, 0); PG8_SCHED; PG8_LDA(At, 0, 0); PG8_STAGE(PG8_SA(1, 1), a1 + hstepA, voffA);
            PG8_WAIT_L(8); PG8_BAR; PG8_WAIT_L(0); PG8_MMA(0, 0, At, B0); PG8_BAR; PG8_SCHED;
            PG8_LDB(B1, 0, 1); PG8_STAGE(PG8_SB(0, 0), b2, voffB);
            PG8_BAR; PG8_WAIT_L(0); PG8_MMA(0, 1, At, B1); PG8_BAR;
            PG8_LDA(At, 0, 1); PG8_STAGE(PG8_SA(0, 0), a2, voffA);
            PG8_BAR; PG8_WAIT_L(0); PG8_MMA(1, 0, At, B0); PG8_BAR; PG8_SCHED;
            PG8_STAGE(PG8_SB(0, 1), b2 + hstepB, voffB);
            PG8_WAIT_V(6); PG8_BAR; PG8_MMA(1, 1, At, B1); PG8_BAR;
            PG8_LDB(B0, 1, 0); PG8_SCHED; PG8_LDA(At, 1, 0); PG8_STAGE(PG8_SA(0, 1), a2 + hstepA, voffA);
            PG8_WAIT_L(8); PG8_BAR; PG8_WAIT_L(0); PG8_MMA(0, 0, At, B0); PG8_BAR; PG8_SCHED;
            PG8_LDB(B1, 1, 1); PG8_STAGE(PG8_SB(1, 0), b3, voffB);
            PG8_BAR; PG8_WAIT_L(0); PG8_MMA(0, 1, At, B1); PG8_BAR;
            PG8_LDA(At, 1, 1); PG8_STAGE(PG8_SA(1, 0), a3, voffA);
            PG8_BAR; PG8_WAIT_L(0); PG8_MMA(1, 0, At, B0); PG8_BAR; PG8_SCHED;
            PG8_STAGE(PG8_SB(1, 1), b3 + hstepB, voffB);
            PG8_WAIT_V(6); PG8_BAR; PG8_MMA(1, 1, At, B1); PG8_BAR;
            }
        }
        if constexpr (ALIGN_EPI) { if (wr == 0) PG8_BAR; }
        if constexpr (!Epi::AFTER_DRAIN) { E(acc, cur, wr, wc, fr, fq); S.done(cur); }
        if (!has_next) break;
#pragma unroll
        for (int a = 0; a < 2; ++a)
#pragma unroll
            for (int b = 0; b < 2; ++b)
#pragma unroll
                for (int m = 0; m < 4; ++m)
#pragma unroll
                    for (int n = 0; n < 2; ++n) acc[a][b][m][n] = (f32x4){0.f, 0.f, 0.f, 0.f};
        cur = nxt; cA = nA; cB = nB; ++ui;
        if constexpr (ALIGN_EPI) { if (wr == 1) PG8_BAR; }
    }
    PG8_WAIT_V(0);
    if constexpr (!ALIGN_EPI) { if (wr == 0) PG8_BAR; }
    PG8_BAR;
    if constexpr (Epi::AFTER_DRAIN) { E.fused(acc, cur, wr, wc, fr, fq, lds, wid, lane); S.done(cur); }
#undef PG8_SA
#undef PG8_SB
#undef PG8_STAGE
#undef PG8_LDA
#undef PG8_LDB
#undef PG8_MMA
#undef PG8_WAIT_V
#undef PG8_WAIT_L
#undef PG8_BAR
#undef PG8_SCHED
}
}

constexpr int NWAVES = 8;
constexpr int DM = 2048, DFF = 5632, NBATCH = 8, SEQ = 2048, NMETA = 16, TP = SEQ + NMETA;
constexpr int DECB = 128, DECS = 4, MPR = NBATCH * TP  , MSM = DECB * DECS  , MREAL = MPR + MSM  , MP = 17152  ;
constexpr int AH = 4, ADK = 256, ADV = 512, NAIN = 6144, NAIN_PAD = 6400;
constexpr int BH = 32, BDH = 64, BKV = 4, WIN = 128;
constexpr float EPS = 1e-6f;

constexpr size_t MiB = 1u << 20;
constexpr size_t WS_CTL = 0, CTL_ZERO_BYTES = 1 * MiB;
constexpr size_t SZ_W1 = (size_t)2 * DFF * DM * 2, SZ_W2 = (size_t)DM * DFF * 2;
constexpr size_t WS_W1 = 1 * MiB;
constexpr size_t WS_W2 = WS_W1 + 4 * SZ_W1;
constexpr size_t WS_WAIN = WS_W2 + 4 * SZ_W2;
constexpr size_t WS_WAOUT = WS_WAIN + (size_t)NAIN_PAD * DM * 2;
constexpr size_t WS_WKV = WS_WAOUT + (size_t)DM * DM * 2;
constexpr size_t WS_WQ = WS_WKV + (size_t)512 * DM * 2;
constexpr size_t WS_WBO = WS_WQ + (size_t)DM * DM * 2;
constexpr size_t WS_H = WS_WBO + (size_t)DM * DM * 2;
constexpr size_t WS_AB = WS_H + (size_t)MP * DM * 4;
constexpr size_t WS_ACT = WS_AB + (size_t)MP * DM * 2;
constexpr size_t WS_QKVO = WS_ACT + (size_t)MP * DFF * 2;
constexpr size_t WS_HM = WS_QKVO + (size_t)MP * NAIN * 2;
constexpr size_t WS_AM = WS_HM + (size_t)MP * DM * 4;
constexpr size_t WS_QB = WS_HM;
constexpr size_t WS_KB = WS_AM + (size_t)MP * DM * 2;
constexpr size_t WS_VB = WS_KB + (size_t)MP * 256 * 2;
constexpr size_t WS_SSQ = WS_VB + (size_t)MP * 256 * 2;
constexpr size_t WS_HSSQ = WS_SSQ + (size_t)MP * 32 * 4;
constexpr size_t WS_GATES = WS_HSSQ + (size_t)MP * 32 * 4;
constexpr size_t WS_PF = WS_GATES + (size_t)MP * 8 * 4;
constexpr size_t WS_GA = WS_PF + (size_t)32 * 17 * 8 * 4 * 1024;
constexpr size_t WS_SLAB = WS_GA + (size_t)32 * 17 * 512 * 4;
constexpr size_t WS_AB2 = WS_SLAB + (size_t)24 * 4 * 65536 * 4;
constexpr size_t WS_SSQ2 = WS_AB2 + (size_t)MP * DM * 2;
constexpr size_t WS_RS = WS_SSQ2 + (size_t)MP * 32 * 4;
constexpr size_t WS_RS2 = WS_RS + (size_t)MP * 4;
constexpr size_t WS_END = WS_RS2 + (size_t)MP * 4;
constexpr int CW_BAR = 4096;
constexpr int CW_SQ = 7680;

constexpr size_t O_YP = 0, O_YS = O_YP + (size_t)NBATCH * SEQ * DM, O_CP = O_YS + (size_t)MSM * DM, O_NP = O_CP + (size_t)NBATCH * AH * ADK * ADV,
                 O_MP = O_NP + NBATCH * AH * ADK, O_KMP = O_MP + NBATCH * AH, O_VMP = O_KMP + NBATCH * NMETA * 256, O_KWP = O_VMP + NBATCH * NMETA * 256,
                 O_VWP = O_KWP + NBATCH * WIN * 256, O_CS = O_VWP + NBATCH * WIN * 256, O_NS = O_CS + (size_t)DECB * AH * ADK * ADV, O_MS = O_NS + DECB * AH * ADK,
                 O_KWS = O_MS + DECB * AH, O_VWS = O_KWS + (size_t)DECB * WIN * 256, O_END = O_VWS + (size_t)DECB * WIN * 256;

constexpr int SCR_BYTES = 143360;
constexpr int MISC_OFF = SCR_BYTES;
constexpr int LDS_BYTES = 147456;

#define GAS __attribute__((address_space(1)))
#define LAS __attribute__((address_space(3)))
typedef unsigned short bf16;
typedef unsigned v4u __attribute__((ext_vector_type(4)));
typedef unsigned v2u __attribute__((ext_vector_type(2)));
typedef float f32x4 __attribute__((ext_vector_type(4)));
typedef short bf16x8 __attribute__((ext_vector_type(8)));
#define LDS_WAIT() asm volatile("s_waitcnt lgkmcnt(0)" ::: "memory")
#define MFMA16(a, b, c) __builtin_amdgcn_mfma_f32_16x16x32_bf16((a), (b), (c), 0, 0, 0)
typedef __bf16 bf16n2 __attribute__((ext_vector_type(2)));
typedef float f32n2 __attribute__((ext_vector_type(2)));
__device__ __forceinline__ unsigned pk2(float lo, float hi) { const f32n2 v = {lo, hi}; return __builtin_bit_cast(unsigned, __builtin_convertvector(v, bf16n2)); }
__device__ __forceinline__ unsigned pk2m(float lo, float hi) { return pk2(lo, hi); }
__device__ __forceinline__ bf16 bf16_rne(float x) { return (bf16)(pk2(x, 0.f) & 0xffffu); }
__device__ __forceinline__ float bflo(unsigned w) { return __uint_as_float(w << 16); }
__device__ __forceinline__ float bfhi(unsigned w) { return __uint_as_float(w & 0xffff0000u); }
__device__ __forceinline__ unsigned bfel(const v4u& r, int e) { return (r[e >> 1] >> (16 * (e & 1))) & 0xffffu; }
__device__ __forceinline__ float wave_sum(float v) {
#pragma unroll
    for (int o = 1; o < 64; o <<= 1) v += __shfl_xor(v, o);
    return v;
}
#define XB_TMO      128
#define XB_XCNT(j)  (256  + 64 * (j))
#define XB_XSUB(j)  (1280 + 64 * (j))
#define XB_XGEN(j)  (2304 + 64 * (j))
#define XB_TOP      3328
#define XB_TOPGEN   3392
#define XCD_BAR_WORDS 3456
#define XB_SPIN_CAP (1u << 18)

__device__ __forceinline__ unsigned xb_ld(unsigned* p)              { return __hip_atomic_load(p, __ATOMIC_RELAXED, __HIP_MEMORY_SCOPE_AGENT); }
__device__ __forceinline__ unsigned xb_add(unsigned* p, unsigned v) { return __hip_atomic_fetch_add(p, v, __ATOMIC_RELAXED, __HIP_MEMORY_SCOPE_AGENT); }
__device__ __forceinline__ unsigned xb_xcc_id() { return (unsigned)__builtin_amdgcn_s_getreg((3 << 11) | 20) & 0xFu; }
#define XB_SPIN(cond, bar) do { unsigned _sp = 0; while (cond) { __builtin_amdgcn_s_sleep(1); \
    if ((++_sp & 255u) == 0u) { if (xb_ld(&(bar)[XB_TMO])) break; if (_sp > XB_SPIN_CAP) { atomicAdd(&(bar)[XB_TMO], 1u); break; } } } } while (0)

struct XcdBarrier {
    unsigned* bar; unsigned x;
    volatile LAS unsigned* st;
};

__device__ __forceinline__ XcdBarrier xcd_barrier_post(unsigned* bar, volatile LAS unsigned* st) {
    XcdBarrier b; b.bar = bar; b.x = xb_xcc_id(); b.st = st;
    if (threadIdx.x == 0) (void)xb_add(&bar[XB_XCNT(b.x)], 1u);
    return b;
}
__device__ __forceinline__ void xcd_barrier_complete(unsigned* bar, unsigned x, unsigned& nloc, unsigned& nx) {
    const unsigned G = gridDim.x * gridDim.y * gridDim.z;
    unsigned sum, cnt, mine, sp = 0u;
    for (;;) {
        sum = 0u; cnt = 0u; mine = 0u;
#pragma unroll
        for (unsigned j = 0; j < 16; ++j) { const unsigned c = xb_ld(&bar[XB_XCNT(j)]); sum += c; cnt += (c > 0u) ? 1u : 0u; mine = (j == x) ? c : mine; }
        if (sum == G) break;
        __builtin_amdgcn_s_sleep(1);
        if ((++sp & 255u) == 0u) { if (xb_ld(&bar[XB_TMO])) break; if (sp > XB_SPIN_CAP) { atomicAdd(&bar[XB_TMO], 1u); break; } }
    }
    nloc = mine > 0u ? mine : 1u; nx = cnt > 0u ? cnt : 1u;
}

__device__ __forceinline__ void xcd_barrier(const XcdBarrier& b) {
    asm volatile("s_waitcnt vmcnt(0)" ::: "memory");
    __syncthreads();
    if (threadIdx.x == 0) {
        unsigned* bar = b.bar;
        __builtin_amdgcn_s_waitcnt(0);
        unsigned nloc = b.st[0], nx = b.st[1];
        if (nloc == 0u) { xcd_barrier_complete(bar, b.x, nloc, nx); b.st[0] = nloc; b.st[1] = nx; }
        const unsigned old = xb_add(&bar[XB_XSUB(b.x)], 1u);
        const unsigned gen = old / nloc;
        if (old + 1u == (gen + 1u) * nloc) {
            __builtin_amdgcn_fence(__ATOMIC_RELEASE, "agent");
            asm volatile("s_waitcnt vmcnt(0)" ::: "memory");
            const unsigned og = xb_add(&bar[XB_TOP], 1u);
            const unsigned tg = og / nx;
            if (og + 1u == (tg + 1u) * nx) xb_add(&bar[XB_TOPGEN], 1u);
            else XB_SPIN(xb_ld(&bar[XB_TOPGEN]) == tg, bar);
            __builtin_amdgcn_fence(__ATOMIC_ACQUIRE, "agent");
            xb_add(&bar[XB_XGEN(b.x)], 1u);
            asm volatile("s_waitcnt vmcnt(0)" ::: "memory");
        } else {
            XB_SPIN(xb_ld(&bar[XB_XGEN(b.x)]) == gen, bar);
            __builtin_amdgcn_fence(__ATOMIC_ACQUIRE, "agent");
            asm volatile("s_waitcnt vmcnt(0)" ::: "memory");
        }
    }
    __syncthreads();
}

constexpr int CW_TMO = 0;
constexpr int CW_Q = 8192;
constexpr int CW_CNT = 16384, CNT_STRIDE = 80;
static_assert((CW_CNT + 13 * CNT_STRIDE * 64) * 4 <= (int)CTL_ZERO_BYTES && CW_Q + 13 * 8 * 64 <= CW_CNT, "CTL map");
#define FLOW_NONE 0xffffffffu
struct FlowOrder {
    int nM, nN, nwg, x; unsigned* q; const unsigned* dep; unsigned need; unsigned* pub; unsigned* tmo; volatile LAS unsigned* slot;
    static constexpr int MID_T = 4;
    int pend_pm; unsigned pend_t; int pend_kind;
    __device__ __forceinline__ void init(int N, unsigned xcc, unsigned* ctl, int phase, int dep_bank, unsigned need_, int pub_bank, volatile LAS unsigned* slot_) {
        nM = MP / 256; nN = N / 256; nwg = nM * nN; x = (int)(xcc & 7u); q = ctl + CW_Q + phase * 8 * 64;
        dep = dep_bank >= 0 ? ctl + CW_CNT + dep_bank * CNT_STRIDE * 64 : nullptr; need = need_;
        pub = pub_bank >= 0 ? ctl + CW_CNT + pub_bank * CNT_STRIDE * 64 : nullptr; tmo = ctl + CW_TMO; slot = slot_; pend_pm = -1; pend_t = 0u; pend_kind = 0; }
    __device__ __forceinline__ int lstart(int xx) const { const int q_ = nwg / 8, r = nwg % 8; return xx < r ? xx * (q_ + 1) : r * (q_ + 1) + (xx - r) * q_; }
    __device__ __forceinline__ unsigned lcount(int xx) const { return (unsigned)(nwg / 8 + (xx < nwg % 8 ? 1 : 0)); }
    static constexpr int WG = 2;
    __device__ __forceinline__ void decode(unsigned wgid, pg8::Unit& u) const { const int w = (int)wgid, nig = WG * nN, gid = w / nig, fm = gid * WG, gsz = (nM - fm) < WG ? (nM - fm) : WG;
        u.pm = fm + ((w % nig) % gsz); u.pn = (w % nig) / gsz; }
    __device__ __forceinline__ unsigned take(int xx) const { unsigned t = 0; if ((threadIdx.x & 63) == 0) t = __hip_atomic_fetch_add(q + 64 * xx, 1u, __ATOMIC_RELAXED, __HIP_MEMORY_SCOPE_AGENT);
        t = (unsigned)__builtin_amdgcn_readfirstlane((int)t); return t < lcount(xx) ? (unsigned)lstart(xx) + t : FLOW_NONE; }
    __device__ __forceinline__ unsigned steal() const {
        for (int k = 1; k < 8; ++k) { const int xx = (x + k) & 7;
            const unsigned h = (unsigned)__builtin_amdgcn_readfirstlane((int)__hip_atomic_load(q + 64 * xx, __ATOMIC_RELAXED, __HIP_MEMORY_SCOPE_AGENT)); if (h >= lcount(xx)) continue;
            const unsigned id = take(xx); if (id != FLOW_NONE) return id; }
        return FLOW_NONE; }
    __device__ __forceinline__ unsigned claim_blocking() const {
        if (__builtin_amdgcn_readfirstlane((int)slot[3]) == 0) { const unsigned id = take(x); if (id != FLOW_NONE) return id; if ((threadIdx.x & 63) == 0) slot[3] = 1u; }
        return steal(); }
    __device__ __forceinline__ void begin() const {
        if (threadIdx.x < 64) {
            if (threadIdx.x == 0) { slot[3] = 0u; slot[5] = 0u; }
            const unsigned u0 = claim_blocking(); const unsigned u1 = u0 != FLOW_NONE ? claim_blocking() : FLOW_NONE;
            if (threadIdx.x == 0) { slot[0] = u0; slot[1] = u1; slot[4] = 2u; if (u1 == FLOW_NONE) slot[5] = 1u; } }
        asm volatile("s_waitcnt lgkmcnt(0)" ::: "memory"); __builtin_amdgcn_s_barrier(); asm volatile("" ::: "memory"); }
    __device__ __forceinline__ bool peek(int i, pg8::Unit& u) const { const unsigned id = (unsigned)__builtin_amdgcn_readfirstlane((int)slot[i % 3]); if (id == FLOW_NONE) return false; decode(id, u); return true; }
    __device__ __forceinline__ void a_ready(const pg8::Unit& u, int prev_pm) const {
        if (dep == nullptr || u.pm == prev_pm) return;
        if (threadIdx.x < 64) {
            const unsigned long long t0 = __builtin_amdgcn_s_memrealtime(); unsigned polls = 0;
            while ((unsigned)__builtin_amdgcn_readfirstlane((int)__hip_atomic_load(dep + 64 * u.pm, __ATOMIC_RELAXED, __HIP_MEMORY_SCOPE_AGENT)) < need) {
                if ((++polls & 255u) == 0u && __builtin_amdgcn_readfirstlane((int)__hip_atomic_load(tmo, __ATOMIC_RELAXED, __HIP_MEMORY_SCOPE_AGENT)) != 0) break;
                if (__builtin_amdgcn_s_memrealtime() - t0 > 2000000ull) {
                    if (threadIdx.x == 0) { unsigned expect = 0u; __hip_atomic_compare_exchange_strong(tmo + 1, &expect, 0x600u | (unsigned)(u.pm & 0xff), __ATOMIC_RELAXED, __ATOMIC_RELAXED, __HIP_MEMORY_SCOPE_AGENT); __hip_atomic_store(tmo, 1u, __ATOMIC_RELAXED, __HIP_MEMORY_SCOPE_AGENT); }
                    break; }
                __builtin_amdgcn_s_sleep(2); }
            __builtin_amdgcn_fence(__ATOMIC_ACQUIRE, "agent");
            asm volatile("s_waitcnt vmcnt(0)" ::: "memory");
        }
        asm volatile("" ::: "memory"); __builtin_amdgcn_s_barrier(); asm volatile("" ::: "memory"); }
    __device__ __forceinline__ void done(const pg8::Unit& u) {
        if (pub) pend_pm = u.pm;
        if (threadIdx.x < 64) {
            const bool all_empty = __builtin_amdgcn_readfirstlane((int)slot[5]) != 0, own_empty = __builtin_amdgcn_readfirstlane((int)slot[3]) != 0;
            pend_kind = all_empty ? 0 : (own_empty ? 2 : 1);
            if (pend_kind == 1 && threadIdx.x == 0) pend_t = __hip_atomic_fetch_add(q + 64 * x, 1u, __ATOMIC_RELAXED, __HIP_MEMORY_SCOPE_AGENT); } }
    __device__ __forceinline__ void mid() {
        if (pend_pm < 0 && pend_kind == 0) return;
        asm volatile("s_waitcnt vmcnt(0)" ::: "memory");
        if (pend_pm >= 0) { if ((threadIdx.x & 63) == 0) __hip_atomic_fetch_add(pub + 64 * pend_pm, 1u, __ATOMIC_RELAXED, __HIP_MEMORY_SCOPE_AGENT); pend_pm = -1; }
        if (threadIdx.x < 64 && pend_kind != 0) {
            unsigned id = FLOW_NONE;
            if (pend_kind == 1) { const unsigned t = (unsigned)__builtin_amdgcn_readfirstlane((int)pend_t); if (t < lcount(x)) id = (unsigned)lstart(x) + t; else { if (threadIdx.x == 0) slot[3] = 1u; id = steal(); } }
            else id = steal();
            if (id == FLOW_NONE && threadIdx.x == 0) slot[5] = 1u;
            const unsigned ci = (unsigned)__builtin_amdgcn_readfirstlane((int)slot[4]);
            if (threadIdx.x == 0) { slot[ci % 3u] = id; slot[4] = ci + 1u; }
            pend_kind = 0; } }
    __device__ __forceinline__ void flush() {
        if (pend_pm >= 0) { if ((threadIdx.x & 63) == 0) __hip_atomic_fetch_add(pub + 64 * pend_pm, 1u, __ATOMIC_RELAXED, __HIP_MEMORY_SCOPE_AGENT); pend_pm = -1; } }
};
template <bool WT> __device__ __forceinline__ void st_b128(void* p, const v4u& v) { if constexpr (WT) asm volatile("global_store_dwordx4 %0, %1, off sc1" :: "v"(p), "v"(v) : "memory"); else *(v4u*)p = v; }
template <bool WT> __device__ __forceinline__ void st_b32(void* p, float v) { if constexpr (WT) asm volatile("global_store_dword %0, %1, off sc1" :: "v"(p), "v"(v) : "memory"); else *(float*)p = v; }

__device__ __forceinline__ void row_rscale8(const float* rs, int row0, float (&r8)[8]) {
#pragma unroll
    for (int ai = 0; ai < 2; ++ai)
#pragma unroll
        for (int m = 0; m < 4; ++m) r8[ai * 4 + m] = rs[row0 + ai * 128 + m * 16];
}
__device__ __forceinline__ float silu_f(float g) { return g * __builtin_amdgcn_rcpf(1.0f + __expf(-g)); }

typedef float f32x2 __attribute__((ext_vector_type(2)));
template <bool WT> struct EpiSwiglu {
    static constexpr bool PERM = true, AFTER_DRAIN = false;
    bf16* O; const float* rs;
    __device__ __forceinline__ void operator()(const f32x4 (&acc)[2][2][4][2], const pg8::Unit& u, int wr, int wc, int fr, int fq) const {
        const int row0 = u.pm * 256 + wr * 64 + fr, col0 = u.pn * 128 + wc * 32 + 8 * fq;
        float r8[8]; row_rscale8(rs, row0, r8);
#pragma unroll
        for (int ai = 0; ai < 2; ++ai)
#pragma unroll
            for (int m = 0; m < 4; ++m) {
                const int row = row0 + ai * 128 + m * 16;
                const float r1 = r8[ai * 4 + m] * 1.4426950408889634f, r2 = r8[ai * 4 + m] * 0.6931471805599453f;
                f32x2 o[4];
#pragma unroll
                for (int n = 0; n < 2; ++n)
#pragma unroll
                    for (int jp = 0; jp < 2; ++jp) {
                        const f32x2 g2 = (f32x2){acc[ai][0][m][n][2 * jp], acc[ai][0][m][n][2 * jp + 1]}, u2 = (f32x2){acc[ai][1][m][n][2 * jp], acc[ai][1][m][n][2 * jp + 1]};
                        const f32x2 t2 = g2 * r1;
                        f32x2 d2 = (f32x2){__builtin_amdgcn_exp2f(-t2.x), __builtin_amdgcn_exp2f(-t2.y)} + 1.0f;
                        const f32x2 s2 = (f32x2){__builtin_amdgcn_rcpf(d2.x), __builtin_amdgcn_rcpf(d2.y)};
                        o[2 * n + jp] = (t2 * s2) * (u2 * r2);
                    }
                v4u w; w.x = pk2(o[0].x, o[0].y); w.y = pk2(o[1].x, o[1].y); w.z = pk2(o[2].x, o[2].y); w.w = pk2(o[3].x, o[3].y);
                const int kt = u.pn * 2 + (wc >> 1), R = wr * 64 + m * 16 + fr, C = (wc & 1) * 32 + 8 * fq;
                st_b128<WT>(O + ((((size_t)u.pm * (DFF / 64) + kt) * 2 + ai) * 8192 + (size_t)R * 64 + C), w);
            }
    }
};
constexpr int TS_PM0 = 64, TS_PARTS = 4, TS_TILES = 24;
static_assert((DFF / TS_PARTS) % 128 == 0 && (DM / TS_PARTS) % 128 == 0, "split-K part depth");
typedef float f32x8 __attribute__((ext_vector_type(8)));
template <bool FINAL, bool WT> struct EpiResid {
    static constexpr bool PERM = true, AFTER_DRAIN = false;
    const bf16* HI; bf16* AB; float* ssq; float* out; float* slab; float sc; int nt_full;
    __device__ __forceinline__ void operator()(const f32x4 (&acc)[2][2][4][2], const pg8::Unit& u, int wr, int wc, int fr, int fq) const {
        const int row0 = u.pm * 256 + wr * 64 + fr, col0 = u.pn * 256 + wc * 32 + 8 * fq;
        if (u.nt != nt_full) {
            float* sp = slab + (size_t)((((u.pm - TS_PM0) * 8 + u.pn) * TS_PARTS) + u.koff / (u.nt * 128)) * 65536 + (size_t)(wr * 64 + fr) * 256 + wc * 32 + 8 * fq;
#pragma unroll
            for (int ai = 0; ai < 2; ++ai)
#pragma unroll
                for (int m = 0; m < 4; ++m)
#pragma unroll
                    for (int bj = 0; bj < 2; ++bj) { float* q = sp + (ai * 128 + m * 16) * 256 + bj * 128; *(f32x4*)q = acc[ai][bj][m][0]; *(f32x4*)(q + 4) = acc[ai][bj][m][1]; }
            return; }
        f32x8 ssv = (f32x8){0.f, 0.f, 0.f, 0.f, 0.f, 0.f, 0.f, 0.f};
#pragma unroll
        for (int ai = 0; ai < 2; ++ai) {
            v4u hbv[4][2];
#pragma unroll
            for (int m = 0; m < 4; ++m)
#pragma unroll
                for (int bj = 0; bj < 2; ++bj) hbv[m][bj] = *(const v4u*)(HI + (size_t)(row0 + ai * 128 + m * 16) * DM + col0 + bj * 128);
#pragma unroll
            for (int m = 0; m < 4; ++m) {
                const int row = row0 + ai * 128 + m * 16;
                float ss = 0.f;
                float* op = nullptr;
                if (FINAL) {
                    if (row < MPR) { const int b = row / TP, t = row - b * TP; if (t >= NMETA) op = out + O_YP + ((size_t)b * SEQ + (t - NMETA)) * DM + col0; }
                    else if (row < MREAL) op = out + O_YS + (size_t)(row - MPR) * DM + col0;
                }
#pragma unroll
                for (int bj = 0; bj < 2; ++bj) {
                    const v4u hb = hbv[m][bj];
                    const f32x4 h0 = (f32x4){bflo(hb.x), bfhi(hb.x), bflo(hb.y), bfhi(hb.y)}, h1 = (f32x4){bflo(hb.z), bfhi(hb.z), bflo(hb.w), bfhi(hb.w)};
                    const f32x4 n0 = h0 + acc[ai][bj][m][0] * sc, n1 = h1 + acc[ai][bj][m][1] * sc;
                    if (FINAL) { if (op) { *(f32x4*)(op + bj * 128) = n0; *(f32x4*)(op + bj * 128 + 4) = n1; } }
                    else {
                        v4u w; w.x = pk2(n0[0], n0[1]); w.y = pk2(n0[2], n0[3]); w.z = pk2(n1[0], n1[1]); w.w = pk2(n1[2], n1[3]);
                        st_b128<WT>(AB + (size_t)row * DM + col0 + bj * 128, w);
                        ss += (n0[0] * n0[0] + n0[1] * n0[1]) + (n0[2] * n0[2] + n0[3] * n0[3]) + (n1[0] * n1[0] + n1[1] * n1[1]) + (n1[2] * n1[2] + n1[3] * n1[3]);
                    }
                }
                ssv[ai * 4 + m] = ss;
            }
        }
        if (!FINAL) {
#pragma unroll
            for (int i = 0; i < 8; ++i) ssv[i] += __shfl_xor(ssv[i], 16);
#pragma unroll
            for (int i = 0; i < 8; ++i) ssv[i] += __shfl_xor(ssv[i], 32);
            if (fq == 0) {
#pragma unroll
                for (int i = 0; i < 8; ++i) st_b32<WT>(ssq + (size_t)(row0 + (i >> 2) * 128 + (i & 3) * 16) * 32 + u.pn * 4 + wc, ssv[i]); }
        }
    }
};
struct EpiQkvo {
    static constexpr bool PERM = true, AFTER_DRAIN = false;
    bf16* O; const float* rs; float* gates; const float* bias;
    __device__ __forceinline__ void operator()(const f32x4 (&acc)[2][2][4][2], const pg8::Unit& u, int wr, int wc, int fr, int fq) const {
        const int row0 = u.pm * 256 + wr * 64 + fr, col0 = u.pn * 256 + wc * 32 + 8 * fq;
        const bool gate_tile = (u.pn == NAIN / 256);
        float r8[8]; row_rscale8(rs, row0, r8);
#pragma unroll
        for (int i = 0; i < 8; ++i) asm volatile("" : "+v"(r8[i]));
#pragma unroll
        for (int ai = 0; ai < 2; ++ai)
#pragma unroll
            for (int m = 0; m < 4; ++m) {
                const int row = row0 + ai * 128 + m * 16;
                const float r = r8[ai * 4 + m];
                if (!gate_tile) {
#pragma unroll
                    for (int bj = 0; bj < 2; ++bj) { const f32x4 v0 = acc[ai][bj][m][0] * r, v1 = acc[ai][bj][m][1] * r;
                        v4u w; w.x = pk2(v0[0], v0[1]); w.y = pk2(v0[2], v0[3]); w.z = pk2(v1[0], v1[1]); w.w = pk2(v1[2], v1[3]);
                        *(v4u*)(O + (size_t)row * NAIN + col0 + bj * 128) = w; }
                } else if (wc == 0 && fq == 0) {
                    const f32x4 bi = *(const f32x4*)bias, bf = *(const f32x4*)(bias + 4);
                    const f32x4 xi = acc[ai][0][m][0] * r + bi, xf = acc[ai][0][m][1] * r + bf;
                    f32x4 gi, gf;
#pragma unroll
                    for (int j = 0; j < 4; ++j) { gi[j] = 15.0f * tanhf(xi[j] * (1.0f / 15.0f)); const float c = 15.0f * tanhf(xf[j] * (1.0f / 15.0f));
                        gf[j] = fminf(c, 0.f) - log1pf(expf(-fabsf(c))); }
                    *(f32x4*)(gates + (size_t)row * 8) = gi; *(f32x4*)(gates + (size_t)row * 8 + 4) = gf;
                }
            }
    }
};
struct EpiHead {
    static constexpr bool PERM = true, AFTER_DRAIN = false;
    bf16* O0; int ld0; bf16* O1; int ld1; int norm_tiles; const float* rs; const float* gain; float post; float* slab; int nt_full;
    __device__ __forceinline__ void operator()(const f32x4 (&acc)[2][2][4][2], const pg8::Unit& u, int wr, int wc, int fr, int fq) const {
        const int row0 = u.pm * 256 + wr * 64 + fr;
        if (u.nt != nt_full) {
            float* sp = slab + (size_t)((((u.pm - TS_PM0) * 8 + u.pn) * TS_PARTS) + u.koff / (u.nt * 128)) * 65536 + (size_t)(wr * 64 + fr) * 256 + wc * 32 + 8 * fq;
#pragma unroll
            for (int ai = 0; ai < 2; ++ai)
#pragma unroll
                for (int m = 0; m < 4; ++m)
#pragma unroll
                    for (int bj = 0; bj < 2; ++bj) { float* q = sp + (ai * 128 + m * 16) * 256 + bj * 128; *(f32x4*)q = acc[ai][bj][m][0]; *(f32x4*)(q + 4) = acc[ai][bj][m][1]; }
            return; }
        const bool normed = u.pn < norm_tiles;
        bf16* base = normed ? O0 + (size_t)u.pn * 256 : O1 + (size_t)(u.pn - norm_tiles) * 256;
        const int ld = normed ? ld0 : ld1;
        float r8[8]; row_rscale8(rs, row0, r8);
        f32x4 gn[2][2];
#pragma unroll
        for (int bj = 0; bj < 2; ++bj)
#pragma unroll
            for (int n = 0; n < 2; ++n) gn[bj][n] = normed ? *(const f32x4*)(gain + 32 * bj + 8 * fq + 4 * n) * post : (f32x4){1.f, 1.f, 1.f, 1.f};
#pragma unroll
        for (int ai = 0; ai < 2; ++ai)
#pragma unroll
            for (int m = 0; m < 4; ++m) {
                const int row = row0 + ai * 128 + m * 16;
                const float r = r8[ai * 4 + m];
                f32x4 x[2][2]; float ms = 0.f;
#pragma unroll
                for (int bj = 0; bj < 2; ++bj)
#pragma unroll
                    for (int n = 0; n < 2; ++n) { x[bj][n] = acc[ai][bj][m][n] * r; const f32x4 q = x[bj][n] * x[bj][n]; ms += (q[0] + q[1]) + (q[2] + q[3]); }
                ms += __shfl_xor(ms, 16); ms += __shfl_xor(ms, 32);
                const float inv = normed ? rsqrtf(ms * (1.0f / 64.0f) + EPS) : 1.0f;
#pragma unroll
                for (int bj = 0; bj < 2; ++bj) { const f32x4 v0 = x[bj][0] * inv * gn[bj][0], v1 = x[bj][1] * inv * gn[bj][1];
                    v4u w; w.x = pk2(v0[0], v0[1]); w.y = pk2(v0[2], v0[3]); w.z = pk2(v1[0], v1[1]); w.w = pk2(v1[2], v1[3]);
                    *(v4u*)(base + (size_t)row * ld + wc * 64 + 32 * bj + 8 * fq) = w; }
            }
    }
};

struct Args { const float* in[25]; float* out; unsigned char* ws; };
enum { I_XP = 0, I_XS, I_SC, I_SN, I_SM, I_CKM, I_CVM, I_CKW, I_CVW, I_META, I_FFNN, I_WFI, I_WFO, I_MIXN, I_WAI, I_BAG, I_AHN, I_WAO, I_KVN, I_WKV, I_KN, I_WQ, I_QN, I_SINK, I_WBO };
struct CvtItem { const float* lp; const float* gain; bf16* dp; int ldw; int valid; float scale; int K; };
constexpr int IT_W1 = (DM / 64) * (2 * DFF / 64), IT_W2 = (DFF / 64) * (DM / 64), IT_AIN = (DM / 64) * (NAIN_PAD / 64), IT_SQ = (DM / 64) * (DM / 64), IT_KV = (DM / 64) * (512 / 64);
constexpr int CVT_NITEMS = 4 * IT_W1 + 4 * IT_W2 + IT_AIN + IT_SQ + IT_KV + IT_SQ + IT_SQ;
__device__ __forceinline__ CvtItem cvt_decode(const Args& a, int it, int lane) {
    unsigned char* ws = a.ws; const int l16 = lane & 15, q = lane >> 4, nl = 4 * l16;
    CvtItem c; c.valid = 1; c.scale = 1.0f; c.gain = nullptr;
    int r = it, kb, n0, col; const float* W; bf16* dst;
    if (r < 4 * IT_W1) { const int f = r / IT_W1; r -= f * IT_W1; const int nblk = 2 * DFF / 64; kb = r / nblk; n0 = 64 * (r % nblk); const int tile = n0 >> 8, within = (n0 & 255) + nl;
        col = within < 128 ? 128 * tile + within : DFF + 128 * tile + (within - 128);
        W = a.in[I_WFI] + (size_t)f * DM * 2 * DFF; c.ldw = 2 * DFF; c.K = DM; c.gain = a.in[I_FFNN] + f * DM; dst = (bf16*)(ws + WS_W1 + f * SZ_W1); }
    else if ((r -= 4 * IT_W1) < 4 * IT_W2) { const int f = r / IT_W2; r -= f * IT_W2; const int nblk = DM / 64; kb = r / nblk; n0 = 64 * (r % nblk); col = n0 + nl;
        W = a.in[I_WFO] + (size_t)f * DFF * DM; c.ldw = DM; c.K = DFF; dst = (bf16*)(ws + WS_W2 + f * SZ_W2); }
    else if ((r -= 4 * IT_W2) < IT_AIN) { const int nblk = NAIN_PAD / 64; kb = r / nblk; n0 = 64 * (r % nblk); col = n0 + nl;
        c.valid = col < NAIN + 8 ? 1 : 0; if (!c.valid) col = 0; c.scale = (n0 >= 1024 && n0 < 2048) ? 0.0625f : 1.0f;
        W = a.in[I_WAI]; c.ldw = NAIN + 8; c.K = DM; c.gain = a.in[I_MIXN]; dst = (bf16*)(ws + WS_WAIN); }
    else if ((r -= IT_AIN) < IT_SQ) { const int nblk = DM / 64; kb = r / nblk; n0 = 64 * (r % nblk); col = n0 + nl; W = a.in[I_WAO]; c.ldw = DM; c.K = DM; dst = (bf16*)(ws + WS_WAOUT); }
    else if ((r -= IT_SQ) < IT_KV) { const int nblk = 512 / 64; kb = r / nblk; n0 = 64 * (r % nblk); const int d = n0 + nl, tile = d >> 8, within = d & 255, bj = within >> 7, wc = (within >> 5) & 3;
        col = 256 * tile + 64 * wc + 32 * bj + (within & 31); W = a.in[I_WKV]; c.ldw = 512; c.K = DM; c.gain = a.in[I_KVN]; dst = (bf16*)(ws + WS_WKV); }
    else if ((r -= IT_KV) < IT_SQ) { const int nblk = DM / 64; kb = r / nblk; n0 = 64 * (r % nblk); const int d = n0 + nl, tile = d >> 8, within = d & 255, bj = within >> 7, wc = (within >> 5) & 3;
        col = 256 * tile + 64 * wc + 32 * bj + (within & 31); W = a.in[I_WQ]; c.ldw = DM; c.K = DM; c.gain = a.in[I_MIXN] + DM; dst = (bf16*)(ws + WS_WQ); }
    else { r -= IT_SQ; const int nblk = DM / 64; kb = r / nblk; n0 = 64 * (r % nblk); col = n0 + nl; W = a.in[I_WBO]; c.ldw = DM; c.K = DM; dst = (bf16*)(ws + WS_WBO); }
    c.lp = W + (size_t)(64 * kb + q) * c.ldw + col;
    if (c.gain) c.gain += 64 * kb;
    c.dp = dst + ((((size_t)(n0 >> 8) * (c.K / 64) + kb) * 2 + ((n0 >> 7) & 1)) * 8192 + (size_t)(n0 & 127) * 64);
    return c;
}
__device__ __forceinline__ void cvt_load(const CvtItem& c, f32x4 (&r)[16]) {
#pragma unroll
    for (int i = 0; i < 16; ++i) r[i] = c.valid ? *(const f32x4*)(c.lp + (size_t)(4 * i) * c.ldw) : (f32x4){0.f, 0.f, 0.f, 0.f};
}
__device__ __forceinline__ void cvt_store(const CvtItem& c, const f32x4 (&r)[16], LAS float* scr, int lane) {
    const int l16 = lane & 15, q = lane >> 4;
#pragma unroll
    for (int i = 0; i < 16; ++i) { LAS float* s = scr + (4 * i + q) * 65 + 4 * l16; s[0] = r[i][0]; s[1] = r[i][1]; s[2] = r[i][2]; s[3] = r[i][3]; }
    LDS_WAIT(); asm volatile("" ::: "memory");
    const int ch = lane & 7;
    f32x4 g0 = (f32x4){c.scale, c.scale, c.scale, c.scale}, g1 = g0;
    if (c.gain) { g0 = *(const f32x4*)(c.gain + 8 * ch) * c.scale; g1 = *(const f32x4*)(c.gain + 8 * ch + 4) * c.scale; }
#pragma unroll
    for (int j = 0; j < 8; ++j) { const int n = (lane >> 3) + 8 * j; const LAS float* s = scr + (8 * ch) * 65 + n;
        v4u o; o.x = pk2(s[0 * 65] * g0[0], s[1 * 65] * g0[1]); o.y = pk2(s[2 * 65] * g0[2], s[3 * 65] * g0[3]); o.z = pk2(s[4 * 65] * g1[0], s[5 * 65] * g1[1]); o.w = pk2(s[6 * 65] * g1[2], s[7 * 65] * g1[3]);
        *(v4u*)(c.dp + (size_t)n * 64 + 8 * ch) = o; }
    LDS_WAIT(); asm volatile("" ::: "memory");
}

__device__ __forceinline__ void p0_prologue(const Args& a, LAS unsigned char* lds, int gw, int NGW, int wave, int lane) {
    LAS float* scr = (LAS float*)(lds + wave * 16640);
    unsigned char* ws = a.ws;
    {
        f32x4 r0[16], r1[16]; int it = gw;
        if (it < CVT_NITEMS) {
            CvtItem c0 = cvt_decode(a, it, lane); CvtItem c1 = cvt_decode(a, it, lane); cvt_load(c0, r0);
            for (;;) {
                it += NGW; const bool h1 = it < CVT_NITEMS; if (h1) { c1 = cvt_decode(a, it, lane); cvt_load(c1, r1); }
                cvt_store(c0, r0, scr, lane);
                if (!h1) break;
                it += NGW; const bool h0 = it < CVT_NITEMS; if (h0) { c0 = cvt_decode(a, it, lane); cvt_load(c0, r0); }
                cvt_store(c1, r1, scr, lane);
                if (!h0) break;
            }
        }
    }
    bf16* AB = (bf16*)(ws + WS_AB); float* RS = (float*)(ws + WS_RS);
    for (int rw0 = gw; rw0 < MP; rw0 += 2 * NGW) {
        f32x4 v0[2][4], v1[2][4];
#pragma unroll
        for (int q = 0; q < 2; ++q) { const int row = rw0 + q * NGW; const float* src = nullptr;
            if (row < MPR) { const int b = row / TP, t = row - b * TP; src = t < NMETA ? a.in[I_META] + (size_t)t * DM : a.in[I_XP] + ((size_t)b * SEQ + (t - NMETA)) * DM; }
            else if (row < MREAL) src = a.in[I_XS] + (size_t)(row - MPR) * DM;
#pragma unroll
            for (int j = 0; j < 4; ++j) { v0[q][j] = (f32x4){0.f, 0.f, 0.f, 0.f}; v1[q][j] = v0[q][j];
                if (src) { v0[q][j] = *(const f32x4*)(src + 512 * j + 8 * lane); v1[q][j] = *(const f32x4*)(src + 512 * j + 8 * lane + 4); } } }
#pragma unroll
        for (int q = 0; q < 2; ++q) { const int row = rw0 + q * NGW; if (row < MP) { float ss = 0.f;
#pragma unroll
            for (int j = 0; j < 4; ++j) {
                v4u w; w.x = pk2(v0[q][j][0], v0[q][j][1]); w.y = pk2(v0[q][j][2], v0[q][j][3]); w.z = pk2(v1[q][j][0], v1[q][j][1]); w.w = pk2(v1[q][j][2], v1[q][j][3]);
                *(v4u*)(AB + (size_t)row * DM + 512 * j + 8 * lane) = w;
                ss += (v0[q][j][0] * v0[q][j][0] + v0[q][j][1] * v0[q][j][1]) + (v0[q][j][2] * v0[q][j][2] + v0[q][j][3] * v0[q][j][3]) + (v1[q][j][0] * v1[q][j][0] + v1[q][j][1] * v1[q][j][1]) + (v1[q][j][2] * v1[q][j][2] + v1[q][j][3] * v1[q][j][3]);
            }
            ss = wave_sum(ss);
            if (lane == 0) RS[row] = rsqrtf(ss * (1.0f / DM) + EPS); } }
    }
}

constexpr int ML_KN = 0, ML_KNS = 272, ML_KT = 34816, ML_KTS = 272, ML_VT = 69632, ML_VTS = 272, ML_CTB = ML_VT + 80 * 272  , ML_CTBS = 528, ML_GA = ML_CTB + 80 * 528  ;
static_assert(ML_GA + 2816 <= SCR_BYTES, "mLSTM LDS map");

#define ML_HALF(DH) do { \
    _Pragma("unroll") for (int ks = 0; ks < 4; ++ks) { bf16x8 fa_[8]; \
        _Pragma("unroll") for (int jb = 0; jb < 8; ++jb) fa_[jb] = *(const LAS bf16x8*)(lds + ML_KN + (16 * jb + i16) * ML_KNS + (32 * ks + 8 * g) * 2); \
        _Pragma("unroll") for (int jb = 0; jb < 8; ++jb) as_[jb] = MFMA16(fa_[jb], qf[4 * (DH) + ks], as_[jb]); } \
    _Pragma("unroll") for (int vb = 0; vb < 5; ++vb) accC[DH][vb] = accC[DH][vb] * decay; \
    _Pragma("unroll") for (int ks = 0; ks < 4; ++ks) { bf16x8 fv_[5]; \
        const bf16x8 bfr = *(const LAS bf16x8*)(lds + ML_KT + (16 * wave + i16) * ML_KTS + (32 * ks + 8 * g) * 2); \
        _Pragma("unroll") for (int vb = 0; vb < 5; ++vb) fv_[vb] = *(const LAS bf16x8*)(lds + ML_VT + (16 * vb + i16) * ML_VTS + (32 * ks + 8 * g) * 2); \
        _Pragma("unroll") for (int vb = 0; vb < 5; ++vb) accC[DH][vb] = MFMA16(fv_[vb], bfr, accC[DH][vb]); } \
} while (0)
#define ML_PUT_CTB(DH) do { _Pragma("unroll") for (int vb = 0; vb < 5; ++vb) _Pragma("unroll") for (int r = 0; r < 4; ++r) \
    *(LAS bf16*)(lds + ML_CTB + (16 * vb + 4 * g + r) * ML_CTBS + (128 * (DH) + 16 * wave + i16) * 2) = bf16_rne(accC[DH][vb][r]); } while (0)
#define ML_LOAD_K_ISSUE(DH, R0, R1) do { _Pragma("unroll") for (int it = 0; it < 2; ++it) { const int dc = wave + 8 * it; \
    const bf16* kp = QKVO + (rowbase + 2 * lane) * NAIN + 1024 + h * ADK + 128 * (DH) + 8 * dc; R0[it] = *(const v4u*)kp; R1[it] = *(const v4u*)(kp + NAIN); } } while (0)
#define ML_LOAD_K_PUT(R0, R1) do { const float w0 = ga[512 + 2 * lane], w1 = ga[512 + 2 * lane + 1]; \
    _Pragma("unroll") for (int it = 0; it < 2; ++it) { const int dc = wave + 8 * it; \
    *(LAS v4u*)(lds + ML_KN + (2 * lane) * ML_KNS + 16 * dc) = R0[it]; *(LAS v4u*)(lds + ML_KN + (2 * lane + 1) * ML_KNS + 16 * dc) = R1[it]; \
    _Pragma("unroll") for (int e = 0; e < 8; ++e) *(LAS unsigned*)(lds + ML_KT + (8 * dc + e) * ML_KTS + 4 * lane) = pk2(__uint_as_float(bfel(R0[it], e) << 16) * w0, __uint_as_float(bfel(R1[it], e) << 16) * w1); } } while (0)

__device__ __forceinline__ void mlstm_prompt_unit(LAS unsigned char* lds, const bf16* QKVO, const float* GATES, float* HM, float* HSSQ, float* out, int b, int h, int j, int tid, int wave, int lane) {
    const int i16 = lane & 15, g = lane >> 4;
    LAS float* ga = (LAS float*)(lds + ML_GA);
    f32x4 accC[2][5];
#pragma unroll
    for (int dh = 0; dh < 2; ++dh)
#pragma unroll
        for (int vb = 0; vb < 5; ++vb) accC[dh][vb] = (f32x4){0.f, 0.f, 0.f, 0.f};
    __syncthreads();
    for (int o = tid * 16; o < 80 * ML_CTBS; o += 512 * 16) *(LAS v4u*)(lds + ML_CTB + o) = (v4u){0u, 0u, 0u, 0u};
    for (int o = tid; o < 16 * 64; o += 512) { const int rr = o >> 6, cc = o & 63; *(LAS unsigned*)(lds + ML_VT + (64 + rr) * ML_VTS + cc * 4) = rr == 0 ? 0x3F803F80u : 0u; }
    float m_prev = 0.f;
    for (int c = 0; c < 17; ++c) {
        const int tok0 = c == 0 ? 0 : NMETA + 128 * (c - 1), nvalid = c == 0 ? NMETA : 128;
        const size_t rowbase = (size_t)b * TP + tok0;
        __syncthreads();
        bf16x8 qf[8];
        { const bf16* qp = QKVO + (rowbase + 16 * wave + i16) * NAIN + h * ADK + 8 * g;
#pragma unroll
          for (int ks = 0; ks < 8; ++ks) qf[ks] = *(const bf16x8*)(qp + 32 * ks); }
        if (wave == 0) {
            const int t0 = 2 * lane, t1 = t0 + 1;
            float ig0 = -1e30f, ig1 = -1e30f, lf0 = 0.f, lf1 = 0.f;
            if (t0 < nvalid) { const float* gp = GATES + (rowbase + t0) * 8; ig0 = gp[h]; lf0 = gp[4 + h]; }
            if (t1 < nvalid) { const float* gp = GATES + (rowbase + t1) * 8; ig1 = gp[h]; lf1 = gp[4 + h]; }
            const float c1 = lf0 + lf1; float sc = c1;
#pragma unroll
            for (int o = 1; o < 64; o <<= 1) { const float t = __shfl_up(sc, o); if (lane >= o) sc += t; }
            const float excl = sc - c1, b0 = excl + lf0, b1 = excl + c1;
            const float a0 = ig0 - b0, a1 = ig1 - b1;
            float smx = fmaxf(a0, a1);
#pragma unroll
            for (int o = 1; o < 64; o <<= 1) { const float t = __shfl_up(smx, o); if (lane >= o) smx = fmaxf(smx, t); }
            float exm = __shfl_up(smx, 1); if (lane == 0) exm = -INFINITY;
            const float p0 = fmaxf(exm, a0), p1 = fmaxf(p0, a1);
            const float pm0 = fmaxf(m_prev, p0), pm1 = fmaxf(m_prev, p1);
            const float Mx = fmaxf(m_prev, __shfl(smx, 63)), blast = __shfl(b1, 63);
            ga[t0] = a0; ga[t1] = a1; ga[128 + t0] = pm0; ga[128 + t1] = pm1;
            ga[256 + t0] = __expf(m_prev - pm0); ga[256 + t1] = __expf(m_prev - pm1);
            ga[384 + t0] = __expf(-(b0 + pm0)); ga[384 + t1] = __expf(-(b1 + pm1));
            ga[512 + t0] = __expf(a0 - Mx); ga[512 + t1] = __expf(a1 - Mx);
            if (lane == 0) ga[640] = __expf(m_prev - Mx);
            m_prev = blast + Mx;
        }
        __syncthreads();
        {
            const bf16* vp = QKVO + (rowbase + 2 * lane) * NAIN + 2048 + h * ADV + 64 * j + 8 * wave;
            const v4u r0 = *(const v4u*)vp, r1 = *(const v4u*)(vp + NAIN);
            v4u ka[2], kb[2]; ML_LOAD_K_ISSUE(0, ka, kb);
#pragma unroll
            for (int e = 0; e < 8; ++e) *(LAS unsigned*)(lds + ML_VT + (8 * wave + e) * ML_VTS + 4 * lane) = bfel(r0, e) | (bfel(r1, e) << 16);
            ML_LOAD_K_PUT(ka, kb);
        }
        __syncthreads();
        const float decay = ga[640];
        f32x4 aqc[5], as_[8];
#pragma unroll
        for (int vb = 0; vb < 5; ++vb) aqc[vb] = (f32x4){0.f, 0.f, 0.f, 0.f};
#pragma unroll
        for (int ks = 0; ks < 8; ++ks) { bf16x8 fb_[5];
#pragma unroll
            for (int vb = 0; vb < 5; ++vb) fb_[vb] = *(const LAS bf16x8*)(lds + ML_CTB + (16 * vb + i16) * ML_CTBS + (32 * ks + 8 * g) * 2);
#pragma unroll
            for (int vb = 0; vb < 5; ++vb) aqc[vb] = MFMA16(qf[ks], fb_[vb], aqc[vb]); }
#pragma unroll
        for (int jb = 0; jb < 8; ++jb) as_[jb] = (f32x4){0.f, 0.f, 0.f, 0.f};
        ML_HALF(0);
        __syncthreads();
        { v4u ka[2], kb[2]; ML_LOAD_K_ISSUE(1, ka, kb);
          ML_PUT_CTB(0);
          ML_LOAD_K_PUT(ka, kb); }
        __syncthreads();
        ML_HALF(1);
        ML_PUT_CTB(1);
        const int tl = 16 * wave + i16; const float pmt = ga[128 + tl];
        bf16x8 pf[4];
#pragma unroll
        for (int kk = 0; kk < 4; ++kk) { float pv[8];
#pragma unroll
            for (int hb = 0; hb < 2; ++hb) { const int jb = 2 * kk + hb; const f32x4 av = *(const LAS f32x4*)(ga + 16 * jb + 4 * g);
#pragma unroll
                for (int r = 0; r < 4; ++r) { const int s = 16 * jb + 4 * g + r; const float wgt = (s <= tl) ? __expf(av[r] - pmt) : 0.f; pv[4 * hb + r] = as_[jb][r] * wgt; } }
            v4u w; w.x = pk2m(pv[0], pv[1]); w.y = pk2m(pv[2], pv[3]); w.z = pk2m(pv[4], pv[5]); w.w = pk2m(pv[6], pv[7]); pf[kk] = __builtin_bit_cast(bf16x8, w); }
        f32x4 apv[5];
#pragma unroll
        for (int vb = 0; vb < 5; ++vb) apv[vb] = (f32x4){0.f, 0.f, 0.f, 0.f};
#pragma unroll
        for (int kk = 0; kk < 4; ++kk) { v4u wv_[5];
#pragma unroll
            for (int vb = 0; vb < 5; ++vb) { const LAS unsigned char* vp = lds + ML_VT + (16 * vb + i16) * ML_VTS + (32 * kk + 4 * g) * 2;
                const v2u lo = *(const LAS v2u*)vp, hi = *(const LAS v2u*)(vp + 32); wv_[vb] = (v4u){lo.x, lo.y, hi.x, hi.y}; }
#pragma unroll
            for (int vb = 0; vb < 5; ++vb) apv[vb] = MFMA16(pf[kk], __builtin_bit_cast(bf16x8, wv_[vb]), apv[vb]); }
        const f32x4 wi4 = *(const LAS f32x4*)(ga + 256 + 16 * wave + 4 * g), ef4 = *(const LAS f32x4*)(ga + 384 + 16 * wave + 4 * g);
#pragma unroll
        for (int r = 0; r < 4; ++r) { const int tr = 16 * wave + 4 * g + r; const float wi = wi4[r];
            float den = apv[4][r] + wi * aqc[4][r]; den = __shfl(den, lane & 48); den = fmaxf(fabsf(den), ef4[r]);
            const float inv = 1.0f / den; float ss = 0.f; const bool ok = tr < nvalid;
#pragma unroll
            for (int vb = 0; vb < 4; ++vb) { const float hv = (apv[vb][r] + wi * aqc[vb][r]) * inv; ss += hv * hv;
                if (ok) HM[(rowbase + tr) * DM + h * ADV + 64 * j + 16 * vb + i16] = hv; }
            ss += __shfl_xor(ss, 1); ss += __shfl_xor(ss, 2); ss += __shfl_xor(ss, 4); ss += __shfl_xor(ss, 8);
            if (ok && i16 == 0) HSSQ[(rowbase + tr) * 32 + h * 8 + j] = ss; }
    }
    const size_t bh = (size_t)b * AH + h;
#pragma unroll
    for (int dh = 0; dh < 2; ++dh) { const int d = 128 * dh + 16 * wave + i16;
#pragma unroll
        for (int vb = 0; vb < 4; ++vb) *(f32x4*)(out + O_CP + (bh * ADK + d) * ADV + 64 * j + 16 * vb + 4 * g) = accC[dh][vb];
        if (j == 0 && g == 0) out[O_NP + bh * ADK + d] = accC[dh][4][0]; }
    if (j == 0 && tid == 0) out[O_MP + bh] = m_prev;
}

__device__ __forceinline__ void mlstm_sample_unit(LAS unsigned char* lds, const bf16* QKVO, const float* GATES, const float* stC, const float* stN, const float* stM,
                                                  float* HM, float* HSSQ, float* out, int b, int h, int tid, int wave, int lane) {
    LAS float* qT = (LAS float*)lds;
    LAS float* wkT = (LAS float*)(lds + 4096);
    LAS float* qN = (LAS float*)(lds + 8192);
    LAS float* kN = (LAS float*)(lds + 12288);
    LAS float* dots = (LAS float*)(lds + 16384);
    LAS float* red = (LAS float*)(lds + 16640);
    const int row0 = MPR + DECS * b; const size_t bh = (size_t)b * AH + h;
    float ig[4], bb[4], a_[4], pm[4], wint[4], efl[4], wst[4];
    const unsigned qq = *(const unsigned*)(QKVO + (size_t)(row0 + (tid >> 7)) * NAIN + h * ADK + (tid & 127) * 2), kk = *(const unsigned*)(QKVO + (size_t)(row0 + (tid >> 7)) * NAIN + h * ADK + (tid & 127) * 2 + 1024);
    v2u vw[4];
#pragma unroll
    for (int s = 0; s < 4; ++s) vw[s] = *(const v2u*)(QKVO + (size_t)(row0 + s) * NAIN + 2048 + h * ADV + 4 * (tid & 127));
    const float mprev = stM[bh];
    { float run = 0.f, pmax = -INFINITY;
#pragma unroll
      for (int s = 0; s < 4; ++s) { ig[s] = GATES[(size_t)(row0 + s) * 8 + h]; run += GATES[(size_t)(row0 + s) * 8 + 4 + h]; bb[s] = run; a_[s] = ig[s] - bb[s]; pmax = fmaxf(pmax, a_[s]);
          pm[s] = fmaxf(mprev, pmax); wint[s] = __expf(mprev - pm[s]); efl[s] = __expf(-(bb[s] + pm[s])); } }
    const float Mx = pm[3], decay = __expf(mprev - Mx), mnew = bb[3] + Mx;
#pragma unroll
    for (int s = 0; s < 4; ++s) wst[s] = __expf(a_[s] - Mx);
    __syncthreads();
    { const int s = tid >> 7, d2 = (tid & 127) * 2;
      const float q0 = bflo(qq), q1 = bfhi(qq), k0 = bflo(kk), k1 = bfhi(kk);
      const float w = s == 0 ? wst[0] : s == 1 ? wst[1] : s == 2 ? wst[2] : wst[3];
      qT[d2 * 4 + s] = q0; qT[(d2 + 1) * 4 + s] = q1; wkT[d2 * 4 + s] = w * k0; wkT[(d2 + 1) * 4 + s] = w * k1;
      qN[s * 256 + d2] = q0; qN[s * 256 + d2 + 1] = q1; kN[s * 256 + d2] = k0; kN[s * 256 + d2 + 1] = k1; }
    __syncthreads();
    for (int x = wave; x < 20; x += 8) { float p = 0.f;
        if (x < 16) { const int t = x >> 2, s = x & 3;
#pragma unroll
            for (int i = 0; i < 4; ++i) p += qN[t * 256 + lane + 64 * i] * kN[s * 256 + lane + 64 * i]; }
        else { const int t = x - 16;
#pragma unroll
            for (int i = 0; i < 4; ++i) p += qN[t * 256 + lane + 64 * i] * stN[bh * ADK + lane + 64 * i]; }
        p = wave_sum(p); if (lane == 0) dots[x] = p; }
    __syncthreads();
    float P[4][4], deninv[4];
#pragma unroll
    for (int t = 0; t < 4; ++t) { float den = 0.f;
#pragma unroll
        for (int s = 0; s < 4; ++s) { P[t][s] = s <= t ? dots[4 * t + s] * __expf(a_[s] - pm[t]) : 0.f; den += P[t][s]; }
        den += wint[t] * dots[16 + t]; deninv[t] = 1.0f / fmaxf(fabsf(den), efl[t]); }
    const int eq = tid & 127, dq = tid >> 7;
    f32x4 vv[4];
#pragma unroll
    for (int s = 0; s < 4; ++s) { const v2u w = vw[s]; vv[s] = (f32x4){bflo(w.x), bfhi(w.x), bflo(w.y), bfhi(w.y)}; }
    f32x4 qc[4];
#pragma unroll
    for (int t = 0; t < 4; ++t) qc[t] = (f32x4){0.f, 0.f, 0.f, 0.f};
    const float* Cin = stC + bh * ADK * ADV + 4 * eq; float* Cout = out + O_CS + bh * ADK * ADV + 4 * eq;
#pragma unroll 8
    for (int dd = 0; dd < 64; ++dd) { const int d = 64 * dq + dd;
        const f32x4 c = *(const f32x4*)(Cin + (size_t)d * ADV); const f32x4 q4 = *(const LAS f32x4*)(qT + 4 * d), k4 = *(const LAS f32x4*)(wkT + 4 * d);
#pragma unroll
        for (int t = 0; t < 4; ++t) qc[t] += c * q4[t];
        *(f32x4*)(Cout + (size_t)d * ADV) = c * decay + vv[0] * k4[0] + vv[1] * k4[1] + vv[2] * k4[2] + vv[3] * k4[3]; }
#pragma unroll
    for (int t = 0; t < 4; ++t) *(LAS f32x4*)(red + (dq * 4 + t) * 512 + 4 * eq) = qc[t];
    __syncthreads();
    { const int e = tid; float ve[4];
#pragma unroll
      for (int s = 0; s < 4; ++s) ve[s] = __uint_as_float((unsigned)QKVO[(size_t)(row0 + s) * NAIN + 2048 + h * ADV + e] << 16);
#pragma unroll
      for (int t = 0; t < 4; ++t) { const float qcs = (red[(0 * 4 + t) * 512 + e] + red[(1 * 4 + t) * 512 + e]) + (red[(2 * 4 + t) * 512 + e] + red[(3 * 4 + t) * 512 + e]);
          float pvv = 0.f;
#pragma unroll
          for (int s = 0; s < 4; ++s) pvv += P[t][s] * ve[s];
          const float hv = (pvv + wint[t] * qcs) * deninv[t];
          HM[(size_t)(row0 + t) * DM + h * ADV + e] = hv;
          const float ss = wave_sum(hv * hv); if (lane == 0) HSSQ[(size_t)(row0 + t) * 32 + h * 8 + wave] = ss; } }
    if (tid < ADK) { const f32x4 k4 = *(const LAS f32x4*)(wkT + 4 * tid); out[O_NS + bh * ADK + tid] = decay * stN[bh * ADK + tid] + ((k4[0] + k4[1]) + (k4[2] + k4[3])); }
    if (tid == 0) out[O_MS + bh] = mnew;
}

__device__ __forceinline__ void mlstm_gate_rows(const float* HM, const float* HSSQ, const bf16* QKVO, const float* gain, bf16* AM, int gw, int NGW, int lane) {
    f32x4 g0[4], g1[4];
#pragma unroll
    for (int i = 0; i < 4; ++i) { g0[i] = *(const f32x4*)(gain + 512 * i + 8 * lane); g1[i] = *(const f32x4*)(gain + 512 * i + 8 * lane + 4); }
    for (int row0 = 2 * gw; row0 < MREAL; row0 += 2 * NGW) {
        f32x4 s0[2][4], s1[2][4], h0[2][4], h1[2][4]; v4u ow[2][4];
#pragma unroll
        for (int q = 0; q < 2; ++q) { const int row = row0 + q < MREAL ? row0 + q : row0;
#pragma unroll
            for (int i = 0; i < 4; ++i) { const int c = 512 * i + 8 * lane;
                s0[q][i] = *(const f32x4*)(HSSQ + (size_t)row * 32 + 8 * i); s1[q][i] = *(const f32x4*)(HSSQ + (size_t)row * 32 + 8 * i + 4);
                h0[q][i] = *(const f32x4*)(HM + (size_t)row * DM + c); h1[q][i] = *(const f32x4*)(HM + (size_t)row * DM + c + 4);
                ow[q][i] = *(const v4u*)(QKVO + (size_t)row * NAIN + 4096 + c); } }
#pragma unroll
        for (int q = 0; q < 2; ++q) { const int row = row0 + q; if (row < MREAL) {
#pragma unroll
            for (int i = 0; i < 4; ++i) {
                const float rs = rsqrtf((((s0[q][i][0] + s0[q][i][1]) + (s0[q][i][2] + s0[q][i][3])) + ((s1[q][i][0] + s1[q][i][1]) + (s1[q][i][2] + s1[q][i][3]))) * (1.0f / ADV) + EPS);
                float o[8];
#pragma unroll
                for (int e = 0; e < 8; ++e) { const float ov = __uint_as_float(bfel(ow[q][i], e) << 16); const float sg = __builtin_amdgcn_rcpf(1.0f + __expf(-ov));
                    const float hv = e < 4 ? h0[q][i][e & 3] * g0[i][e & 3] : h1[q][i][e & 3] * g1[i][e & 3]; o[e] = hv * rs * sg; }
                v4u w; w.x = pk2(o[0], o[1]); w.y = pk2(o[2], o[3]); w.z = pk2(o[4], o[5]); w.w = pk2(o[6], o[7]);
                *(v4u*)(AM + (size_t)row * DM + 512 * i + 8 * lane) = w; } } }
    }
}

template <int NKEY> struct AttnLds { static constexpr int KNS = 144, KN = 0, VT = NKEY * 144, VTS = NKEY * 2 + 16, END = VT + 64 * VTS; };

struct AttnMask { int rel0, lim, mrel;
    __device__ __forceinline__ bool operator()(int jj, int blk, int r, float& dist) const {
        if (jj == 0) { dist = (float)WIN; return mrel - r >= WIN; }
        const int rel = rel0 - 16 * blk - r; dist = (float)rel; return (unsigned)rel <= (unsigned)lim; } };
struct MaskGen { AttnMask m; float slope;
    __device__ __forceinline__ float apply(int jj, int blk, int r, float s) const { float dist; const bool ok = m(jj, blk, r, dist); return ok ? s - slope * dist : -INFINITY; }
    __device__ __forceinline__ float shift() const { return 0.f; } };
struct MaskFast { float u[4], s16, m0, sh; int relT;
    __device__ __forceinline__ void init(float slope, int lane) { const int i16 = lane & 15, g = lane >> 4;
#pragma unroll
        for (int r = 0; r < 4; ++r) u[r] = slope * (float)(4 * g + r);
        s16 = 16.0f * slope; m0 = slope * (float)(16 + i16); sh = slope * (float)(144 + i16); relT = 144 + i16 - 4 * g; }
    __device__ __forceinline__ float apply(int jj, int, int r, float s) const {
        if (jj == 0) return s + m0;
        const float v = (s + u[r]) + s16 * (float)jj;
        if (jj == 1) return relT - 16 - r <= WIN - 1 ? v : -INFINITY;
        if (jj == 9) return relT - 144 - r >= 0 ? v : -INFINITY;
        return v; }
    __device__ __forceinline__ float shift() const { return sh; } };
template <int NKEY, int NJB, class MaskF, class BlkF>
__device__ __forceinline__ void attn_tblock(LAS unsigned char* lds, const bf16x8 qf0, const bf16x8 qf1, float sink_in, const MaskF& mask, const BlkF& blk,
                                            bf16* orow  , int nq_valid, int lane) {
    typedef AttnLds<NKEY> L;
    const int i16 = lane & 15, g = lane >> 4;
    f32x4 sacc[NJB];
#pragma unroll
    for (int jb = 0; jb < NJB; ++jb) { sacc[jb] = (f32x4){0.f, 0.f, 0.f, 0.f};
        const LAS unsigned char* kp = lds + L::KN + (16 * blk(jb) + i16) * L::KNS + 16 * g;
        sacc[jb] = MFMA16(*(const LAS bf16x8*)kp, qf0, sacc[jb]); sacc[jb] = MFMA16(*(const LAS bf16x8*)(kp + 64), qf1, sacc[jb]); }
    const float sink = sink_in + mask.shift();
    float mx = sink;
#pragma unroll
    for (int jb = 0; jb < NJB; ++jb)
#pragma unroll
        for (int r = 0; r < 4; ++r) { const float sv = mask.apply(jb, blk(jb), r, sacc[jb][r]); sacc[jb][r] = sv; mx = fmaxf(mx, sv); }
    mx = fmaxf(mx, __shfl_xor(mx, 16)); mx = fmaxf(mx, __shfl_xor(mx, 32));
    float sum = 0.f;
#pragma unroll
    for (int jb = 0; jb < NJB; ++jb)
#pragma unroll
        for (int r = 0; r < 4; ++r) { const float p = __expf(sacc[jb][r] - mx); sacc[jb][r] = p; sum += p; }
    sum += __shfl_xor(sum, 16); sum += __shfl_xor(sum, 32);
    sum += __expf(sink - mx);
    const float inv = 1.0f / sum;
    f32x4 oacc[4];
#pragma unroll
    for (int db = 0; db < 4; ++db) oacc[db] = (f32x4){0.f, 0.f, 0.f, 0.f};
#pragma unroll
    for (int kk = 0; kk < NJB / 2; ++kk) {
        v4u w; w.x = pk2m(sacc[2 * kk][0], sacc[2 * kk][1]); w.y = pk2m(sacc[2 * kk][2], sacc[2 * kk][3]); w.z = pk2m(sacc[2 * kk + 1][0], sacc[2 * kk + 1][1]); w.w = pk2m(sacc[2 * kk + 1][2], sacc[2 * kk + 1][3]);
        const bf16x8 pf = __builtin_bit_cast(bf16x8, w);
#pragma unroll
        for (int db = 0; db < 4; ++db) { const LAS unsigned char* vp = lds + L::VT + (16 * db + i16) * L::VTS + 8 * g;
            const v2u lo = *(const LAS v2u*)(vp + 32 * blk(2 * kk)), hi = *(const LAS v2u*)(vp + 32 * blk(2 * kk + 1)); const v4u bw = (v4u){lo.x, lo.y, hi.x, hi.y};
            oacc[db] = MFMA16(__builtin_bit_cast(bf16x8, bw), pf, oacc[db]); } }
    if (i16 < nq_valid) {
#pragma unroll
        for (int db = 0; db < 4; ++db) { const f32x4 o = oacc[db] * inv; v2u w; w.x = pk2(o[0], o[1]); w.y = pk2(o[2], o[3]); *(v2u*)(orow + (size_t)i16 * DM + 16 * db + 4 * g) = w; } }
}

__device__ __forceinline__ void attn_prompt_unit(LAS unsigned char* lds, const bf16* QB, const bf16* KB, const bf16* VB, const float* sinks, bf16* AM, int b, int g, int n, int tid, int wave, int lane) {
    typedef AttnLds<288> L;
    const int hh = 8 * g + wave; const float slope = exp2f(-0.25f * (float)(hh + 1)), sink = sinks[hh];
    const bf16* qbase = QB + ((size_t)b * TP + 128 * n + (lane & 15)) * DM + hh * 64 + 8 * (lane >> 4);
    bf16x8 q0 = *(const bf16x8*)qbase, q1 = *(const bf16x8*)(qbase + 32);
    __syncthreads();
    { v4u kr[5], vr0[3], vr1[3];
#pragma unroll
      for (int i = 0; i < 5; ++i) { const int it = tid + 512 * i, kk = it >> 3, ch = it & 7; const int pos = kk < NMETA ? kk : 128 * (n - 1) + kk - NMETA; kr[i] = (v4u){0u, 0u, 0u, 0u};
          if (it < 288 * 8 && kk < NMETA + 256 && pos >= 0 && pos < TP) kr[i] = *(const v4u*)(KB + ((size_t)b * TP + pos) * 256 + g * 64 + 8 * ch); }
#pragma unroll
      for (int i = 0; i < 3; ++i) { const int it = tid + 512 * i, ch = it / 144, p = it - ch * 144; vr0[i] = (v4u){0u, 0u, 0u, 0u}; vr1[i] = vr0[i];
          if (it < 144 * 8) {
              { const int kk = 2 * p, pos = kk < NMETA ? kk : 128 * (n - 1) + kk - NMETA; if (kk < NMETA + 256 && pos >= 0 && pos < TP) vr0[i] = *(const v4u*)(VB + ((size_t)b * TP + pos) * 256 + g * 64 + 8 * ch); }
              { const int kk = 2 * p + 1, pos = kk < NMETA ? kk : 128 * (n - 1) + kk - NMETA; if (kk < NMETA + 256 && pos >= 0 && pos < TP) vr1[i] = *(const v4u*)(VB + ((size_t)b * TP + pos) * 256 + g * 64 + 8 * ch); } } }
#pragma unroll
      for (int i = 0; i < 5; ++i) { const int it = tid + 512 * i, kk = it >> 3, ch = it & 7; if (it < 288 * 8) *(LAS v4u*)(lds + L::KN + kk * L::KNS + 16 * ch) = kr[i]; }
#pragma unroll
      for (int i = 0; i < 3; ++i) { const int it = tid + 512 * i, ch = it / 144, p = it - ch * 144;
          if (it < 144 * 8) {
#pragma unroll
              for (int e = 0; e < 8; ++e) *(LAS unsigned*)(lds + L::VT + (8 * ch + e) * L::VTS + 4 * p) = bfel(vr0[i], e) | (bfel(vr1[i], e) << 16); } } }
    __syncthreads();
    MaskFast mf; mf.init(slope, lane);
    for (int tb = 0; tb < 8; ++tb) { const int tpos0 = 128 * n + 16 * tb; if (tpos0 >= TP) break;
        const size_t row0 = (size_t)b * TP + tpos0;
        const int tbn = (tb < 7 && tpos0 + 16 < TP) ? tb + 1 : tb;
        const bf16x8 n0 = *(const bf16x8*)(qbase + (size_t)tbn * 16 * DM), n1 = *(const bf16x8*)(qbase + (size_t)tbn * 16 * DM + 32);
        __builtin_amdgcn_sched_barrier(0);
        const auto blk = [tb](int jj) { return jj == 0 ? 0 : tb + jj; };
        if (n >= 2) attn_tblock<288, 10>(lds, q0, q1, sink, mf, blk, AM + row0 * DM + hh * 64, 16, lane);
        else { const int tpos = tpos0 + (lane & 15);
            const MaskGen mk{AttnMask{tpos - 128 * (n - 1) + NMETA - 4 * (lane >> 4), tpos < WIN - 1 ? tpos : WIN - 1, tpos - 4 * (lane >> 4)}, slope};
            attn_tblock<288, 10>(lds, q0, q1, sink, mk, blk, AM + row0 * DM + hh * 64, 16, lane); }
        q0 = n0; q1 = n1; }
}
__device__ __forceinline__ void attn_sample_unit(LAS unsigned char* lds, const bf16* QB, const bf16* KB, const bf16* VB, const float* ckm, const float* cvm, const float* ckw, const float* cvw,
                                                 const float* sinks, bf16* AM, int b, int g, int tid, int wave, int lane) {
    typedef AttnLds<160> L;
    const int hh = 8 * g + wave; const float slope = exp2f(-0.25f * (float)(hh + 1)), sink = sinks[hh];
    const size_t row0 = (size_t)MPR + DECS * b;
    const bf16* qbase = QB + (row0 + (lane & 15)) * DM + hh * 64 + 8 * (lane >> 4);
    const bf16x8 q0 = *(const bf16x8*)qbase, q1 = *(const bf16x8*)(qbase + 32);
    __syncthreads();
    { f32x4 kf0[3], kf1[3]; v4u kn[3];
#pragma unroll
      for (int i = 0; i < 3; ++i) { const int it = tid + 512 * i, kk = it >> 3, ch = it & 7; kf0[i] = (f32x4){0.f, 0.f, 0.f, 0.f}; kf1[i] = kf0[i]; kn[i] = (v4u){0u, 0u, 0u, 0u};
          if (it < 160 * 8) {
              if (kk < NMETA + WIN) { const float* src = kk < NMETA ? ckm + (((size_t)b * NMETA + kk) * BKV + g) * 64 + 8 * ch : ckw + (((size_t)b * WIN + (kk - NMETA)) * BKV + g) * 64 + 8 * ch;
                  kf0[i] = *(const f32x4*)src; kf1[i] = *(const f32x4*)(src + 4); }
              else if (kk < NMETA + WIN + DECS) kn[i] = *(const v4u*)(KB + ((size_t)MPR + DECS * b + (kk - NMETA - WIN)) * 256 + g * 64 + 8 * ch); } }
      f32x4 vf0[2][2], vf1[2][2]; v4u vn[2][2];
#pragma unroll
      for (int i = 0; i < 2; ++i) { const int it = tid + 512 * i, ch = it / 80, p = it - ch * 80;
#pragma unroll
          for (int q = 0; q < 2; ++q) { const int kk = 2 * p + q; vf0[i][q] = (f32x4){0.f, 0.f, 0.f, 0.f}; vf1[i][q] = vf0[i][q]; vn[i][q] = (v4u){0u, 0u, 0u, 0u};
              if (it < 80 * 8) {
                  if (kk < NMETA + WIN) { const float* src = kk < NMETA ? cvm + (((size_t)b * NMETA + kk) * BKV + g) * 64 + 8 * ch : cvw + (((size_t)b * WIN + (kk - NMETA)) * BKV + g) * 64 + 8 * ch;
                      vf0[i][q] = *(const f32x4*)src; vf1[i][q] = *(const f32x4*)(src + 4); }
                  else if (kk < NMETA + WIN + DECS) vn[i][q] = *(const v4u*)(VB + ((size_t)MPR + DECS * b + (kk - NMETA - WIN)) * 256 + g * 64 + 8 * ch); } } }
#pragma unroll
      for (int i = 0; i < 3; ++i) { const int it = tid + 512 * i, kk = it >> 3, ch = it & 7;
          if (it < 160 * 8) { v4u r = kn[i];
              if (kk < NMETA + WIN) { r.x = pk2(kf0[i][0], kf0[i][1]); r.y = pk2(kf0[i][2], kf0[i][3]); r.z = pk2(kf1[i][0], kf1[i][1]); r.w = pk2(kf1[i][2], kf1[i][3]); }
              *(LAS v4u*)(lds + L::KN + kk * L::KNS + 16 * ch) = r; } }
#pragma unroll
      for (int i = 0; i < 2; ++i) { const int it = tid + 512 * i, ch = it / 80, p = it - ch * 80;
          if (it < 80 * 8) { v4u rr[2];
#pragma unroll
              for (int q = 0; q < 2; ++q) { const int kk = 2 * p + q; v4u r = vn[i][q];
                  if (kk < NMETA + WIN) { r.x = pk2(vf0[i][q][0], vf0[i][q][1]); r.y = pk2(vf0[i][q][2], vf0[i][q][3]); r.z = pk2(vf1[i][q][0], vf1[i][q][1]); r.w = pk2(vf1[i][q][2], vf1[i][q][3]); }
                  rr[q] = r; }
#pragma unroll
              for (int e = 0; e < 8; ++e) *(LAS unsigned*)(lds + L::VT + (8 * ch + e) * L::VTS + 4 * p) = bfel(rr[0], e) | (bfel(rr[1], e) << 16); } } }
    __syncthreads();
    const MaskGen mk{AttnMask{WIN + (lane & 15) + NMETA - 4 * (lane >> 4), WIN - 1, 1 << 20}, slope};
    const auto blk = [](int jj) { return jj; };
    attn_tblock<160, 10>(lds, q0, q1, sink, mk, blk, AM + row0 * DM + hh * 64, DECS, lane);
}
__device__ __forceinline__ void kv_outputs(const Args& a, const bf16* KB, const bf16* VB, size_t gtid, size_t gthreads) {
    float* out = a.out;
    for (size_t i = gtid; i < (size_t)NBATCH * (NMETA + WIN) * 256; i += gthreads) { const int c = (int)(i & 255); const int rr = (int)(i >> 8); const int b = rr / (NMETA + WIN), q = rr - b * (NMETA + WIN);
        const int t = q < NMETA ? q : TP - WIN + (q - NMETA); const size_t src = ((size_t)b * TP + t) * 256 + c;
        const float kv = __uint_as_float((unsigned)KB[src] << 16), vv = __uint_as_float((unsigned)VB[src] << 16);
        if (q < NMETA) { out[O_KMP + ((size_t)b * NMETA + q) * 256 + c] = kv; out[O_VMP + ((size_t)b * NMETA + q) * 256 + c] = vv; }
        else { out[O_KWP + ((size_t)b * WIN + (q - NMETA)) * 256 + c] = kv; out[O_VWP + ((size_t)b * WIN + (q - NMETA)) * 256 + c] = vv; } }
    for (size_t i = gtid; i < (size_t)DECB * WIN * 64; i += gthreads) { const int c4 = (int)(i & 63) * 4; const int rr = (int)(i >> 6); const int b = rr >> 7, jj = rr & 127;
        f32x4 kv, vv;
        if (jj < WIN - DECS) { kv = *(const f32x4*)(a.in[I_CKW] + ((size_t)b * WIN + jj + DECS) * 256 + c4); vv = *(const f32x4*)(a.in[I_CVW] + ((size_t)b * WIN + jj + DECS) * 256 + c4); }
        else { const size_t src = ((size_t)MPR + DECS * b + (jj - (WIN - DECS))) * 256 + c4; const v2u kw = *(const v2u*)(KB + src), vw = *(const v2u*)(VB + src);
            kv = (f32x4){bflo(kw.x), bfhi(kw.x), bflo(kw.y), bfhi(kw.y)}; vv = (f32x4){bflo(vw.x), bfhi(vw.x), bflo(vw.y), bfhi(vw.y)}; }
        *(f32x4*)(out + O_KWS + ((size_t)b * WIN + jj) * 256 + c4) = kv; *(f32x4*)(out + O_VWS + ((size_t)b * WIN + jj) * 256 + c4) = vv; }
}

struct TailSplitOrder {
    pg8::StaticOrder mo; int G, c, kp;
    __device__ void init(int N, int K, int G_, int c_) { mo.init(TS_PM0 * 256, N, G_, c_); mo.nt0 = K / 64; kp = K / TS_PARTS; G = G_; c = c_; }
    __device__ bool next(int i, pg8::Unit& u) const {
        if (mo.next(i, u)) return true;
        const long L = (long)i * G + c - (long)mo.nwg; if (L < 0 || L >= TS_TILES * TS_PARTS) return false;
        const int t = (int)L / TS_PARTS, part = (int)L % TS_PARTS; u.pm = TS_PM0 + t / 8; u.pn = t % 8; u.koff = part * kp * 2; u.nt = kp / 64; return true; }
    __device__ __forceinline__ void a_ready(const pg8::Unit&) const {}
    __device__ __forceinline__ void done(const pg8::Unit&) const {}
};
template <bool FINAL> __device__ __forceinline__ void resid_combine(LAS unsigned char* lds, const bf16* HI, bf16* AB, const float* ssq, float* rs, const float* slab, float sc, float* out, int G, int wave, int gw, int NGW, int lane) {
    LAS float* red = (LAS float*)lds;
    constexpr int NT = MP - TS_PM0 * 256;
    for (int j0 = 0; (int)blockIdx.x + G * j0 < NT; j0 += 3) {
        f32x4 pp[3][4]; v2u hb[3];
#pragma unroll
        for (int j = 0; j < 3; ++j) { const int it = (int)blockIdx.x + G * (j0 + j); const int itc = it < NT ? it : (int)blockIdx.x;
            const int r = itc & 255, row = TS_PM0 * 256 + itc, t = (itc >> 8) * 8 + wave;
            const float* sp = slab + (size_t)(t * TS_PARTS) * 65536 + (size_t)r * 256 + 4 * lane;
#pragma unroll
            for (int p = 0; p < 4; ++p) pp[j][p] = *(const f32x4*)(sp + (size_t)p * 65536);
            hb[j] = *(const v2u*)(HI + (size_t)row * DM + wave * 256 + 4 * lane); }
        if (!FINAL && j0 > 0) __syncthreads();
#pragma unroll
        for (int j = 0; j < 3; ++j) { const int it = (int)blockIdx.x + G * (j0 + j);
            if (it < NT) { const int row = TS_PM0 * 256 + it, col = wave * 256 + 4 * lane;
                const f32x4 hn = (f32x4){bflo(hb[j].x), bfhi(hb[j].x), bflo(hb[j].y), bfhi(hb[j].y)} + ((pp[j][0] + pp[j][1]) + (pp[j][2] + pp[j][3])) * sc;
                if (FINAL) { float* op = nullptr;
                    if (row < MPR) { const int b = row / TP, tt = row - b * TP; if (tt >= NMETA) op = out + O_YP + ((size_t)b * SEQ + (tt - NMETA)) * DM; }
                    else if (row < MREAL) op = out + O_YS + (size_t)(row - MPR) * DM;
                    if (op) *(f32x4*)(op + col) = hn; }
                else { v2u w; w.x = pk2(hn[0], hn[1]); w.y = pk2(hn[2], hn[3]); *(v2u*)(AB + (size_t)row * DM + col) = w;
                    const float ss = wave_sum((hn[0] * hn[0] + hn[1] * hn[1]) + (hn[2] * hn[2] + hn[3] * hn[3]));
                    if (lane == 0) red[j * 8 + wave] = ss; } } }
        if (!FINAL) {
            __syncthreads();
            if (wave == 0 && lane < 3) { const int it = (int)blockIdx.x + G * (j0 + lane);
                if (it < NT) { float s = 0.f;
#pragma unroll
                    for (int w = 0; w < 8; ++w) s += red[lane * 8 + w];
                    rs[TS_PM0 * 256 + it] = rsqrtf(s * (1.0f / DM) + EPS); } } } }
    if (!FINAL) {
        for (int it0 = gw; it0 < TS_PM0 * 128; it0 += 4 * NGW) { float sv[4];
#pragma unroll
            for (int k = 0; k < 4; ++k) { const int it = it0 + k * NGW; sv[k] = it < TS_PM0 * 128 ? ssq[(size_t)(2 * it + (lane >> 5)) * 32 + (lane & 31)] : 0.f; }
#pragma unroll
            for (int k = 0; k < 4; ++k) { const int it = it0 + k * NGW; float s = sv[k];
                s += __shfl_xor(s, 1); s += __shfl_xor(s, 2); s += __shfl_xor(s, 4); s += __shfl_xor(s, 8); s += __shfl_xor(s, 16);
                if (it < TS_PM0 * 128 && (lane & 31) == 0) rs[2 * it + (lane >> 5)] = rsqrtf(s * (1.0f / DM) + EPS); } } }
}
__device__ __forceinline__ void head_combine(bf16* O, const float* rsv, const float* gain, float post, const float* slab, int gw, int NGW, int lane) {
    const int hd = (lane >> 3) & 3, dim = 32 * (lane >> 5) + 4 * (lane & 7);
    const f32x4 gv = *(const f32x4*)(gain + dim);
    for (int it0 = gw; it0 < TS_TILES * 256; it0 += 3 * NGW) {
        f32x4 pp[3][4]; float rsl[3];
#pragma unroll
        for (int k = 0; k < 3; ++k) { const int it = it0 + k * NGW < TS_TILES * 256 ? it0 + k * NGW : it0; const int t = it >> 8, r = it & 255, row = (TS_PM0 + (t >> 3)) * 256 + r;
            const float* sp = slab + (size_t)(t * TS_PARTS) * 65536 + (size_t)r * 256 + 4 * lane;
#pragma unroll
            for (int p = 0; p < 4; ++p) pp[k][p] = *(const f32x4*)(sp + (size_t)p * 65536);
            rsl[k] = rsv[row]; }
#pragma unroll
        for (int k = 0; k < 3; ++k) { const int it = it0 + k * NGW; if (it < TS_TILES * 256) { const int t = it >> 8, r = it & 255, pn = t & 7, row = (TS_PM0 + (t >> 3)) * 256 + r;
            const f32x4 x = ((pp[k][0] + pp[k][1]) + (pp[k][2] + pp[k][3])) * rsl[k];
            float ms = (x[0] * x[0] + x[1] * x[1]) + (x[2] * x[2] + x[3] * x[3]);
            ms += __shfl_xor(ms, 1); ms += __shfl_xor(ms, 2); ms += __shfl_xor(ms, 4); ms += __shfl_xor(ms, 32);
            const float inv = rsqrtf(ms * (1.0f / 64.0f) + EPS) * post;
            const f32x4 o = x * inv * gv;
            v2u w; w.x = pk2(o[0], o[1]); w.y = pk2(o[2], o[3]); *(v2u*)(O + (size_t)row * DM + pn * 256 + hd * 64 + dim) = w; } }
    }
}
#define GEMM_PHASE_TS(EPI_T, E, Aptr, Bptr, K_) do { pg8::Gemm gg{(const pg8::bf16_t*)(Aptr), (const pg8::bf16_t*)(Bptr), MP, DM, (K_)}; int bx_ = (int)blockIdx.x; asm volatile("" : "+s"(bx_)); TailSplitOrder SS; SS.init(DM, (K_), G, bx_); \
    pg8::gemm_phase<EPI_T, TailSplitOrder, true, true>(lds, gg, SS, (E)); } while (0)
#define GEMM_PHASE_TSA(EPI_T, E, Aptr, Bptr, K_) do { pg8::Gemm gg{(const pg8::bf16_t*)(Aptr), (const pg8::bf16_t*)(Bptr), MP, DM, (K_)}; int bx_ = (int)blockIdx.x; asm volatile("" : "+s"(bx_)); TailSplitOrder SS; SS.init(DM, (K_), G, bx_); \
    pg8::gemm_phase<EPI_T, TailSplitOrder, true, true, true>(lds, gg, SS, (E)); } while (0)
typedef EpiResid<false, false> EpiResPlain; typedef EpiResid<true, false> EpiResFinal;
#define GEMM_PHASE(EPI_T, E, Aptr, Bptr, N_, K_) do { pg8::Gemm gg{(const pg8::bf16_t*)(Aptr), (const pg8::bf16_t*)(Bptr), MP, (N_), (K_)}; int bx_ = (int)blockIdx.x; asm volatile("" : "+s"(bx_)); pg8::StaticOrder SS; SS.init(MP, (N_), G, bx_); SS.nt0 = (K_) / 64; \
    pg8::gemm_phase<EPI_T, pg8::StaticOrder, true, true>(lds, gg, SS, (E)); } while (0)

__global__ void __launch_bounds__(NWAVES * 64, 2) yoco_fwd(Args args) {
    extern __shared__ __attribute__((aligned(16))) unsigned char lds_raw[];
    LAS unsigned char* lds = (LAS unsigned char*)lds_raw;
    volatile LAS unsigned* MISC = (volatile LAS unsigned*)(lds + MISC_OFF);
    const int tid = threadIdx.x, lane = tid & 63, wave = __builtin_amdgcn_readfirstlane(tid >> 6);
    const int G = gridDim.x, gw = blockIdx.x * NWAVES + wave, NGW = G * NWAVES;
    unsigned char* ws = args.ws;
    for (int u = tid; u < (LDS_BYTES - MISC_OFF) / 4; u += NWAVES * 64) ((LAS unsigned*)(lds + MISC_OFF))[u] = 0u;
    __syncthreads();
    XcdBarrier bar = xcd_barrier_post((unsigned*)(ws + WS_CTL) + CW_BAR, MISC + 8);

    bf16* AB = (bf16*)(ws + WS_AB); bf16* ACT = (bf16*)(ws + WS_ACT); bf16* QKVO = (bf16*)(ws + WS_ACT);
    float* HM = (float*)(ws + WS_HM); bf16* AM = (bf16*)(ws + WS_AM); bf16* QB = (bf16*)(ws + WS_QB); bf16* KB = (bf16*)(ws + WS_KB); bf16* VB = (bf16*)(ws + WS_VB);
    bf16* AB2 = (bf16*)(ws + WS_AB2); float* SSQ2 = (float*)(ws + WS_SSQ2); float* RS = (float*)(ws + WS_RS); float* RS2 = (float*)(ws + WS_RS2);
    float* SSQ = (float*)(ws + WS_SSQ); float* HSSQ = (float*)(ws + WS_HSSQ); float* GATES = (float*)(ws + WS_GATES);

    p0_prologue(args, lds, gw, NGW, wave, lane);
    xcd_barrier(bar);

    { EpiSwiglu<false> E{ACT, RS}; GEMM_PHASE(EpiSwiglu<false>, E, AB, ws + WS_W1 + 0 * SZ_W1, 2 * DFF, DM); }
    xcd_barrier(bar);
    { EpiResPlain E{AB, AB, SSQ, nullptr, (float*)(ws + WS_SLAB), 0.5f, DFF / 64}; GEMM_PHASE_TSA(EpiResPlain, E, ACT, ws + WS_W2 + 0 * SZ_W2, DFF); }
    xcd_barrier(bar);
    resid_combine<false>(lds, AB, AB, SSQ, RS, (const float*)(ws + WS_SLAB), 0.5f, nullptr, G, wave, gw, NGW, lane);
    xcd_barrier(bar);

    { EpiQkvo E{QKVO, RS, GATES, args.in[I_BAG]}; GEMM_PHASE(EpiQkvo, E, AB, ws + WS_WAIN, NAIN_PAD, DM); }
    xcd_barrier(bar);
    for (int u = blockIdx.x; u < NBATCH * AH * 8; u += G) {
        const int v = (((u & 7) * 4 + (u >> 6)) << 3) | ((u >> 3) & 7);
        mlstm_prompt_unit(lds, QKVO, GATES, HM, HSSQ, args.out, v >> 5, (v >> 3) & 3, v & 7, tid, wave, lane); }
    for (int u = blockIdx.x; u < DECB * AH; u += G) mlstm_sample_unit(lds, QKVO, GATES, args.in[I_SC], args.in[I_SN], args.in[I_SM], HM, HSSQ, args.out, u >> 2, u & 3, tid, wave, lane);
    xcd_barrier(bar);
    mlstm_gate_rows(HM, HSSQ, QKVO, args.in[I_AHN], AM, gw, NGW, lane);
    xcd_barrier(bar);
    { EpiResPlain E{AB, AB, SSQ, nullptr, (float*)(ws + WS_SLAB), 1.0f, DM / 64}; GEMM_PHASE_TS(EpiResPlain, E, AM, ws + WS_WAOUT, DM); }
    xcd_barrier(bar);
    resid_combine<false>(lds, AB, AB, SSQ, RS, (const float*)(ws + WS_SLAB), 1.0f, nullptr, G, wave, gw, NGW, lane);
    xcd_barrier(bar);

    { EpiSwiglu<false> E{ACT, RS}; GEMM_PHASE(EpiSwiglu<false>, E, AB, ws + WS_W1 + 1 * SZ_W1, 2 * DFF, DM); }
    xcd_barrier(bar);
    { EpiResPlain E{AB, AB, SSQ, nullptr, (float*)(ws + WS_SLAB), 0.5f, DFF / 64}; GEMM_PHASE_TSA(EpiResPlain, E, ACT, ws + WS_W2 + 1 * SZ_W2, DFF); }
    xcd_barrier(bar);
    resid_combine<false>(lds, AB, AB, SSQ, RS, (const float*)(ws + WS_SLAB), 0.5f, nullptr, G, wave, gw, NGW, lane);
    xcd_barrier(bar);

    { EpiSwiglu<false> E{ACT, RS}; GEMM_PHASE(EpiSwiglu<false>, E, AB, ws + WS_W1 + 2 * SZ_W1, 2 * DFF, DM); }
    xcd_barrier(bar);
    { EpiResPlain E{AB, AB2, SSQ2, nullptr, (float*)(ws + WS_SLAB), 0.5f, DFF / 64}; GEMM_PHASE_TSA(EpiResPlain, E, ACT, ws + WS_W2 + 2 * SZ_W2, DFF); }
    { EpiHead E{KB, 256, VB, 256, 1, RS, args.in[I_KN], 1.0f, nullptr, DM / 64}; pg8::Gemm gg{(const pg8::bf16_t*)AB, (const pg8::bf16_t*)(ws + WS_WKV), MP, 512, DM}; int bx_ = ((int)blockIdx.x + G - TS_TILES * TS_PARTS % G) % G; asm volatile("" : "+s"(bx_));
      pg8::StaticOrder SS; SS.init(MP, 512, G, bx_); SS.nt0 = DM / 64; pg8::gemm_phase<EpiHead, pg8::StaticOrder, true, true>(lds, gg, SS, E); }
    xcd_barrier(bar);
    resid_combine<false>(lds, AB, AB2, SSQ2, RS2, (const float*)(ws + WS_SLAB), 0.5f, nullptr, G, wave, gw, NGW, lane);
    xcd_barrier(bar);

    { EpiHead E{QB, DM, QB, DM, 8, RS2, args.in[I_QN], 0.125f, (float*)(ws + WS_SLAB), DM / 64}; GEMM_PHASE_TS(EpiHead, E, AB2, ws + WS_WQ, DM); }
    if ((int)blockIdx.x >= TS_TILES * TS_PARTS) kv_outputs(args, KB, VB, (size_t)(blockIdx.x - TS_TILES * TS_PARTS) * (NWAVES * 64) + tid, (size_t)(G - TS_TILES * TS_PARTS) * NWAVES * 64);
    xcd_barrier(bar);
    head_combine(QB, RS2, args.in[I_QN], 0.125f, (const float*)(ws + WS_SLAB), gw, NGW, lane);
    xcd_barrier(bar);
    for (int u = blockIdx.x; u < NBATCH * BKV * 17; u += G) { const int n = u % 17, bg = u / 17; attn_prompt_unit(lds, QB, KB, VB, args.in[I_SINK], AM, bg >> 2, bg & 3, n, tid, wave, lane); }
    for (int u = (int)blockIdx.x - 32; u >= 0 && u < DECB * BKV; u += G - 32) attn_sample_unit(lds, QB, KB, VB, args.in[I_CKM], args.in[I_CVM], args.in[I_CKW], args.in[I_CVW], args.in[I_SINK], AM, u >> 2, u & 3, tid, wave, lane);
    xcd_barrier(bar);
    { EpiResPlain E{AB2, AB, SSQ, nullptr, (float*)(ws + WS_SLAB), 1.0f, DM / 64}; GEMM_PHASE_TS(EpiResPlain, E, AM, ws + WS_WBO, DM); }
    xcd_barrier(bar);
    resid_combine<false>(lds, AB2, AB, SSQ, RS, (const float*)(ws + WS_SLAB), 1.0f, nullptr, G, wave, gw, NGW, lane);
    xcd_barrier(bar);

    { EpiSwiglu<false> E{ACT, RS}; GEMM_PHASE(EpiSwiglu<false>, E, AB, ws + WS_W1 + 3 * SZ_W1, 2 * DFF, DM); }
    xcd_barrier(bar);
    { EpiResFinal E{AB, AB, SSQ, args.out, (float*)(ws + WS_SLAB), 0.5f, DFF / 64}; GEMM_PHASE_TSA(EpiResFinal, E, ACT, ws + WS_W2 + 3 * SZ_W2, DFF); }
    xcd_barrier(bar);
    resid_combine<true>(lds, AB, AB, SSQ, RS, (const float*)(ws + WS_SLAB), 0.5f, args.out, G, wave, gw, NGW, lane);
}

extern "C" void kernel_launch(void* const* d_in, const int* in_sizes, int n_in, void* d_out, int out_size, void* d_ws, size_t ws_size, hipStream_t stream) {
    static int grid = 0;
    if (grid == 0) {
        if (n_in != 25 || (size_t)out_size != O_END || ws_size < WS_END) { fprintf(stderr, "kernel_launch: unexpected shapes (n_in %d, out %d vs %zu, ws %zu vs %zu); nothing launched\n", n_in, out_size, (size_t)O_END, ws_size, (size_t)WS_END); grid = -1; return; }
        int dev = 0, cus = 0, per_cu = 0;
        if (hipGetDevice(&dev) != hipSuccess || hipDeviceGetAttribute(&cus, hipDeviceAttributeMultiprocessorCount, dev) != hipSuccess) { grid = -1; return; }
        if (hipFuncSetAttribute((const void*)yoco_fwd, hipFuncAttributeMaxDynamicSharedMemorySize, LDS_BYTES) != hipSuccess) { fprintf(stderr, "kernel_launch: hipFuncSetAttribute failed\n"); grid = -1; return; }
        if (hipOccupancyMaxActiveBlocksPerMultiprocessor(&per_cu, (const void*)yoco_fwd, NWAVES * 64, LDS_BYTES) != hipSuccess || per_cu < 1) fprintf(stderr, "kernel_launch: occupancy query says %d\n", per_cu);
        (void)hipGetLastError();
        grid = cus;
    }
    if (grid < 0) return;
    (void)in_sizes;
    if (hipMemsetAsync((char*)d_ws + WS_CTL, 0, CTL_ZERO_BYTES, stream) != hipSuccess) return;
    Args a{};
    for (int i = 0; i < 25; ++i) a.in[i] = (const float*)d_in[i];
    a.out = (float*)d_out; a.ws = (unsigned char*)d_ws;
    hipLaunchKernelGGL(yoco_fwd, dim3(grid), dim3(NWAVES * 64), LDS_BYTES, stream, a);
}
```
